# Optimizing an MI355X kernel written in HIP

```python
import math
import jax, jax.numpy as jnp
from jax import lax
import numpy as np

D_MODEL = 1024
BATCH = 8
SEQ = 2048
DEPTH = 1
DEC_BATCH = 128
DEC_SEQ = 8
PAST_LEN = 16384
PAGE_SIZE = 128

N_META = 16
D_LRU = 1024
LRU_BLOCKS = 16
LRU_BW = D_LRU // LRU_BLOCKS
LRU_CONV = 4
LRU_C = 8.0
ML_HEADS = 4
D_ML = 1024
ML_DH = D_ML // ML_HEADS
MLSTM_CHUNK = 64
D_FF = 2816
FFN_CONV = 3
N_IN = D_LRU + 4 * D_ML + 2 * ML_HEADS + 2 * D_MODEL
EPS = 1e-6

kernel_name = "hawk_mlstm_parallel_gated_convffn_step"


def rms_norm(x, g):
    xf = x.astype(jnp.float32)
    out = xf * lax.rsqrt(jnp.mean(xf * xf, axis=-1, keepdims=True) + EPS)
    return (out * g.astype(jnp.float32)).astype(x.dtype)


def causal_dwconv(u, buf, w, b):
    L = u.shape[1]
    W = w.shape[0]
    full = jnp.concatenate([buf.astype(u.dtype), u], axis=1)
    out = b + sum(full[:, j:j + L] * w[j] for j in range(W))
    return out, full[:, L:]


def rg_lru(x, h0, w_r, b_r, w_i, b_i, lam):
    B, L, C = x.shape
    xb = x.reshape(B, L, LRU_BLOCKS, LRU_BW)
    r = jax.nn.sigmoid(jnp.einsum('blnc,ncd->blnd', xb, w_r).reshape(B, L, C) + b_r)
    i = jax.nn.sigmoid(jnp.einsum('blnc,ncd->blnd', xb, w_i).reshape(B, L, C) + b_i)
    log_a = -LRU_C * r.astype(jnp.float32) * jax.nn.softplus(-lam.astype(jnp.float32))
    a = jnp.exp(log_a)
    inp = jnp.sqrt(-jnp.expm1(2.0 * log_a)) * (i * x).astype(jnp.float32)

    def step(h, t):
        a_t, u_t = t
        h = a_t * h + u_t
        return h, h

    h_last, hs = lax.scan(step, h0.astype(jnp.float32),
                          (jnp.swapaxes(a, 0, 1), jnp.swapaxes(inp, 0, 1)))
    return jnp.swapaxes(hs, 0, 1).astype(x.dtype), h_last


def mlstm_chunk(carry, inp):
    C, n, m = carry
    q, k, v, ig, lf = inp
    L = q.shape[2]
    b = jnp.cumsum(lf, axis=-1)
    causal = jnp.tril(jnp.ones((L, L), dtype=bool))
    dmat = jnp.where(causal, b[..., :, None] - b[..., None, :] + ig[..., None, :], -jnp.inf)
    inter = b + m[..., None]
    m_t = jnp.maximum(jnp.max(dmat, axis=-1), inter)
    w = jnp.exp(dmat - m_t[..., None])
    s = jnp.einsum('bhtd,bhsd->bhts', q, k) * w
    e_int = jnp.exp(inter - m_t)
    num = jnp.einsum('bhts,bhsv->bhtv', s, v) + e_int[..., None] * jnp.einsum('bhtd,bhdv->bhtv', q, C)
    den = jnp.sum(s, axis=-1) + e_int * jnp.einsum('bhtd,bhd->bht', q, n)
    h = num / jnp.maximum(jnp.abs(den), jnp.exp(-m_t))[..., None]
    bL = b[..., -1]
    g = bL[..., None] - b + ig
    m_new = jnp.maximum(bL + m, jnp.max(g, axis=-1))
    decay = jnp.exp(bL + m - m_new)
    wk = jnp.exp(g - m_new[..., None])
    C_new = decay[..., None, None] * C + jnp.einsum('bhs,bhsd,bhsv->bhdv', wk, k, v)
    n_new = decay[..., None] * n + jnp.einsum('bhs,bhsd->bhd', wk, k)
    return (C_new, n_new, m_new), h


def mlstm_seq(q, k, v, ig, lf, C, n, m, lead):
    B, H, Ltot, _ = q.shape
    carry = (C, n, m)
    outs = []
    if lead > 0:
        carry, h0 = mlstm_chunk(carry, (q[:, :, :lead], k[:, :, :lead], v[:, :, :lead],
                                        ig[:, :, :lead], lf[:, :, :lead]))
        outs.append(h0)
    T = Ltot - lead
    cs = math.gcd(T, MLSTM_CHUNK)
    nc = T // cs

    def to_chunks(a):
        a = a[:, :, lead:]
        a = a.reshape(a.shape[:2] + (nc, cs) + a.shape[3:])
        return jnp.moveaxis(a, 2, 0)

    carry, hs = lax.scan(mlstm_chunk, carry,
                         (to_chunks(q), to_chunks(k), to_chunks(v), to_chunks(ig), to_chunks(lf)))
    hs = jnp.moveaxis(hs, 0, 2).reshape(B, H, T, v.shape[-1])
    outs.append(hs)
    return jnp.concatenate(outs, axis=2), carry


def conv_ffn(xn, buf, w_up, cw, cb, w_down):
    up = xn @ w_up
    upc, new_buf = causal_dwconv(up, buf, cw, cb)
    val, gate = jnp.split(upc, 2, axis=-1)
    return (jax.nn.gelu(gate) * val) @ w_down, new_buf


def block(x, lead, st, lp):
    lru_conv_buf, lru_h, C, n, m, ffn_buf = st
    sdt = lru_h.dtype
    B, L, _ = x.shape
    xn = rms_norm(x, lp['norm1_g'])
    z = xn @ lp['w_in'] + lp['b_in']
    sizes = [D_LRU, D_ML, D_ML, D_ML, D_ML, ML_HEADS, ML_HEADS, D_MODEL]
    u, q, k, v, o, ipre, fpre, ga, gb = jnp.split(z, np.cumsum(sizes).tolist(), axis=-1)
    uc, new_lru_conv = causal_dwconv(u, lru_conv_buf, lp['lru_conv_w'], lp['lru_conv_b'])
    ha, new_lru_h = rg_lru(uc, lru_h, lp['lru_w_r'], lp['lru_b_r'], lp['lru_w_i'], lp['lru_b_i'], lp['lru_lambda'])

    def heads(a):
        return a.reshape(B, L, ML_HEADS, ML_DH).transpose(0, 2, 1, 3).astype(jnp.float32)

    qh = heads(q) * (ML_DH ** -0.5)
    kh = heads(k)
    vh = heads(v)
    ig = ipre.astype(jnp.float32).transpose(0, 2, 1)
    lf = jax.nn.log_sigmoid(fpre.astype(jnp.float32)).transpose(0, 2, 1)
    hb, (Cn, nn_, mn) = mlstm_seq(qh, kh, vh, ig, lf, C.astype(jnp.float32), n.astype(jnp.float32),
                                  m.astype(jnp.float32), lead)
    hb = hb.transpose(0, 2, 1, 3)
    hb = hb * lax.rsqrt(jnp.mean(hb * hb, axis=-1, keepdims=True) + EPS)
    hb = (hb.reshape(B, L, D_ML) * lp['mlstm_head_g'].astype(jnp.float32)).astype(x.dtype) * jax.nn.sigmoid(o)
    merged = jax.nn.sigmoid(ga) * (ha @ lp['w_branch_a']) + jax.nn.sigmoid(gb) * (hb @ lp['w_branch_b'])
    x = x + merged @ lp['w_out']
    f, new_ffn = conv_ffn(rms_norm(x, lp['norm2_g']), ffn_buf, lp['w_up'], lp['ffn_conv_w'],
                          lp['ffn_conv_b'], lp['w_down'])
    x = x + f
    return x, (new_lru_conv.astype(sdt), new_lru_h.astype(sdt), Cn.astype(sdt), nn_.astype(sdt),
               mn.astype(sdt), new_ffn.astype(sdt))


def setup_inputs(seed: int = 0) -> dict:
    key = jax.random.key(seed)
    ks = jax.random.split(key, 32)

    def nrm(k, shape, s):
        return jax.random.normal(k, shape, jnp.float32) * s

    f_off = D_LRU + 4 * D_ML + ML_HEADS
    b_in = nrm(ks[11], (DEPTH, N_IN), 0.01)
    b_in = b_in.at[:, f_off:f_off + ML_HEADS].add(jnp.linspace(3.0, 6.0, ML_HEADS))
    a0 = jax.random.uniform(ks[18], (DEPTH, D_LRU), jnp.float32, minval=0.9, maxval=0.999)
    s0 = a0 ** (1.0 / LRU_C)
    lru_lambda = jnp.log(s0) - jnp.log1p(-s0)
    return {
        "x_prompt": nrm(ks[0], (BATCH, SEQ, D_MODEL), 1.0),
        "x_sample": nrm(ks[1], (DEC_BATCH, DEC_SEQ, D_MODEL), 1.0),
        "state_lru_conv": nrm(ks[2], (DEPTH, DEC_BATCH, LRU_CONV - 1, D_LRU), 1.0),
        "state_lru_h": nrm(ks[3], (DEPTH, DEC_BATCH, D_LRU), 0.5),
        "state_mlstm_C": nrm(ks[4], (DEPTH, DEC_BATCH, ML_HEADS, ML_DH, ML_DH), 0.05),
        "state_mlstm_n": nrm(ks[5], (DEPTH, DEC_BATCH, ML_HEADS, ML_DH), 0.05),
        "state_mlstm_m": nrm(ks[6], (DEPTH, DEC_BATCH, ML_HEADS), 1.0),
        "state_ffn_conv": nrm(ks[7], (DEPTH, DEC_BATCH, FFN_CONV - 1, 2 * D_FF), 1.0),
        "meta_tokens": nrm(ks[8], (N_META, D_MODEL), 1.0),
        "norm1_g": 1.0 + nrm(ks[9], (DEPTH, D_MODEL), 0.02),
        "w_in": nrm(ks[10], (DEPTH, D_MODEL, N_IN), D_MODEL ** -0.5),
        "b_in": b_in,
        "lru_conv_w": nrm(ks[12], (DEPTH, LRU_CONV, D_LRU), LRU_CONV ** -0.5),
        "lru_conv_b": nrm(ks[13], (DEPTH, D_LRU), 0.01),
        "lru_w_r": nrm(ks[14], (DEPTH, LRU_BLOCKS, LRU_BW, LRU_BW), LRU_BW ** -0.5),
        "lru_b_r": nrm(ks[15], (DEPTH, D_LRU), 0.01),
        "lru_w_i": nrm(ks[16], (DEPTH, LRU_BLOCKS, LRU_BW, LRU_BW), LRU_BW ** -0.5),
        "lru_b_i": nrm(ks[17], (DEPTH, D_LRU), 0.01),
        "lru_lambda": lru_lambda,
        "mlstm_head_g": 1.0 + nrm(ks[19], (DEPTH, D_ML), 0.02),
        "w_branch_a": nrm(ks[20], (DEPTH, D_LRU, D_MODEL), D_LRU ** -0.5),
        "w_branch_b": nrm(ks[21], (DEPTH, D_ML, D_MODEL), D_ML ** -0.5),
        "w_out": nrm(ks[22], (DEPTH, D_MODEL, D_MODEL), D_MODEL ** -0.5),
        "norm2_g": 1.0 + nrm(ks[23], (DEPTH, D_MODEL), 0.02),
        "w_up": nrm(ks[24], (DEPTH, D_MODEL, 2 * D_FF), D_MODEL ** -0.5),
        "ffn_conv_w": nrm(ks[25], (DEPTH, FFN_CONV, 2 * D_FF), FFN_CONV ** -0.5),
        "ffn_conv_b": nrm(ks[26], (DEPTH, 2 * D_FF), 0.01),
        "w_down": nrm(ks[27], (DEPTH, D_FF, D_MODEL), D_FF ** -0.5),
        "final_g": 1.0 + nrm(ks[28], (D_MODEL,), 0.02),
    }


def reference(x_prompt, x_sample, state_lru_conv, state_lru_h, state_mlstm_C, state_mlstm_n,
              state_mlstm_m, state_ffn_conv, meta_tokens, norm1_g, w_in, b_in, lru_conv_w, lru_conv_b,
              lru_w_r, lru_b_r, lru_w_i, lru_b_i, lru_lambda, mlstm_head_g, w_branch_a, w_branch_b,
              w_out, norm2_g, w_up, ffn_conv_w, ffn_conv_b, w_down, final_g):
    dt = x_prompt.dtype
    bp = x_prompt.shape[0]
    meta = jnp.broadcast_to(meta_tokens[None].astype(dt), (bp, N_META, D_MODEL))
    xp = jnp.concatenate([meta, x_prompt], axis=1)
    xs = x_sample
    new_p = []
    new_s = []
    for l in range(DEPTH):
        lp = {
            'norm1_g': norm1_g[l], 'w_in': w_in[l], 'b_in': b_in[l],
            'lru_conv_w': lru_conv_w[l], 'lru_conv_b': lru_conv_b[l],
            'lru_w_r': lru_w_r[l], 'lru_b_r': lru_b_r[l], 'lru_w_i': lru_w_i[l], 'lru_b_i': lru_b_i[l],
            'lru_lambda': lru_lambda[l], 'mlstm_head_g': mlstm_head_g[l],
            'w_branch_a': w_branch_a[l], 'w_branch_b': w_branch_b[l], 'w_out': w_out[l],
            'norm2_g': norm2_g[l], 'w_up': w_up[l], 'ffn_conv_w': ffn_conv_w[l],
            'ffn_conv_b': ffn_conv_b[l], 'w_down': w_down[l],
        }
        zero = (jnp.zeros((bp, LRU_CONV - 1, D_LRU), dt), jnp.zeros((bp, D_LRU), dt),
                jnp.zeros((bp, ML_HEADS, ML_DH, ML_DH), dt), jnp.zeros((bp, ML_HEADS, ML_DH), dt),
                jnp.zeros((bp, ML_HEADS), dt), jnp.zeros((bp, FFN_CONV - 1, 2 * D_FF), dt))
        xp, sp = block(xp, N_META, zero, lp)
        xs, ss = block(xs, 0, (state_lru_conv[l], state_lru_h[l], state_mlstm_C[l], state_mlstm_n[l],
                               state_mlstm_m[l], state_ffn_conv[l]), lp)
        new_p.append(sp)
        new_s.append(ss)

    def stk(lst, i):
        return jnp.stack([t[i] for t in lst], axis=0)

    y_prompt = rms_norm(xp[:, N_META:], final_g)
    y_sample = rms_norm(xs, final_g)
    return (y_prompt, y_sample,
            stk(new_p, 0), stk(new_p, 1), stk(new_p, 2), stk(new_p, 3), stk(new_p, 4), stk(new_p, 5),
            stk(new_s, 0), stk(new_s, 1), stk(new_s, 2), stk(new_s, 3), stk(new_s, 4), stk(new_s, 5))
```

```cpp
#include <hip/hip_runtime.h>
#include <hip/hip_cooperative_groups.h>
#include <cstdio>
#include <cstdint>
namespace cg = cooperative_groups;

#ifndef MK_ONE_LAUNCH
#define MK_ONE_LAUNCH 1
#endif

#ifndef MK_KROT
#define MK_KROT 0
#endif
#ifndef MK_DUP
#define MK_DUP -1
#endif
#define LAS __attribute__((address_space(3)))
typedef unsigned short bf16_t;
typedef short bf16x8 __attribute__((ext_vector_type(8)));
typedef float f32x4 __attribute__((ext_vector_type(4)));
typedef float f32x2 __attribute__((ext_vector_type(2)));
typedef unsigned u32x4 __attribute__((ext_vector_type(4)));
typedef unsigned u32x2 __attribute__((ext_vector_type(2)));

constexpr int D = 1024, NBP = 8, SEQ = 2048, NMETA = 16, LP = SEQ + NMETA, DECB = 128, DECS = 8;
constexpr int MP = NBP * LP, MS = DECB * DECS, MTOK = MP + MS, MPAD = 17664;
constexpr int NSEQ = NBP + DECB;
constexpr int NIN = 7176, NZ = 7168;
constexpr int ZC_U = 0, ZC_Q = 1024, ZC_K = 2048, ZC_V = 3072, ZC_O = 4096, ZC_GA = 5120, ZC_GB = 6144;
constexpr int DFF = 2816, NUP = 5632, NH = 4, DH = 256;
constexpr float EPS = 1e-6f;
constexpr size_t O_YP = 0;
constexpr size_t O_YS = O_YP + (size_t)NBP * SEQ * D;
constexpr size_t O_PLC = O_YS + (size_t)DECB * DECS * D;
constexpr size_t O_PLH = O_PLC + (size_t)NBP * 3 * D;
constexpr size_t O_PC = O_PLH + (size_t)NBP * D;
constexpr size_t O_PN = O_PC + (size_t)NBP * NH * DH * DH;
constexpr size_t O_PM = O_PN + (size_t)NBP * NH * DH;
constexpr size_t O_PF = O_PM + (size_t)NBP * NH;
constexpr size_t O_SLC = O_PF + (size_t)NBP * 2 * NUP;
constexpr size_t O_SLH = O_SLC + (size_t)DECB * 3 * D;
constexpr size_t O_SC = O_SLH + (size_t)DECB * D;
constexpr size_t O_SN = O_SC + (size_t)DECB * NH * DH * DH;
constexpr size_t O_SM = O_SN + (size_t)DECB * NH * DH;
constexpr size_t O_SF = O_SM + (size_t)DECB * NH;
constexpr size_t O_END = O_SF + (size_t)DECB * 2 * NUP;
constexpr size_t MiB = 1u << 20;
constexpr size_t WS_CTL = 0, WS_WIN = 1 * MiB, WS_WCAT = 15 * MiB, WS_WOUT = 19 * MiB, WS_WUP = 21 * MiB, WS_WDOWN = 32 * MiB;
constexpr size_t WS_SMALL = 38 * MiB;
constexpr size_t WS_XN = 40 * MiB;
constexpr size_t WS_Z = 75 * MiB;
constexpr size_t WS_ACAT = 317 * MiB;
constexpr size_t WS_MERGED = 386 * MiB;
constexpr size_t WS_X1 = 421 * MiB;
constexpr size_t WS_END = 490 * MiB;
constexpr int LSEG = 64, NSEGP = 33;
constexpr size_t WS_WLRU = 39 * MiB;
constexpr size_t WS_SSQ = 39 * MiB + 512 * 1024;
constexpr size_t WS_PCUM = WS_MERGED;
constexpr size_t WS_AGG = WS_X1;
constexpr size_t WS_CARRY = WS_X1 + 4 * MiB;

struct P {
    const float* in[29];
    float* out;
    unsigned char* ws;
};
enum { I_XP = 0, I_XS, I_SLC, I_SLH, I_SC, I_SN, I_SM, I_SF, I_META, I_G1, I_WIN, I_BIN, I_LCW, I_LCB, I_LWR, I_LBR, I_LWI, I_LBI, I_LAM, I_HG, I_WA, I_WB, I_WOUT, I_G2, I_WUP, I_FCW, I_FCB, I_WDOWN, I_GF };

__device__ __forceinline__ unsigned pk2(float lo, float hi) { unsigned r; asm("v_cvt_pk_bf16_f32 %0, %1, %2" : "=v"(r) : "v"(lo), "v"(hi)); return r; }
__device__ __forceinline__ unsigned f2bf(float f) { return pk2(f, 0.f) & 0xffffu; }
__device__ __forceinline__ float bf2f(unsigned short b) { return __builtin_bit_cast(float, ((unsigned)b) << 16); }
__device__ __forceinline__ float bflo(unsigned w) { return __builtin_bit_cast(float, w << 16); }
__device__ __forceinline__ float bfhi(unsigned w) { return __builtin_bit_cast(float, w & 0xffff0000u); }
__device__ __forceinline__ void unpack8(const u32x4 w, float (&o)[8]) { o[0] = bflo(w.x); o[1] = bfhi(w.x); o[2] = bflo(w.y); o[3] = bfhi(w.y); o[4] = bflo(w.z); o[5] = bfhi(w.z); o[6] = bflo(w.w); o[7] = bfhi(w.w); }
__device__ __forceinline__ float wave_sum(float v) {
#pragma unroll
    for (int o = 1; o < 64; o <<= 1) v += __shfl_xor(v, o);
    return v;
}
__device__ __forceinline__ int lane_id_volatile() { int l; asm volatile("v_mbcnt_lo_u32_b32 %0, -1, 0\n\tv_mbcnt_hi_u32_b32 %0, -1, %0" : "=v"(l)); return l; }
__device__ __forceinline__ int opaque_tid(int wv) { return wv * 64 + lane_id_volatile(); }
__device__ __forceinline__ float sigmoidf_(float x) { return __builtin_amdgcn_rcpf(1.0f + __expf(-x)); }
constexpr int ZG_OFF = 8192, ZG_PITCH = 14336;
__device__ __forceinline__ float ub0(unsigned w) { return (float)(w & 0xffu); }
__device__ __forceinline__ float ub1(unsigned w) { return (float)((w >> 8) & 0xffu); }
__device__ __forceinline__ float ub2(unsigned w) { return (float)((w >> 16) & 0xffu); }
__device__ __forceinline__ float ub3(unsigned w) { return (float)(w >> 24); }
__device__ __forceinline__ unsigned q8(float s, unsigned lo) { const unsigned q = (unsigned)(s * 255.0f + 0.5f); return q < lo ? lo : q; }
__device__ __forceinline__ float logsigmoidf_(float x) { return fminf(x, 0.f) - log1pf(__expf(-fabsf(x))); }
__device__ __forceinline__ void seq_info(int s, int& row0, int& L) { if (s < NBP) { row0 = s * LP; L = LP; } else { row0 = MP + (s - NBP) * DECS; L = DECS; } }
__device__ __forceinline__ const float* xrow3(const float* meta, const float* xp, const float* xs, int r) {
    if (r < MP) { const int b = r / LP, t = r - b * LP; return t < NMETA ? meta + (size_t)t * D : xp + ((size_t)b * SEQ + (t - NMETA)) * D; }
    return xs + (size_t)(r - MP) * D;
}
__device__ __forceinline__ const float* xrow_ptr(const P& p, int r) {
    if (r < MP) { const int b = r / LP, t = r - b * LP; return t < NMETA ? p.in[I_META] + (size_t)t * D : p.in[I_XP] + ((size_t)b * SEQ + (t - NMETA)) * D; }
    return p.in[I_XS] + (size_t)(r - MP) * D;
}

namespace pg8 {
constexpr int BM = 256, BK = 64, HALF = 128, HTB = HALF * BK * 2, STAGE_BYTES = 8 * HTB, NXCD = 8, WGM = 8;
__host__ __device__ __forceinline__ int lds_byte(int r, int c) { const int st = (r >> 4) * 2 + (c >> 5), rr = r & 15, cc = c & 31, ob = rr * 64 + cc * 2; return st * 1024 + (ob ^ (((ob >> 9) & 1) << 5)); }
__host__ __device__ __forceinline__ void stage_rc(int b, int& R, int& C) { const int st = b / 1024, sb = b % 1024, swz = sb ^ (((sb >> 9) & 1) << 5); R = (st >> 1) * 16 + swz / 64; C = (st & 1) * 32 + (swz % 64) / 2; }
__host__ __device__ __forceinline__ int perm32(int rho) { const int n = rho >> 4, i = rho & 15; return 8 * (i >> 2) + 4 * n + (i & 3); }
__host__ __device__ __forceinline__ int up_row0(int pm) { return pm < 65 ? 254 * pm : MP + 256 * (pm - 65); }
struct Unit { int pm, pn, kt0, nt, kind, slot; };
struct Gemm { const bf16_t* A; const bf16_t* Bt; int M, N, K; int a_mode; };
struct StaticOrder {
    int nM, nN, nwg, G, c, ntk;
    __host__ __device__ void init(int M, int N, int K, int G_, int c_) { nM = M / BM; nN = N / BM; nwg = nM * nN; G = G_; c = c_; ntk = K / BK; }
    __host__ __device__ bool next(int i, Unit& u) const {
        const long L = (long)i * G + c; if (L >= nwg) return false;
        int wgid = (int)L; { const int q = nwg / NXCD, r = nwg % NXCD, xcd = wgid % NXCD, off = wgid / NXCD; wgid = (xcd < r ? xcd * (q + 1) : r * (q + 1) + (xcd - r) * q) + off; }
        const int nig = WGM * nN, gid = wgid / nig, fm = gid * WGM, gsz = (nM - fm) < WGM ? (nM - fm) : WGM;
        u.pm = fm + ((wgid % nig) % gsz); u.pn = (wgid % nig) / gsz; u.kt0 = 0; u.nt = ntk; u.kind = 0; u.slot = 0; return true;
    }
    __device__ __forceinline__ void a_ready(const Unit&) const {}
    __device__ __forceinline__ void done(const Unit&) const {}
};
struct SplitTailOrder : StaticOrder {
    int S;
    __host__ __device__ bool next(int i, Unit& u) const {
        if (S <= 0 || i == 0) return StaticOrder::next(i, u);
        if (i > 1) return false;
        const int R = nwg - G; if (R <= 0 || c >= R * S) return false;
        StaticOrder t = *this; t.c = c / S; if (!t.StaticOrder::next(1, u)) return false;
        const int sl = c % S, per = ntk / S; u.kt0 = sl * per; u.nt = per; u.kind = 1; u.slot = c; return true;
    }
};
__device__ __forceinline__ unsigned cvt_pk_bf16(float lo, float hi) { unsigned r; asm volatile("v_cvt_pk_bf16_f32 %0, %1, %2" : "=v"(r) : "v"(lo), "v"(hi)); return r; }

struct EpiBf16 {
    static constexpr bool PERM = true, APERM = false, AFTER_DRAIN = false, HAS_MID = false, TAIL_REDUCE = false;
    bf16_t* O; int ldc; const float* bias; const float* ssq;
    __device__ __forceinline__ void mid(f32x4 (&acc)[2][2][4][2], const Unit& u, int wr, int wc, int fr, int fq) const {}
    __device__ __forceinline__ void operator()(const f32x4 (&acc)[2][2][4][2], const Unit& u, int wr, int wc, int fr, int fq) const {
        const int row0 = u.pm * BM + wr * 64 + fr; const int col0 = u.pn * BM + wc * 32 + 8 * fq;
        f32x4 bv[2][2];
#pragma unroll
        for (int bj = 0; bj < 2; ++bj)
#pragma unroll
            for (int n = 0; n < 2; ++n) bv[bj][n] = bias ? *(const f32x4*)(bias + col0 + bj * HALF + 4 * n) : (f32x4){0.f, 0.f, 0.f, 0.f};
        if (u.pn >= 16) {
            const unsigned lo = (u.pn >= 24) ? 1u : 0u; unsigned char* zb = (unsigned char*)O + ZG_OFF + (col0 - 4096);
#pragma unroll
            for (int ai = 0; ai < 2; ++ai)
#pragma unroll
                for (int m = 0; m < 4; ++m) { unsigned char* rowp = zb + (size_t)(row0 + ai * HALF + m * 16) * ZG_PITCH;
#pragma unroll
                    for (int bj = 0; bj < 2; ++bj) { u32x2 w;
#pragma unroll
                        for (int n = 0; n < 2; ++n) {
                            const f32x4 t = (acc[ai][bj][m][n] + bv[bj][n]) * (-1.4426950408889634f);
                            const f32x4 d = (f32x4){__builtin_amdgcn_exp2f(t[0]), __builtin_amdgcn_exp2f(t[1]), __builtin_amdgcn_exp2f(t[2]), __builtin_amdgcn_exp2f(t[3])} + 1.0f;
                            const f32x4 sq = (f32x4){__builtin_amdgcn_rcpf(d[0]), __builtin_amdgcn_rcpf(d[1]), __builtin_amdgcn_rcpf(d[2]), __builtin_amdgcn_rcpf(d[3])} * 255.0f + 0.5f;
                            unsigned q0 = (unsigned)sq[0], q1 = (unsigned)sq[1], q2 = (unsigned)sq[2], q3 = (unsigned)sq[3];
                            if (lo) { q0 = q0 < 1u ? 1u : q0; q1 = q1 < 1u ? 1u : q1; q2 = q2 < 1u ? 1u : q2; q3 = q3 < 1u ? 1u : q3; }
                            const unsigned pw = q0 | (q1 << 8) | (q2 << 16) | (q3 << 24); if (n == 0) w.x = pw; else w.y = pw; }
                        *(u32x2*)(rowp + bj * HALF) = w; } }
            return; }
#pragma unroll
        for (int ai = 0; ai < 2; ++ai)
#pragma unroll
            for (int m = 0; m < 4; ++m) { bf16_t* rowp = O + (size_t)(row0 + ai * HALF + m * 16) * ldc + col0;
                const float rs = ssq ? 1.0f / sqrtf(ssq[row0 + ai * HALF + m * 16] * (1.0f / D) + EPS) : 1.0f;
#pragma unroll
                for (int bj = 0; bj < 2; ++bj) { const f32x4 v0 = acc[ai][bj][m][0] * rs + bv[bj][0], v1 = acc[ai][bj][m][1] * rs + bv[bj][1];
                    u32x4 w; w.x = cvt_pk_bf16(v0[0], v0[1]); w.y = cvt_pk_bf16(v0[2], v0[3]); w.z = cvt_pk_bf16(v1[0], v1[1]); w.w = cvt_pk_bf16(v1[2], v1[3]);
                    __builtin_nontemporal_store(w, (u32x4*)(rowp + bj * HALF)); } }
    }
};
template <int CTRL> __device__ __forceinline__ float dppmovz(float src) { return __builtin_bit_cast(float, __builtin_amdgcn_update_dpp(0, __builtin_bit_cast(int, src), CTRL, 0xf, 0xf, true)); }
__device__ __forceinline__ float gelu_tanh_e(float x) { const float u2 = -1.5957691216057308f * (x + 0.044715f * x * x * x); return x * __builtin_amdgcn_rcpf(1.0f + __expf(u2)); }
struct EpiUp {
    static constexpr bool PERM = true, APERM = true, AFTER_DRAIN = false, HAS_MID = false, TAIL_REDUCE = false;
    bf16_t* HM; const float* ssq; const float* cw; const float* cb; const float* sf; float* out; LAS float* EX;
    __device__ __forceinline__ void mid(f32x4 (&acc)[2][2][4][2], const Unit& u, int wr, int wc, int fr, int fq) const {}
    __device__ __forceinline__ void operator()(f32x4 (&acc)[2][2][4][2], const Unit& u, int wr, int wc, int fr_, int fq_) const {
        int fr = fr_, fq = fq_; asm volatile("" : "+v"(fr), "+v"(fq));
        const int rbase = up_row0(u.pm) + wr * 64 + 4 * fr;
        const bool sample = u.pm >= 65;
#pragma unroll
        for (int ai = 0; ai < 2; ++ai) { const f32x4 sq = *(const f32x4*)(ssq + rbase + ai * HALF);
#pragma unroll
            for (int m = 0; m < 4; ++m) { const float rs = __builtin_amdgcn_rsqf(sq[m] * (1.0f / D) + EPS);
#pragma unroll
                for (int bj = 0; bj < 2; ++bj)
#pragma unroll
                    for (int n = 0; n < 2; ++n) acc[ai][bj][m][n] = acc[ai][bj][m][n] * rs; } }
        const int cl = wc * 32 + 8 * fq;
        if (fr == 15) {
#pragma unroll
            for (int ai = 0; ai < 2; ++ai)
#pragma unroll
                for (int bj = 0; bj < 2; ++bj)
#pragma unroll
                    for (int n = 0; n < 2; ++n) { *(LAS f32x4*)(EX + ((ai * 2 + wr) * 2 + 0) * 256 + bj * 128 + cl + 4 * n) = acc[ai][bj][2][n]; *(LAS f32x4*)(EX + ((ai * 2 + wr) * 2 + 1) * 256 + bj * 128 + cl + 4 * n) = acc[ai][bj][3][n]; } }
        asm volatile("s_waitcnt lgkmcnt(0)" ::: "memory"); __builtin_amdgcn_s_barrier(); asm volatile("" ::: "memory");
        const float mk0 = (fr == 0) ? 1.f : 0.f;
        const int hal = (u.pm >= 1 && u.pm < 65) ? 2 : 0;
        const int ch0 = u.pn * 128 + cl;
#pragma unroll
        for (int n = 0; n < 2; ++n) {
            const int ch = ch0 + 4 * n;
            const f32x4 wv0 = *(const f32x4*)(cw + ch), wv1 = *(const f32x4*)(cw + NUP + ch), wv2 = *(const f32x4*)(cw + 2 * NUP + ch), bv = *(const f32x4*)(cb + ch);
            const f32x4 wg0 = *(const f32x4*)(cw + DFF + ch), wg1 = *(const f32x4*)(cw + NUP + DFF + ch), wg2 = *(const f32x4*)(cw + 2 * NUP + DFF + ch), bg = *(const f32x4*)(cb + DFF + ch);
#pragma unroll
            for (int ai = 0; ai < 2; ++ai) {
                const int r0 = rbase + ai * HALF;
                const int t0 = sample ? ((r0 - MP) & 7) : (r0 - (r0 / LP) * LP);
                f32x4 p1v = {0.f, 0.f, 0.f, 0.f}, p2v = p1v, p1g = p1v, p2g = p1v;
                if (ai + wr > 0) { const int pb = (wr == 1) ? (ai * 2) : 1;
                    p2v = *(const LAS f32x4*)(EX + (pb * 2 + 0) * 256 + cl + 4 * n) * mk0; p1v = *(const LAS f32x4*)(EX + (pb * 2 + 1) * 256 + cl + 4 * n) * mk0;
                    p2g = *(const LAS f32x4*)(EX + (pb * 2 + 0) * 256 + 128 + cl + 4 * n) * mk0; p1g = *(const LAS f32x4*)(EX + (pb * 2 + 1) * 256 + 128 + cl + 4 * n) * mk0; }
#pragma unroll
                for (int j = 0; j < 4; ++j) { p1v[j] += dppmovz<0x111>(acc[ai][0][3][n][j]); p2v[j] += dppmovz<0x111>(acc[ai][0][2][n][j]); p1g[j] += dppmovz<0x111>(acc[ai][1][3][n][j]); p2g[j] += dppmovz<0x111>(acc[ai][1][2][n][j]); }
                if (sample) {
                    if ((fr & 1) == 0) { const float* b0 = sf + (size_t)((r0 - MP) >> 3) * 2 * NUP; p2v = *(const f32x4*)(b0 + ch); p2g = *(const f32x4*)(b0 + DFF + ch); p1v = *(const f32x4*)(b0 + NUP + ch); p1g = *(const f32x4*)(b0 + NUP + DFF + ch); } }
                if (!sample && __builtin_amdgcn_ballot_w64(t0 == 0) != 0ull) { const float keep = (t0 == 0) ? 0.f : 1.f; p1v = p1v * keep; p2v = p2v * keep; p1g = p1g * keep; p2g = p2g * keep; }
                const bool zmid = !sample && __builtin_amdgcn_ballot_w64(t0 == LP - 2) != 0ull; const float z2 = (!sample && t0 == LP - 2) ? 1.f : 0.f;
#pragma unroll
                for (int m = 0; m < 4; ++m) {
                    const f32x4 xv = acc[ai][0][m][n], xg = acc[ai][1][m][n];
                    const f32x4 av = (m == 0) ? p1v : acc[ai][0][m > 0 ? m - 1 : 0][n], ag = (m == 0) ? p1g : acc[ai][1][m > 0 ? m - 1 : 0][n];
                    const f32x4 bv2 = (m == 0) ? p2v : (m == 1) ? p1v : acc[ai][0][m > 1 ? m - 2 : 0][n], bg2 = (m == 0) ? p2g : (m == 1) ? p1g : acc[ai][1][m > 1 ? m - 2 : 0][n];
                    f32x4 cv = bv + wv2 * xv + wv1 * av + wv0 * bv2, cg = bg + wg2 * xg + wg1 * ag + wg0 * bg2;
                    if (zmid && m == 2) { cv -= z2 * (wv1 * av + wv0 * bv2); cg -= z2 * (wg1 * ag + wg0 * bg2); }
                    if (zmid && m == 3) { cv -= z2 * (wv0 * bv2); cg -= z2 * (wg0 * bg2); }
                    if (ai * HALF + wr * 64 + 4 * fr + m >= hal) {
                        const f32x4 tg = cg * ((cg * cg) * 0.044715f + 1.0f), ug = tg * (-1.5957691216057308f * 1.4426950408889634f);
                        const f32x4 dg = (f32x4){__builtin_amdgcn_exp2f(ug[0]), __builtin_amdgcn_exp2f(ug[1]), __builtin_amdgcn_exp2f(ug[2]), __builtin_amdgcn_exp2f(ug[3])} + 1.0f;
                        const f32x4 og = (cg * cv) * (f32x4){__builtin_amdgcn_rcpf(dg[0]), __builtin_amdgcn_rcpf(dg[1]), __builtin_amdgcn_rcpf(dg[2]), __builtin_amdgcn_rcpf(dg[3])};
                        u32x2 w; w.x = cvt_pk_bf16(og[0], og[1]); w.y = cvt_pk_bf16(og[2], og[3]);
                        *(u32x2*)(HM + (size_t)(r0 + m) * DFF + ch) = w; }
                    __builtin_amdgcn_sched_barrier(0); }
            }
        }
#pragma unroll
        for (int ai = 0; ai < 2; ++ai) {
            int r0s = rbase + ai * HALF; asm volatile("" : "+v"(r0s));
            const int t0 = sample ? ((r0s - MP) & 7) : (r0s - (r0s / LP) * LP), Lq = sample ? DECS : LP;
            if (__builtin_amdgcn_ballot_w64(t0 + 3 >= Lq - 2) != 0ull) {
                float* ob = sample ? out + O_SF + (size_t)((r0s - MP) >> 3) * 2 * NUP : out + O_PF + (size_t)(r0s / LP) * 2 * NUP;
#pragma unroll
                for (int m = 0; m < 4; ++m) { const int t = t0 + m, i = ai * HALF + wr * 64 + 4 * fr + m;
                    if (t >= Lq - 2 && t < Lq && i >= hal) { float* of = ob + (size_t)(t - (Lq - 2)) * NUP + ch0;
                        *(f32x4*)(of) = acc[ai][0][m][0]; *(f32x4*)(of + 4) = acc[ai][0][m][1]; *(f32x4*)(of + DFF) = acc[ai][1][m][0]; *(f32x4*)(of + DFF + 4) = acc[ai][1][m][1]; } } }
        }
    }
};
struct EpiMerge {
    static constexpr bool PERM = true, APERM = false, AFTER_DRAIN = false, HAS_MID = true, TAIL_REDUCE = true;
    bf16_t* O; const bf16_t* Z; float* PART; unsigned* tcnt; int S;
    __device__ __forceinline__ void mid(f32x4 (&acc)[2][2][4][2], const Unit& u, int wr, int wc, int fr, int fq) const {
        int row0 = u.pm * BM + wr * 64 + fr; const int col0 = u.pn * BM + wc * 32 + 8 * fq;
        asm volatile("" : "+v"(row0));
#pragma unroll
        for (int ai = 0; ai < 2; ++ai)
#pragma unroll
            for (int m = 0; m < 4; ++m) { const unsigned char* zr = (const unsigned char*)Z + (size_t)(row0 + ai * HALF + m * 16) * ZG_PITCH + ZG_OFF + col0;
#pragma unroll
                for (int bj = 0; bj < 2; ++bj) {
                    const u32x2 qa = *(const u32x2*)(zr + 1024 + bj * HALF), qb = *(const u32x2*)(zr + 2048 + bj * HALF);
                    const unsigned qaw[2] = {qa.x, qa.y}, qbw[2] = {qb.x, qb.y};
#pragma unroll
                    for (int n = 0; n < 2; ++n) { const unsigned wa = qaw[n], wb = qbw[n];
                        acc[ai][bj][m][n][0] *= ub0(wa) * __builtin_amdgcn_rcpf(ub0(wb)); acc[ai][bj][m][n][1] *= ub1(wa) * __builtin_amdgcn_rcpf(ub1(wb));
                        acc[ai][bj][m][n][2] *= ub2(wa) * __builtin_amdgcn_rcpf(ub2(wb)); acc[ai][bj][m][n][3] *= ub3(wa) * __builtin_amdgcn_rcpf(ub3(wb)); } }
                asm volatile("" ::: "memory"); }
    }
    __device__ __forceinline__ void operator()(const f32x4 (&acc)[2][2][4][2], const Unit& u, int wr, int wc, int fr, int fq) const {
        const int row0 = u.pm * BM + wr * 64 + fr; const int col0 = u.pn * BM + wc * 32 + 8 * fq;
#pragma unroll
        for (int ai = 0; ai < 2; ++ai)
#pragma unroll
            for (int m = 0; m < 4; ++m) { const size_t r = (size_t)(row0 + ai * HALF + m * 16);
#pragma unroll
                for (int bj = 0; bj < 2; ++bj) {
                    const u32x2 qb = *(const u32x2*)((const unsigned char*)Z + r * ZG_PITCH + ZG_OFF + 2048 + col0 + bj * HALF); const unsigned qbw[2] = {qb.x, qb.y};
                    float v[8];
#pragma unroll
                    for (int n = 0; n < 2; ++n) { const unsigned wb = qbw[n]; const f32x4 a = acc[ai][bj][m][n] * (1.0f / 255.0f);
                        v[4 * n + 0] = a[0] * ub0(wb); v[4 * n + 1] = a[1] * ub1(wb); v[4 * n + 2] = a[2] * ub2(wb); v[4 * n + 3] = a[3] * ub3(wb); }
                    u32x4 w; w.x = cvt_pk_bf16(v[0], v[1]); w.y = cvt_pk_bf16(v[2], v[3]); w.z = cvt_pk_bf16(v[4], v[5]); w.w = cvt_pk_bf16(v[6], v[7]);
                    *(u32x4*)(O + r * D + col0 + bj * HALF) = w; }
                asm volatile("" ::: "memory"); }
    }
    __device__ __forceinline__ void strip(const f32x4 (&sA)[4][2], const f32x4 (&sB)[4][2], const Unit& u, int wr, int wc, int fr, int fq, int a, int b, int m0, int nm) const {
        const int row0 = u.pm * BM + a * HALF + wr * 64 + fr, col0 = u.pn * BM + b * HALF + wc * 32 + 8 * fq;
#pragma unroll
        for (int mi = 0; mi < 4; ++mi) if (mi < nm) { const size_t r = (size_t)(row0 + (m0 + mi) * 16);
            const unsigned char* zr = (const unsigned char*)Z + r * ZG_PITCH + ZG_OFF + col0; const u32x2 qa = *(const u32x2*)(zr + 1024), qb = *(const u32x2*)(zr + 2048); const unsigned qaw[2] = {qa.x, qa.y}, qbw[2] = {qb.x, qb.y};
            float v[8];
#pragma unroll
            for (int n = 0; n < 2; ++n) { const unsigned wa = qaw[n], wb = qbw[n]; const f32x4 xa = sA[mi][n] * (1.0f / 255.0f), xb = sB[mi][n] * (1.0f / 255.0f);
                v[4 * n + 0] = ub0(wa) * xa[0] + ub0(wb) * xb[0]; v[4 * n + 1] = ub1(wa) * xa[1] + ub1(wb) * xb[1]; v[4 * n + 2] = ub2(wa) * xa[2] + ub2(wb) * xb[2]; v[4 * n + 3] = ub3(wa) * xa[3] + ub3(wb) * xb[3]; }
            u32x4 w; w.x = cvt_pk_bf16(v[0], v[1]); w.y = cvt_pk_bf16(v[2], v[3]); w.z = cvt_pk_bf16(v[4], v[5]); w.w = cvt_pk_bf16(v[6], v[7]);
            *(u32x4*)(O + r * D + col0) = w; }
    }
};
struct EpiX1 {
    static constexpr bool PERM = true, APERM = false, AFTER_DRAIN = false, HAS_MID = false, TAIL_REDUCE = true;
    const float *meta, *xp, *xs; float* X1; bf16_t* XN; float* ssq; float* PART; unsigned* tcnt; int S;
    __device__ __forceinline__ void mid(f32x4 (&acc)[2][2][4][2], const Unit& u, int wr, int wc, int fr, int fq) const {}
    __device__ __forceinline__ void operator()(const f32x4 (&acc)[2][2][4][2], const Unit& u, int wr, int wc, int fr, int fq) const {
        const int row0 = u.pm * BM + wr * 64 + fr, col0 = u.pn * BM + wc * 32 + 8 * fq;
#pragma unroll
        for (int ai = 0; ai < 2; ++ai)
#pragma unroll
            for (int m = 0; m < 4; ++m) { const int r = row0 + ai * HALF + m * 16; float sq = 0.f;
                if (r < MTOK) { const float* xr = xrow3(meta, xp, xs, r) + col0; bf16_t* ob = XN + (size_t)r * D + col0;
#pragma unroll
                    for (int bj = 0; bj < 2; ++bj) { const f32x4 v0 = *(const f32x4*)(xr + bj * HALF) + acc[ai][bj][m][0], v1 = *(const f32x4*)(xr + bj * HALF + 4) + acc[ai][bj][m][1];
                        u32x4 w; w.x = cvt_pk_bf16(v0[0], v0[1]); w.y = cvt_pk_bf16(v0[2], v0[3]); w.z = cvt_pk_bf16(v1[0], v1[1]); w.w = cvt_pk_bf16(v1[2], v1[3]); *(u32x4*)(ob + bj * HALF) = w;
                        sq += ((v0[0] * v0[0] + v0[1] * v0[1]) + (v0[2] * v0[2] + v0[3] * v0[3])) + ((v1[0] * v1[0] + v1[1] * v1[1]) + (v1[2] * v1[2] + v1[3] * v1[3])); } }
                sq += __shfl_xor(sq, 16); sq += __shfl_xor(sq, 32);
                if (fq == 0 && r < MTOK) atomicAdd(ssq + r, sq); }
    }
    __device__ __forceinline__ void strip(const f32x4 (&sA)[4][2], const f32x4 (&sB)[4][2], const Unit& u, int wr, int wc, int fr, int fq, int a, int b, int m0, int nm) const {
        const int row0 = u.pm * BM + a * HALF + wr * 64 + fr, col0 = u.pn * BM + b * HALF + wc * 32 + 8 * fq;
#pragma unroll
        for (int mi = 0; mi < 4; ++mi) if (mi < nm) { const int r = row0 + (m0 + mi) * 16; float sq = 0.f;
            if (r < MTOK) { const float* xr = xrow3(meta, xp, xs, r) + col0; bf16_t* ob = XN + (size_t)r * D + col0;
                const f32x4 v0 = *(const f32x4*)(xr) + sA[mi][0], v1 = *(const f32x4*)(xr + 4) + sA[mi][1];
                u32x4 w; w.x = cvt_pk_bf16(v0[0], v0[1]); w.y = cvt_pk_bf16(v0[2], v0[3]); w.z = cvt_pk_bf16(v1[0], v1[1]); w.w = cvt_pk_bf16(v1[2], v1[3]); *(u32x4*)ob = w;
                sq += ((v0[0] * v0[0] + v0[1] * v0[1]) + (v0[2] * v0[2] + v0[3] * v0[3])) + ((v1[0] * v1[0] + v1[1] * v1[1]) + (v1[2] * v1[2] + v1[3] * v1[3])); }
            sq += __shfl_xor(sq, 16); sq += __shfl_xor(sq, 32);
            if (fq == 0 && r < MTOK) atomicAdd(ssq + r, sq); }
    }
};
struct EpiAcc {
    static constexpr bool PERM = true, APERM = false, AFTER_DRAIN = false, HAS_MID = false, TAIL_REDUCE = false;
    const bf16_t* X1B; bf16_t* X2B; float* PART;
    __device__ __forceinline__ void mid(f32x4 (&acc)[2][2][4][2], const Unit& u, int wr, int wc, int fr, int fq) const {}
    __device__ __forceinline__ void operator()(const f32x4 (&acc)[2][2][4][2], const Unit& u, int wr, int wc, int fr, int fq) const {
        const int rl0 = wr * 64 + fr, cl0 = wc * 32 + 8 * fq;
        if (u.kind == 0) {
#pragma unroll
            for (int ai = 0; ai < 2; ++ai)
#pragma unroll
                for (int m = 0; m < 4; ++m) { const int r = u.pm * BM + rl0 + ai * HALF + m * 16;
                    if (r < MTOK) { const size_t e = (size_t)r * D + u.pn * BM + cl0;
#pragma unroll
                        for (int bj = 0; bj < 2; ++bj) { const u32x4 xw = *(const u32x4*)(X1B + e + bj * HALF); const f32x4 a0 = acc[ai][bj][m][0], a1 = acc[ai][bj][m][1];
                            u32x4 w; w.x = cvt_pk_bf16(bflo(xw.x) + a0[0], bfhi(xw.x) + a0[1]); w.y = cvt_pk_bf16(bflo(xw.y) + a0[2], bfhi(xw.y) + a0[3]);
                            w.z = cvt_pk_bf16(bflo(xw.z) + a1[0], bfhi(xw.z) + a1[1]); w.w = cvt_pk_bf16(bflo(xw.w) + a1[2], bfhi(xw.w) + a1[3]);
                            *(u32x4*)(X2B + e + bj * HALF) = w; } } }
        } else {
            bf16_t* pt = (bf16_t*)PART + (size_t)u.slot * 65536;
#pragma unroll
            for (int ai = 0; ai < 2; ++ai)
#pragma unroll
                for (int m = 0; m < 4; ++m) { bf16_t* o = pt + (size_t)(rl0 + ai * HALF + m * 16) * 256 + cl0;
#pragma unroll
                    for (int bj = 0; bj < 2; ++bj) { const f32x4 a0 = acc[ai][bj][m][0], a1 = acc[ai][bj][m][1];
                        u32x4 w; w.x = cvt_pk_bf16(a0[0], a0[1]); w.y = cvt_pk_bf16(a0[2], a0[3]); w.z = cvt_pk_bf16(a1[0], a1[1]); w.w = cvt_pk_bf16(a1[2], a1[3]); *(u32x4*)(o + bj * HALF) = w; } }
        }
    }
};

template <class Epi, class Sched, bool ALIGN_EPI = false, bool SP2 = false>
__device__ __forceinline__ void gemm_phase(LAS unsigned char* lds, const Gemm g, const Sched& S, const Epi& E, int wv) {
    int tid_ = opaque_tid(wv);
    const int tid = tid_, wid = __builtin_amdgcn_readfirstlane(tid >> 6), lane = tid & 63, wr = wid >> 2, wc = wid & 3, fr = lane & 15, fq = lane >> 4;
    const int K = g.K;
    unsigned voffA[2], voffB[2];
#pragma unroll
    for (int i = 0; i < 2; ++i) { int R, C; stage_rc(tid * 16 + i * 8192, R, C); const int Rb = Epi::PERM ? ((R & ~31) + perm32(R & 31)) : R;
        const int Ra = Epi::APERM ? ((R & ~63) + 4 * (R & 15) + ((R >> 4) & 3)) : R;
        voffA[i] = (unsigned)(Ra * K + C) * 2u; voffB[i] = (unsigned)(Rb * K + C) * 2u; }
    const size_t kstep = (size_t)(BK * 2);
    const size_t hstep = (size_t)HALF * K * 2;
    const size_t tstep = 2 * hstep;
    const unsigned ldsw = (unsigned)wid * 1024u;
    const int aoff = lds_byte(wr * 64 + fr, fq * 8), boff = lds_byte(wc * 32 + fr, fq * 8);
#define PG8_SA(b, h) (((b) * 2 + (h)) * HTB)
#define PG8_SB(b, h) ((4 + (b) * 2 + (h)) * HTB)
#define PG8_STAGE(bufoff, gbase, voff) do { _Pragma("unroll") for (int _i = 0; _i < 2; ++_i) \
        __builtin_amdgcn_global_load_lds((const unsigned*)((const char*)(gbase) + (voff)[_i]), (LAS unsigned*)(lds + (bufoff) + ldsw + _i * 8192), 16, 0, 0); } while (0)
#define PG8_LDA(dst, b, h) do { _Pragma("unroll") for (int m = 0; m < 4; ++m) _Pragma("unroll") for (int k = 0; k < 2; ++k) dst[m][k] = *(const LAS bf16x8*)(lds + PG8_SA(b, h) + aoff + m * 2048 + k * 1024); } while (0)
#define PG8_LDB(dst, b, h) do { _Pragma("unroll") for (int n = 0; n < 2; ++n) _Pragma("unroll") for (int k = 0; k < 2; ++k) dst[n][k] = *(const LAS bf16x8*)(lds + PG8_SB(b, h) + boff + n * 2048 + k * 1024); } while (0)
#define PG8_MMA(ai, bj, At, Bt) do { __builtin_amdgcn_s_setprio(1); _Pragma("unroll") for (int m = 0; m < 4; ++m) _Pragma("unroll") for (int n = 0; n < 2; ++n) _Pragma("unroll") for (int k = 0; k < 2; ++k) \
        acc[ai][bj][m][n] = __builtin_amdgcn_mfma_f32_16x16x32_bf16(Bt[n][k], At[m][k], acc[ai][bj][m][n], 0, 0, 0); __builtin_amdgcn_s_setprio(0); } while (0)
#define PG8_WAIT_V(n) asm volatile("s_waitcnt vmcnt(" #n ")" ::: "memory")
#define PG8_WAIT_L(n) asm volatile("s_waitcnt lgkmcnt(" #n ")" ::: "memory")
#define PG8_BAR __builtin_amdgcn_s_barrier()
#define PG8_SCHED __builtin_amdgcn_sched_barrier(0)
    Unit cur, nxt; int ui = 0;
    if (!S.next(0, cur)) return;
    f32x4 acc[2][2][4][2];
#pragma unroll
    for (int a = 0; a < 2; ++a)
#pragma unroll
        for (int b = 0; b < 2; ++b)
#pragma unroll
            for (int m = 0; m < 4; ++m)
#pragma unroll
                for (int n = 0; n < 2; ++n) acc[a][b][m][n] = (f32x4){0.f, 0.f, 0.f, 0.f};
    bf16x8 At[4][2], B0[2][2], B1[2][2];
    const char* cA = (const char*)g.A + (size_t)(g.a_mode ? up_row0(cur.pm) : cur.pm * BM) * K * 2 + (size_t)cur.kt0 * kstep; const char* cB = (const char*)g.Bt + (size_t)cur.pn * tstep + (size_t)cur.kt0 * kstep;
    S.a_ready(cur);
    auto krot = [](const Unit& u) -> int { return (MK_KROT && !Epi::HAS_MID && u.kind == 0) ? (((((u.pm + 2 * u.pn) & 7) * u.nt) >> 3) & ~1) : 0; };
    int crot = krot(cur);
    { const char* fA = cA + (size_t)crot * kstep; const char* fB = cB + (size_t)crot * kstep;
    if constexpr (SP2) {
        PG8_STAGE(PG8_SB(0, 0), fB, voffB); PG8_STAGE(PG8_SB(0, 1), fB + hstep, voffB); PG8_STAGE(PG8_SA(0, 0), fA, voffA); PG8_STAGE(PG8_SA(0, 1), fA + hstep, voffA);
        if (wr == 1) PG8_BAR;
        PG8_WAIT_V(2); PG8_BAR;
        PG8_STAGE(PG8_SB(1, 0), fB + kstep, voffB); PG8_STAGE(PG8_SA(1, 0), fA + kstep, voffA); PG8_STAGE(PG8_SB(1, 1), fB + hstep + kstep, voffB);
        PG8_WAIT_V(6); PG8_BAR;
    } else {
        PG8_STAGE(PG8_SB(0, 0), fB, voffB); PG8_STAGE(PG8_SA(0, 0), fA, voffA); PG8_STAGE(PG8_SB(0, 1), fB + hstep, voffB); PG8_STAGE(PG8_SA(0, 1), fA + hstep, voffA);
        if (wr == 1) PG8_BAR;
        PG8_WAIT_V(4); PG8_BAR;
        PG8_STAGE(PG8_SB(1, 0), fB + kstep, voffB); PG8_STAGE(PG8_SA(1, 0), fA + kstep, voffA); PG8_STAGE(PG8_SB(1, 1), fB + hstep + kstep, voffB);
        PG8_WAIT_V(6); PG8_BAR;
    } }
    for (;;) {
        const bool has_next = S.next(ui + 1, nxt);
        const char* nA = has_next ? (const char*)g.A + (size_t)(g.a_mode ? up_row0(nxt.pm) : nxt.pm * BM) * K * 2 + (size_t)nxt.kt0 * kstep : cA; const char* nB = has_next ? (const char*)g.Bt + (size_t)nxt.pn * tstep + (size_t)nxt.kt0 * kstep : cB;
        const int nt = cur.nt; const int nrot = has_next ? krot(nxt) : 0;
        for (int t = 0; t < nt; t += 2) {
            const bool last = (t == nt - 2);
            int k1 = crot + t + 1, k2 = crot + t + 2; if (k1 >= nt) k1 -= nt; if (k2 >= nt) k2 -= nt;
            const char* a1 = cA + (size_t)k1 * kstep;
            const char* a2 = last ? nA + (size_t)nrot * kstep : cA + (size_t)k2 * kstep; const char* b2 = last ? nB + (size_t)nrot * kstep : cB + (size_t)k2 * kstep;
            const char* a3 = a2 + kstep; const char* b3 = b2 + kstep;
            if (last && has_next) S.a_ready(nxt);
            if constexpr (Epi::HAS_MID) { if (cur.kind == 0 && t == (nt >> 1)) E.mid(acc, cur, wr, wc, fr, fq); }
            if constexpr (SP2) {
            PG8_LDB(B0, 0, 0); PG8_LDB(B1, 0, 1); PG8_SCHED; PG8_LDA(At, 0, 0); PG8_STAGE(PG8_SA(1, 1), a1 + hstep, voffA);
            PG8_WAIT_V(8); PG8_WAIT_L(0); PG8_BAR; PG8_MMA(0, 0, At, B0); PG8_MMA(0, 1, At, B1); PG8_BAR; PG8_SCHED;
            PG8_LDA(At, 0, 1); PG8_STAGE(PG8_SB(0, 0), b2, voffB); PG8_STAGE(PG8_SB(0, 1), b2 + hstep, voffB); PG8_STAGE(PG8_SA(0, 0), a2, voffA);
            PG8_WAIT_V(8); PG8_WAIT_L(0); PG8_BAR; PG8_MMA(1, 0, At, B0); PG8_MMA(1, 1, At, B1); PG8_BAR; PG8_SCHED;
            PG8_LDB(B0, 1, 0); PG8_LDB(B1, 1, 1); PG8_SCHED; PG8_LDA(At, 1, 0); PG8_STAGE(PG8_SA(0, 1), a2 + hstep, voffA);
            PG8_WAIT_V(8); PG8_WAIT_L(0); PG8_BAR; PG8_MMA(0, 0, At, B0); PG8_MMA(0, 1, At, B1); PG8_BAR; PG8_SCHED;
            PG8_LDA(At, 1, 1); PG8_STAGE(PG8_SB(1, 0), b3, voffB); PG8_STAGE(PG8_SB(1, 1), b3 + hstep, voffB); PG8_STAGE(PG8_SA(1, 0), a3, voffA);
            PG8_WAIT_V(8); PG8_WAIT_L(0); PG8_BAR; PG8_MMA(1, 0, At, B0); PG8_MMA(1, 1, At, B1); PG8_BAR; PG8_SCHED;
            } else {
            PG8_LDB(B0, 0, 0); PG8_SCHED; PG8_LDA(At, 0, 0); PG8_STAGE(PG8_SA(1, 1), a1 + hstep, voffA);
            PG8_WAIT_L(8); PG8_BAR; PG8_WAIT_L(0); PG8_MMA(0, 0, At, B0); PG8_BAR; PG8_SCHED;
            PG8_LDB(B1, 0, 1); PG8_STAGE(PG8_SB(0, 0), b2, voffB);
            PG8_BAR; PG8_WAIT_L(0); PG8_MMA(0, 1, At, B1); PG8_BAR;
            PG8_LDA(At, 0, 1); PG8_STAGE(PG8_SA(0, 0), a2, voffA);
            PG8_BAR; PG8_WAIT_L(0); PG8_MMA(1, 0, At, B0); PG8_BAR; PG8_SCHED;
            PG8_STAGE(PG8_SB(0, 1), b2 + hstep, voffB);
            PG8_WAIT_V(6); PG8_BAR; PG8_MMA(1, 1, At, B1); PG8_BAR;
            PG8_LDB(B0, 1, 0); PG8_SCHED; PG8_LDA(At, 1, 0); PG8_STAGE(PG8_SA(0, 1), a2 + hstep, voffA);
            PG8_WAIT_L(8); PG8_BAR; PG8_WAIT_L(0); PG8_MMA(0, 0, At, B0); PG8_BAR; PG8_SCHED;
            PG8_LDB(B1, 1, 1); PG8_STAGE(PG8_SB(1, 0), b3, voffB);
            PG8_BAR; PG8_WAIT_L(0); PG8_MMA(0, 1, At, B1); PG8_BAR;
            PG8_LDA(At, 1, 1); PG8_STAGE(PG8_SA(1, 0), a3, voffA);
            PG8_BAR; PG8_WAIT_L(0); PG8_MMA(1, 0, At, B0); PG8_BAR; PG8_SCHED;
            PG8_STAGE(PG8_SB(1, 1), b3 + hstep, voffB);
            PG8_WAIT_V(6); PG8_BAR; PG8_MMA(1, 1, At, B1); PG8_BAR;
            }
        }
        if constexpr (ALIGN_EPI) { if (wr == 0) PG8_BAR; }
        if constexpr (Epi::TAIL_REDUCE) {
            if (cur.kind == 1) {
                const int tix = cur.slot / E.S, sl = cur.slot - tix * E.S; LAS unsigned* bw = (LAS unsigned*)(lds + STAGE_BYTES + 8192);
                { const __amdgpu_buffer_rsrc_t rs = __builtin_amdgcn_make_buffer_rsrc(E.PART, 0, 0x7fffffff, 0x00020000); const unsigned base = ((unsigned)cur.slot * 8192u + (unsigned)tid) * 16u;
#pragma unroll
                  for (int a = 0; a < 2; ++a)
#pragma unroll
                      for (int b = 0; b < 2; ++b)
#pragma unroll
                          for (int m = 0; m < 4; ++m) { const f32x4 a0 = acc[a][b][m][0], a1 = acc[a][b][m][1];
                              u32x4 w; w.x = cvt_pk_bf16(a0[0], a0[1]); w.y = cvt_pk_bf16(a0[2], a0[3]); w.z = cvt_pk_bf16(a1[0], a1[1]); w.w = cvt_pk_bf16(a1[2], a1[3]);
                              __builtin_amdgcn_raw_buffer_store_b128(w, rs, base + (unsigned)(((a * 2 + b) * 4 + m) * 512 * 16), 0, 16); } }
                asm volatile("s_waitcnt vmcnt(0)" ::: "memory"); PG8_BAR; asm volatile("" ::: "memory");
                if (tid == 0) { (void)__hip_atomic_fetch_add(E.tcnt + tix, 1u, __ATOMIC_RELAXED, __HIP_MEMORY_SCOPE_AGENT);
                    unsigned sp = 0; while (__hip_atomic_load(E.tcnt + tix, __ATOMIC_RELAXED, __HIP_MEMORY_SCOPE_AGENT) < (unsigned)E.S) { __builtin_amdgcn_s_sleep(2); if (++sp > (1u << 22)) break; }
                    __builtin_amdgcn_fence(__ATOMIC_ACQUIRE, "agent"); }
                asm volatile("s_waitcnt vmcnt(0) lgkmcnt(0)" ::: "memory"); PG8_BAR; asm volatile("" ::: "memory");
                __builtin_amdgcn_fence(__ATOMIC_ACQUIRE, "agent"); asm volatile("s_waitcnt vmcnt(0)" ::: "memory");
                const int per = 32 / E.S, i0 = sl * per, sa_ = i0 >> 4, sb_ = (i0 >> 3) & 1, m0 = (i0 >> 1) & 3, nm = per >> 1;
                f32x4 sA[4][2], sB[4][2];
#pragma unroll
                for (int mi = 0; mi < 4; ++mi)
#pragma unroll
                    for (int n = 0; n < 2; ++n) { sA[mi][n] = (f32x4){0.f, 0.f, 0.f, 0.f}; sB[mi][n] = (f32x4){0.f, 0.f, 0.f, 0.f}; }
#pragma unroll 1
                for (int s2 = 0; s2 < E.S; ++s2) {
                    const u32x4* pp = (const u32x4*)((const char*)E.PART + (size_t)(tix * E.S + s2) * 131072) + tid + (i0 >> 1) * 512; f32x4 tq[4][2];
#pragma unroll
                    for (int mi = 0; mi < 4; ++mi) { u32x4 pw = {0u, 0u, 0u, 0u}; if (mi < nm) pw = pp[mi * 512];
                        tq[mi][0] = (f32x4){__builtin_bit_cast(float, pw.x << 16), __builtin_bit_cast(float, pw.x & 0xffff0000u), __builtin_bit_cast(float, pw.y << 16), __builtin_bit_cast(float, pw.y & 0xffff0000u)};
                        tq[mi][1] = (f32x4){__builtin_bit_cast(float, pw.z << 16), __builtin_bit_cast(float, pw.z & 0xffff0000u), __builtin_bit_cast(float, pw.w << 16), __builtin_bit_cast(float, pw.w & 0xffff0000u)}; }
                    const bool second = Epi::HAS_MID && (s2 >= (E.S >> 1));
#pragma unroll
                    for (int mi = 0; mi < 4; ++mi)
#pragma unroll
                        for (int n = 0; n < 2; ++n) { if (second) sB[mi][n] += tq[mi][n]; else sA[mi][n] += tq[mi][n]; } }
                E.strip(sA, sB, cur, wr, wc, fr, fq, sa_, sb_, m0, nm);
            } else E(acc, cur, wr, wc, fr, fq);
        } else E(acc, cur, wr, wc, fr, fq);
        S.done(cur);
        if (!has_next) break;
#pragma unroll
        for (int a = 0; a < 2; ++a)
#pragma unroll
            for (int b = 0; b < 2; ++b)
#pragma unroll
                for (int m = 0; m < 4; ++m)
#pragma unroll
                    for (int n = 0; n < 2; ++n) acc[a][b][m][n] = (f32x4){0.f, 0.f, 0.f, 0.f};
        cur = nxt; cA = nA; cB = nB; crot = nrot; ++ui;
        if constexpr (ALIGN_EPI) { if (wr == 1) PG8_BAR; }
    }
    PG8_WAIT_V(0);
    if constexpr (!ALIGN_EPI) { if (wr == 0) PG8_BAR; }
    PG8_BAR;
#undef PG8_SA
#undef PG8_SB
#undef PG8_STAGE
#undef PG8_LDA
#undef PG8_LDB
#undef PG8_MMA
#undef PG8_WAIT_V
#undef PG8_WAIT_L
#undef PG8_BAR
#undef PG8_SCHED
}
}

constexpr int LDS_BYTES = 159744;
constexpr int NTHREADS = 512;

__device__ __forceinline__ void tr_item(const float* W, int ldw, int k0, int ns0, bf16_t* WT, int ldt, int nd0, int kd0, const float* kscale, float cs, LAS float* scr, int lane) {
    float wv_[32];
#pragma unroll
    for (int i = 0; i < 32; ++i) wv_[i] = W[(size_t)(k0 + 2 * i + (lane >> 5)) * ldw + ns0 + (lane & 31)];
#pragma unroll
    for (int i = 0; i < 32; ++i) { const int kk = 2 * i + (lane >> 5); const float s = kscale ? kscale[k0 + kk] * cs : cs; scr[kk * 33 + (lane & 31)] = wv_[i] * s; }
    asm volatile("s_waitcnt lgkmcnt(0)" ::: "memory");
    const int c = lane & 7;
#pragma unroll
    for (int j = 0; j < 4; ++j) { const int n = (lane >> 3) + 8 * j; const LAS float* s = scr + (8 * c) * 33 + n;
        u32x4 o; o.x = pk2(s[0 * 33], s[1 * 33]); o.y = pk2(s[2 * 33], s[3 * 33]); o.z = pk2(s[4 * 33], s[5 * 33]); o.w = pk2(s[6 * 33], s[7 * 33]);
        *(u32x4*)(WT + (size_t)(nd0 + n) * ldt + kd0 + k0 + 8 * c) = o; }
    asm volatile("s_waitcnt lgkmcnt(0)" ::: "memory");
}
__device__ __forceinline__ void phase_prep(const P& p, LAS unsigned char* lds, int bid, int nb, int wv) {
    const int tid = opaque_tid(wv), lane = tid & 63, wave = tid >> 6;
    unsigned char* ws = p.ws;
    LAS float* scr = (LAS float*)(lds + wave * 8448);
    LAS float* wg = (LAS float*)(lds + 8 * 8448);
    const float* w_in = p.in[I_WIN];
    for (int i = tid; i < 8192; i += NTHREADS) { const int k = i >> 3, j = i & 7; wg[j * 1024 + k] = w_in[(size_t)k * NIN + 5120 + j]; }
    __syncthreads();
    const int gw = wave * nb + bid, NGW = nb * 8;
    constexpr int I_IN = 16 * 224;
    for (int it = gw; it < I_IN; it += NGW) { const int kb = it / 224, nbk = it % 224, n0 = nbk * 32; const int ns0 = n0 + (n0 >= 5120 ? 8 : 0); const float cs = (n0 >= ZC_Q && n0 < ZC_K) ? 0.0625f : 1.0f;
        tr_item(w_in, NIN, kb * 64, ns0, (bf16_t*)(ws + WS_WIN), 1024, n0, 0, nullptr, cs, scr, lane); }
    { bf16_t* WL = (bf16_t*)(ws + WS_WLRU);
      for (int e = bid * NTHREADS + tid; e < 2 * 65536; e += nb * NTHREADS) { const int gate = e >> 16, n = (e >> 12) & 15, d = (e >> 6) & 63, c = e & 63;
          WL[e] = (bf16_t)f2bf((gate ? p.in[I_LWI] : p.in[I_LWR])[(size_t)(n * 64 + c) * 64 + d]); }
    }
    { float* ssq = (float*)(ws + WS_SSQ); for (int i = bid * NTHREADS + tid; i < MPAD; i += nb * NTHREADS) ssq[i] = 0.f; }
    { float* bias1 = (float*)(ws + WS_SMALL); const float* b_in = p.in[I_BIN];
      for (int n = bid * NTHREADS + tid; n < NZ; n += nb * NTHREADS) { const float cs = (n >= ZC_Q && n < ZC_K) ? 0.0625f : 1.0f; bias1[n] = b_in[n + (n >= 5120 ? 8 : 0)] * cs; } }
    { bf16_t* XN = (bf16_t*)(ws + WS_XN); float* gates = (float*)(ws + WS_SMALL + 65536); const float* g1 = p.in[I_G1]; const float* b_in = p.in[I_BIN];
      f32x4 vn[4];
      if (gw < MTOK) { const f32x4* xr = (const f32x4*)xrow_ptr(p, gw) + lane;
#pragma unroll
          for (int j = 0; j < 4; ++j) vn[j] = xr[64 * j]; }
      for (int m = gw; m < MTOK; m += NGW) {
          f32x4 v[4]; float s = 0.f;
#pragma unroll
          for (int j = 0; j < 4; ++j) v[j] = vn[j];
          if (m + NGW < MTOK) { const f32x4* xr = (const f32x4*)xrow_ptr(p, m + NGW) + lane;
#pragma unroll
              for (int j = 0; j < 4; ++j) vn[j] = xr[64 * j]; }
#pragma unroll
          for (int j = 0; j < 4; ++j) s += (v[j].x * v[j].x + v[j].y * v[j].y) + (v[j].z * v[j].z + v[j].w * v[j].w);
          const float rstd = 1.0f / sqrtf(wave_sum(s) * (1.0f / D) + EPS);
          unsigned long long* o8 = (unsigned long long*)(XN + (size_t)m * D) + lane;
          float ga[8];
#pragma unroll
          for (int q = 0; q < 8; ++q) ga[q] = 0.f;
#pragma unroll
          for (int j = 0; j < 4; ++j) { const f32x4 gg = ((const f32x4*)g1)[lane + 64 * j]; v[j] = v[j] * rstd * gg;
              o8[64 * j] = (unsigned long long)pk2(v[j].x, v[j].y) | ((unsigned long long)pk2(v[j].z, v[j].w) << 32);
#pragma unroll
              for (int q = 0; q < 8; ++q) { const f32x4 w = *(const LAS f32x4*)(wg + q * 1024 + 4 * (lane + 64 * j)); ga[q] += (v[j].x * w.x + v[j].y * w.y) + (v[j].z * w.z + v[j].w * w.w); } }
#pragma unroll
          for (int q = 0; q < 8; ++q) ga[q] = wave_sum(ga[q]);
          if (lane < 8) { float r = ga[0];
#pragma unroll
              for (int q = 1; q < 8; ++q) r = (lane == q) ? ga[q] : r;
              gates[(size_t)m * 8 + lane] = r + b_in[5120 + lane]; }
      } }
}

__device__ __forceinline__ void lru_load8(const bf16_t* Z, const float* st, int row0, int L, int tok, int ch, float (&o)[8]) {
    if (tok >= 0) { const int tc = tok < L ? tok : L - 1; const u32x4 w = *(const u32x4*)(Z + (size_t)(row0 + tc) * NZ + ZC_U + ch);
        o[0] = bflo(w.x); o[1] = bfhi(w.x); o[2] = bflo(w.y); o[3] = bfhi(w.y); o[4] = bflo(w.z); o[5] = bfhi(w.z); o[6] = bflo(w.w); o[7] = bfhi(w.w); }
    else if (st) { const f32x4 a = *(const f32x4*)(st + (size_t)(3 + tok) * D + ch), b = *(const f32x4*)(st + (size_t)(3 + tok) * D + ch + 4);
        o[0] = a.x; o[1] = a.y; o[2] = a.z; o[3] = a.w; o[4] = b.x; o[5] = b.y; o[6] = b.z; o[7] = b.w; }
    else {
#pragma unroll
        for (int q = 0; q < 8; ++q) o[q] = 0.f; }
}
__device__ __forceinline__ void phase_lru(const P& p, LAS unsigned char* lds, int bid, int nb, int wv, int it_lo, int it_hi) {
    const int tid = opaque_tid(wv), lane = tid & 63, w = __builtin_amdgcn_readfirstlane(tid >> 6), g = lane >> 4, li = lane & 15;
    const bf16_t* Z = (const bf16_t*)(p.ws + WS_Z); bf16_t* ACAT = (bf16_t*)(p.ws + WS_ACAT); bf16_t* PCUM = (bf16_t*)(p.ws + WS_PCUM);
    float* AGG = (float*)(p.ws + WS_AGG); float* CARRY = (float*)(p.ws + WS_CARRY); const bf16_t* WL = (const bf16_t*)(p.ws + WS_WLRU); unsigned* cnt = (unsigned*)(p.ws + WS_CTL);
    LAS float* cwL = (LAS float*)(lds + w * 6400);
    LAS float* ucL = cwL + 320;
    LAS float* gbL = cwL + 1408;
    const int n = bid & 15;
    LAS unsigned char* wls = lds + 8 * 6400;
    for (int i = tid; i < 1024; i += NTHREADS) { const int row = i >> 3, ch8 = i & 7; *(LAS u32x4*)(wls + row * 144 + ch8 * 16) = *(const u32x4*)(WL + (size_t)((row >> 6) * 16 + n) * 4096 + (row & 63) * 64 + ch8 * 8); }
    __syncthreads();
    constexpr int NPI = NBP * NSEGP, NIT = NPI + DECB;
    const int nwv = (nb >> 4) * 8;
    for (int it = it_lo + (bid >> 4) * 8 + w; it < (it_hi < NIT ? it_hi : NIT); it += nwv) {
        int s, seg;
        constexpr int NFULL = NBP * (NSEGP - 1);
        if (it < NFULL) { seg = it % (NSEGP - 1); s = it / (NSEGP - 1); } else if (it < NPI) { s = it - NFULL; seg = NSEGP - 1; } else { s = NBP + (it - NPI); seg = 0; }
        int row0, L; seq_info(s, row0, L);
        const int tb = seg * LSEG, te = (tb + LSEG < L) ? tb + LSEG : L, ntile = (te - tb + 15) >> 4;
        const float* st = (s >= NBP) ? p.in[I_SLC] + (size_t)(s - NBP) * 3 * D : nullptr;
        { const int ch = n * 64 + lane; cwL[lane] = p.in[I_LCW][ch]; cwL[64 + lane] = p.in[I_LCW][D + ch]; cwL[128 + lane] = p.in[I_LCW][2 * D + ch]; cwL[192 + lane] = p.in[I_LCW][3 * D + ch]; cwL[256 + lane] = p.in[I_LCB][ch]; }
        { const int ch = n * 64 + lane; const float lam = p.in[I_LAM][ch]; gbL[lane] = p.in[I_LBR][ch]; gbL[64 + lane] = p.in[I_LBI][ch]; gbL[128 + lane] = 8.0f * (fmaxf(-lam, 0.f) + log1pf(__expf(-fabsf(lam)))); }
        float hc[4], pc[4];
#pragma unroll
        for (int q = 0; q < 4; ++q) { const int ch = n * 64 + 16 * q + li; hc[q] = (s >= NBP) ? p.in[I_SLH][(size_t)(s - NBP) * D + ch] : 0.f; pc[q] = 1.f; }
        const int cA = n * 64 + 8 * g, cB = cA + 32;
        u32x4 rwa[4], rwb[4];
#define LRU_LOADRAW(tt0_) do { _Pragma("unroll") for (int d = 0; d < 4; ++d) { int tok = (tt0_) + li - 3 + d; tok = tok < 0 ? 0 : (tok < L ? tok : L - 1); \
            const bf16_t* zr = Z + (size_t)(row0 + tok) * NZ + ZC_U; rwa[d] = *(const u32x4*)(zr + cA); rwb[d] = *(const u32x4*)(zr + cB); } } while (0)
        LRU_LOADRAW(tb);
        for (int tile = 0; tile < ntile; ++tile) {
            const int tt0 = tb + tile * 16, t = tt0 + li;
            float ucA[8], ucB[8];
            { const f32x4 b0 = *(const LAS f32x4*)(cwL + 256 + 8 * g), b1 = *(const LAS f32x4*)(cwL + 256 + 8 * g + 4), b2 = *(const LAS f32x4*)(cwL + 256 + 32 + 8 * g), b3 = *(const LAS f32x4*)(cwL + 256 + 32 + 8 * g + 4);
              ucA[0] = b0.x; ucA[1] = b0.y; ucA[2] = b0.z; ucA[3] = b0.w; ucA[4] = b1.x; ucA[5] = b1.y; ucA[6] = b1.z; ucA[7] = b1.w;
              ucB[0] = b2.x; ucB[1] = b2.y; ucB[2] = b2.z; ucB[3] = b2.w; ucB[4] = b3.x; ucB[5] = b3.y; ucB[6] = b3.z; ucB[7] = b3.w; }
#pragma unroll
            for (int d = 0; d < 4; ++d) { float ua[8], ub[8]; unpack8(rwa[d], ua); unpack8(rwb[d], ub);
                if (tt0 == 0 && t - 3 + d < 0) { lru_load8(Z, st, row0, L, t - 3 + d, cA, ua); lru_load8(Z, st, row0, L, t - 3 + d, cB, ub); }
                const f32x4 w0 = *(const LAS f32x4*)(cwL + d * 64 + 8 * g), w1 = *(const LAS f32x4*)(cwL + d * 64 + 8 * g + 4), w2 = *(const LAS f32x4*)(cwL + d * 64 + 32 + 8 * g), w3 = *(const LAS f32x4*)(cwL + d * 64 + 32 + 8 * g + 4);
                ucA[0] += w0.x * ua[0]; ucA[1] += w0.y * ua[1]; ucA[2] += w0.z * ua[2]; ucA[3] += w0.w * ua[3]; ucA[4] += w1.x * ua[4]; ucA[5] += w1.y * ua[5]; ucA[6] += w1.z * ua[6]; ucA[7] += w1.w * ua[7];
                ucB[0] += w2.x * ub[0]; ucB[1] += w2.y * ub[1]; ucB[2] += w2.z * ub[2]; ucB[3] += w2.w * ub[3]; ucB[4] += w3.x * ub[4]; ucB[5] += w3.y * ub[5]; ucB[6] += w3.z * ub[6]; ucB[7] += w3.w * ub[7]; }
            if (tile + 1 < ntile) LRU_LOADRAW(tt0 + 16);
            *(LAS f32x4*)(ucL + li * 68 + 8 * g) = (f32x4){ucA[0], ucA[1], ucA[2], ucA[3]}; *(LAS f32x4*)(ucL + li * 68 + 8 * g + 4) = (f32x4){ucA[4], ucA[5], ucA[6], ucA[7]};
            *(LAS f32x4*)(ucL + li * 68 + 32 + 8 * g) = (f32x4){ucB[0], ucB[1], ucB[2], ucB[3]}; *(LAS f32x4*)(ucL + li * 68 + 32 + 8 * g + 4) = (f32x4){ucB[4], ucB[5], ucB[6], ucB[7]};
            bf16x8 af[2];
            { u32x4 a0, a1; a0.x = pk2(ucA[0], ucA[1]); a0.y = pk2(ucA[2], ucA[3]); a0.z = pk2(ucA[4], ucA[5]); a0.w = pk2(ucA[6], ucA[7]);
              a1.x = pk2(ucB[0], ucB[1]); a1.y = pk2(ucB[2], ucB[3]); a1.z = pk2(ucB[4], ucB[5]); a1.w = pk2(ucB[6], ucB[7]);
              af[0] = __builtin_bit_cast(bf16x8, a0); af[1] = __builtin_bit_cast(bf16x8, a1); }
            f32x4 ra[4], ia[4];
#pragma unroll
            for (int q = 0; q < 4; ++q) { ra[q] = (f32x4){0.f, 0.f, 0.f, 0.f}; ia[q] = (f32x4){0.f, 0.f, 0.f, 0.f};
#pragma unroll
                for (int k = 0; k < 2; ++k) { const bf16x8 wr0 = *(const LAS bf16x8*)(wls + (16 * q + li) * 144 + (32 * k + 8 * g) * 2), wi0 = *(const LAS bf16x8*)(wls + (64 + 16 * q + li) * 144 + (32 * k + 8 * g) * 2);
                    ra[q] = __builtin_amdgcn_mfma_f32_16x16x32_bf16(af[k], wr0, ra[q], 0, 0, 0); ia[q] = __builtin_amdgcn_mfma_f32_16x16x32_bf16(af[k], wi0, ia[q], 0, 0, 0); } }
            asm volatile("s_waitcnt lgkmcnt(0)" ::: "memory");
#pragma unroll
            for (int q = 0; q < 4; ++q) {
                const float brq = gbL[16 * q + li], biq = gbL[64 + 16 * q + li], sp8q = gbL[128 + 16 * q + li];
                float av[4], hv[4], pv[4];
                {
                    constexpr float L2E = 1.4426950408889634f;
                    const f32x4 uc4 = {ucL[(4 * g + 0) * 68 + 16 * q + li], ucL[(4 * g + 1) * 68 + 16 * q + li], ucL[(4 * g + 2) * 68 + 16 * q + li], ucL[(4 * g + 3) * 68 + 16 * q + li]};
                    const f32x4 xr = (ra[q] + brq) * (-L2E), xi = (ia[q] + biq) * (-L2E);
                    const f32x4 dr = (f32x4){__builtin_amdgcn_exp2f(xr[0]), __builtin_amdgcn_exp2f(xr[1]), __builtin_amdgcn_exp2f(xr[2]), __builtin_amdgcn_exp2f(xr[3])} + 1.0f;
                    const f32x4 di = (f32x4){__builtin_amdgcn_exp2f(xi[0]), __builtin_amdgcn_exp2f(xi[1]), __builtin_amdgcn_exp2f(xi[2]), __builtin_amdgcn_exp2f(xi[3])} + 1.0f;
                    const f32x4 rg = {__builtin_amdgcn_rcpf(dr[0]), __builtin_amdgcn_rcpf(dr[1]), __builtin_amdgcn_rcpf(dr[2]), __builtin_amdgcn_rcpf(dr[3])};
                    const f32x4 ig = {__builtin_amdgcn_rcpf(di[0]), __builtin_amdgcn_rcpf(di[1]), __builtin_amdgcn_rcpf(di[2]), __builtin_amdgcn_rcpf(di[3])};
                    const f32x4 la = rg * (-sp8q), y = la + la, le = la * L2E;
                    const f32x4 a4 = {__builtin_amdgcn_exp2f(le[0]), __builtin_amdgcn_exp2f(le[1]), __builtin_amdgcn_exp2f(le[2]), __builtin_amdgcn_exp2f(le[3])};
                    const f32x4 ser = (0.0f - y) * (1.0f + y * (0.5f + y * (0.16666667f + y * (0.041666668f + y * 0.0083333338f)))), dir = 1.0f - a4 * a4;
                    const f32x4 iu = ig * uc4;
#pragma unroll
                    for (int r = 0; r < 4; ++r) { const float om = (y[r] > -0.125f) ? ser[r] : dir[r]; float a = a4[r], inp = __builtin_amdgcn_sqrtf(om) * iu[r];
                        if (tt0 + 4 * g + r >= te) { a = 1.f; inp = 0.f; }
                        av[r] = a; hv[r] = inp; } }
                pv[0] = av[0];
#pragma unroll
                for (int r = 1; r < 4; ++r) { hv[r] = av[r] * hv[r - 1] + hv[r]; pv[r] = av[r] * pv[r - 1]; }
                float Pg[4], Hg[4];
#pragma unroll
                for (int x = 0; x < 4; ++x) { Pg[x] = __shfl(pv[3], li + 16 * x); Hg[x] = __shfl(hv[3], li + 16 * x); }
                float cin = hc[q], pin = pc[q], mycin = cin, mypin = pin;
#pragma unroll
                for (int x = 0; x < 4; ++x) { cin = Hg[x] + Pg[x] * cin; pin = Pg[x] * pin; if (g == x + 1) { mycin = cin; mypin = pin; } }
                hc[q] = cin; pc[q] = pin;
                { const unsigned ao = ((unsigned)(row0 + tt0 + 4 * g) * 2048u + (unsigned)(n * 64 + li)) * 2u, po = ((unsigned)(row0 + tt0 + 4 * g) * (unsigned)D + (unsigned)(n * 64 + li)) * 2u;
                  if (tt0 + 16 <= te) {
#pragma unroll
                      for (int r = 0; r < 4; ++r) { *(bf16_t*)((char*)ACAT + (ao + (unsigned)(r * 4096 + q * 32))) = (bf16_t)f2bf(hv[r] + pv[r] * mycin);
                          if (seg > 0) *((unsigned char*)PCUM + ((po >> 1) + (unsigned)(r * D + q * 16))) = (unsigned char)q8(pv[r] * mypin, 0u); }
                  } else {
#pragma unroll
                      for (int r = 0; r < 4; ++r) { if (tt0 + 4 * g + r < te) { *(bf16_t*)((char*)ACAT + (ao + (unsigned)(r * 4096 + q * 32))) = (bf16_t)f2bf(hv[r] + pv[r] * mycin);
                          if (seg > 0) *((unsigned char*)PCUM + ((po >> 1) + (unsigned)(r * D + q * 16))) = (unsigned char)q8(pv[r] * mypin, 0u); } } } }
            }
        }
        const int lane = lane_id_volatile(), g = lane >> 4, li = lane & 15;
        if (te == L) { float* oc = (s < NBP) ? p.out + O_PLC + (size_t)s * 3 * D : p.out + O_SLC + (size_t)(s - NBP) * 3 * D; const int ch = n * 64 + lane;
#pragma unroll
            for (int i = 0; i < 3; ++i) oc[(size_t)i * D + ch] = bf2f(Z[(size_t)(row0 + L - 3 + i) * NZ + ZC_U + ch]); }
        if (s >= NBP) { if (g == 0) {
#pragma unroll
            for (int q = 0; q < 4; ++q) p.out[O_SLH + (size_t)(s - NBP) * D + n * 64 + 16 * q + li] = hc[q]; } }
        else {
            if (g == 0) {
#pragma unroll
                for (int q = 0; q < 4; ++q) { float* ag = AGG + ((size_t)(s * NSEGP + seg) * D + n * 64 + 16 * q + li) * 2;
                    __hip_atomic_store(ag, pc[q], __ATOMIC_RELAXED, __HIP_MEMORY_SCOPE_AGENT); __hip_atomic_store(ag + 1, hc[q], __ATOMIC_RELAXED, __HIP_MEMORY_SCOPE_AGENT); } }
            asm volatile("s_waitcnt vmcnt(0)" ::: "memory");
            unsigned old = 0; if (lane == 0) old = __hip_atomic_fetch_add(cnt + s * 16 + n, 1u, __ATOMIC_RELAXED, __HIP_MEMORY_SCOPE_AGENT);
            old = (unsigned)__builtin_amdgcn_readfirstlane((int)old);
            if (old == NSEGP - 1) {
                __builtin_amdgcn_fence(__ATOMIC_ACQUIRE, "agent");
                const int ch = n * 64 + lane; const float* ag0 = AGG + ((size_t)(s * NSEGP) * D + ch) * 2;
                float Pv[NSEGP], Ev[NSEGP];
#pragma unroll
                for (int sg = 0; sg < NSEGP; ++sg) { Pv[sg] = __hip_atomic_load(ag0 + (size_t)sg * D * 2, __ATOMIC_RELAXED, __HIP_MEMORY_SCOPE_AGENT); Ev[sg] = __hip_atomic_load(ag0 + (size_t)sg * D * 2 + 1, __ATOMIC_RELAXED, __HIP_MEMORY_SCOPE_AGENT); }
                float c = 0.f;
#pragma unroll
                for (int sg = 0; sg < NSEGP; ++sg) { CARRY[(size_t)(s * NSEGP + sg) * D + ch] = c; c = Ev[sg] + Pv[sg] * c; }
                p.out[O_PLH + (size_t)s * D + ch] = c; }
        }
        asm volatile("s_waitcnt lgkmcnt(0)" ::: "memory");
    }
#undef LRU_LOADRAW
}

constexpr int ML_RS = 528, ML_VS = 144;
constexpr int ML_Q = 0, ML_K = 33792, ML_CT = 67584, ML_VT = 101376, ML_WV = 110592, ML_SW = 119808, ML_N = 129024, ML_GA = 130048, ML_QN = 131328, ML_DEN = 131584, ML_SC = 132096;
typedef short v4s __attribute__((ext_vector_type(4)));
__device__ __forceinline__ int vt_off(int R, int gi) { return R * ML_VS + ((gi ^ ((R >> 3) & 7)) << 4); }
__device__ __forceinline__ float scan_sum64(float x, int lane) {
#pragma unroll
    for (int o = 1; o < 64; o <<= 1) { const float t = __shfl_up(x, o); if (lane >= o) x += t; }
    return x;
}
__device__ __forceinline__ float scan_max64(float x, int lane) {
#pragma unroll
    for (int o = 1; o < 64; o <<= 1) { const float t = __shfl_up(x, o); if (lane >= o) x = fmaxf(x, t); }
    return x;
}
constexpr int ML_AL = 132160, ML_BL = ML_AL + 8448, ML_ML = ML_BL + 8448, ML_NT = ML_ML + 8448;
__device__ __forceinline__ void phase_mlstm(const P& p, LAS unsigned char* lds, int bid, int nb, int wv) {
    const int tid = opaque_tid(wv), lane = tid & 63, w = __builtin_amdgcn_readfirstlane(tid >> 6), g = lane >> 4, li = lane & 15;
    const bf16_t* Z = (const bf16_t*)(p.ws + WS_Z); bf16_t* ACAT = (bf16_t*)(p.ws + WS_ACAT); const float* gates = (const float*)(p.ws + WS_SMALL + 65536);
    LAS float* nL = (LAS float*)(lds + ML_N); LAS float* wkL = (LAS float*)(lds + ML_GA); LAS float* totL = wkL + 64; LAS float* cmxL = wkL + 128;
    LAS float* qnL = (LAS float*)(lds + ML_QN); LAS float* denL = (LAS float*)(lds + ML_DEN);
    LAS float* aL = (LAS float*)(lds + ML_AL); LAS float* BL = (LAS float*)(lds + ML_BL); LAS float* ML_ = (LAS float*)(lds + ML_ML);
    for (int it = bid; it < NBP * 16; it += nb) {
        const int lane = lane_id_volatile(), tid = w * 64 + lane, g = lane >> 4, li = lane & 15;
        const int sh = (it & 7) + 8 * (it >> 5), s = sh >> 2, hh = sh & 3, j = (it >> 3) & 3;
        int row0, L; seq_info(s, row0, L);
        const int nch = (L + 63) >> 6;
        const float m0 = 0.f;
        f32x4 cacc[2][4], nacc[2];
#pragma unroll
        for (int di = 0; di < 2; ++di) { nacc[di] = (f32x4){0.f, 0.f, 0.f, 0.f};
#pragma unroll
            for (int vi = 0; vi < 4; ++vi) cacc[di][vi] = (f32x4){0.f, 0.f, 0.f, 0.f}; }
        {
#pragma unroll 1
          for (int c = w; c < nch; c += 8) { const int t = c * 64 + lane; const bool valid = t < L; const float* gr = gates + (size_t)(row0 + t) * 8 + hh;
              const float lf = valid ? logsigmoidf_(gr[4]) : 0.f; const float sl = scan_sum64(lf, lane); aL[t] = valid ? gr[0] : -INFINITY; BL[t] = sl; if (lane == 63) totL[c] = sl; }
          __syncthreads();
          { const float x = (lane < nch) ? totL[lane] : 0.f; const float inc = scan_sum64(x, lane);
#pragma unroll 1
            for (int c = w; c < nch; c += 8) { const int t = c * 64 + lane; const float boff = (c > 0) ? __shfl(inc, c - 1) : 0.f; const float Bt = boff + BL[t]; const float a = aL[t] - Bt;
                const float ml = scan_max64(a, lane); aL[t] = a; BL[t] = Bt; ML_[t] = ml; if (lane == 63) cmxL[c] = ml; } }
          __syncthreads();
          { const float x = (lane < nch) ? cmxL[lane] : -INFINITY; const float pm = scan_max64(x, lane);
#pragma unroll 1
            for (int c = w; c < nch; c += 8) { const int t = c * 64 + lane; const float mp = (c > 0) ? fmaxf(m0, __shfl(pm, c - 1)) : m0; ML_[t] = fmaxf(mp, ML_[t]); } }
        }
        u32x4 pq[4], pk[4], pv;
#define ML_LOAD(t0_) do { const int t0__ = (t0_); \
            _Pragma("unroll") for (int i = 0; i < 4; ++i) { const int id = tid + 512 * i, rr = id >> 5, ch = id & 31; const bf16_t* zr = Z + (size_t)(row0 + t0__ + rr) * NZ + hh * DH + ch * 8; \
                pq[i] = *(const u32x4*)(zr + ZC_Q); pk[i] = *(const u32x4*)(zr + ZC_K); } \
            { const int rr = tid >> 3, ch = tid & 7; pv = *(const u32x4*)(Z + (size_t)(row0 + t0__ + rr) * NZ + ZC_V + hh * DH + j * 64 + ch * 8); } } while (0)
        ML_LOAD(0);
        for (int c = 0; c < nch; ++c) {
            const int t0 = c * 64;
            int tid_c = tid; asm volatile("" : "+v"(tid_c));
            const int tid = tid_c, lane = tid & 63, g = lane >> 4, li = lane & 15;
#pragma unroll
            for (int i = 0; i < 4; ++i) { const int id = tid + 512 * i, rr = id >> 5, ch = id & 31;
                *(LAS u32x4*)(lds + ML_Q + rr * ML_RS + ch * 16) = pq[i]; *(LAS u32x4*)(lds + ML_K + rr * ML_RS + ch * 16) = pk[i]; }
            { const int rr = tid >> 3, ch = tid & 7; const unsigned vw[4] = {pv.x, pv.y, pv.z, pv.w};
#pragma unroll
                for (int q = 0; q < 4; ++q) { *(LAS unsigned short*)(lds + ML_VT + vt_off(ch * 8 + 2 * q, rr >> 3) + (rr & 7) * 2) = (unsigned short)(vw[q] & 0xffffu);
                                              *(LAS unsigned short*)(lds + ML_VT + vt_off(ch * 8 + 2 * q + 1, rr >> 3) + (rr & 7) * 2) = (unsigned short)(vw[q] >> 16); } }
#pragma unroll
            for (int di = 0; di < 2; ++di) {
#pragma unroll
                for (int vi = 0; vi < 4; ++vi) { u32x2 cw; cw.x = pk2(cacc[di][vi][0], cacc[di][vi][1]); cw.y = pk2(cacc[di][vi][2], cacc[di][vi][3]);
                    *(LAS u32x2*)(lds + ML_CT + (16 * vi + li) * ML_RS + (32 * w + 16 * di + 4 * g) * 2) = cw; }
                if (li == 0) { u32x2 nw; nw.x = pk2(nacc[di][0], nacc[di][1]); nw.y = pk2(nacc[di][2], nacc[di][3]); *(LAS u32x2*)(lds + ML_NT + (32 * w + 16 * di + 4 * g) * 2) = nw; } }
            __syncthreads();
            if (c + 1 < nch) ML_LOAD(t0 + 64);
            const float Mprev = (c > 0) ? ML_[t0 - 1] : m0, MT = ML_[t0 + 63];
            bf16x8 qf[8];
            { const int ti = w >> 1, si0 = 2 * (w & 1); const bool need0 = si0 <= ti, need1 = si0 + 1 <= ti, needn = (w & 1) == 0;
              f32x4 a0 = {0.f, 0.f, 0.f, 0.f}, a1 = {0.f, 0.f, 0.f, 0.f}, aN = {0.f, 0.f, 0.f, 0.f};
              bf16x8 kf[8], nf[8];
#pragma unroll
              for (int k = 0; k < 8; ++k) qf[k] = *(const LAS bf16x8*)(lds + ML_Q + (16 * ti + li) * ML_RS + (32 * k + 8 * g) * 2);
              if (need0) {
#pragma unroll
                  for (int k = 0; k < 8; ++k) kf[k] = *(const LAS bf16x8*)(lds + ML_K + (16 * si0 + li) * ML_RS + (32 * k + 8 * g) * 2); }
              if (needn) {
#pragma unroll
                  for (int k = 0; k < 8; ++k) { const u32x4 t = *(const LAS u32x4*)(lds + ML_NT + (32 * k + 8 * g) * 2); nf[k] = __builtin_bit_cast(bf16x8, (li == 0) ? t : (u32x4){0u, 0u, 0u, 0u}); } }
              __builtin_amdgcn_sched_barrier(0);
              if (need0) {
#pragma unroll
                  for (int k = 0; k < 8; ++k) a0 = __builtin_amdgcn_mfma_f32_16x16x32_bf16(kf[k], qf[k], a0, 0, 0, 0); }
              __builtin_amdgcn_sched_barrier(0);
              if (need1) {
#pragma unroll
                  for (int k = 0; k < 8; ++k) kf[k] = *(const LAS bf16x8*)(lds + ML_K + (16 * si0 + 16 + li) * ML_RS + (32 * k + 8 * g) * 2); }
              if (needn) {
#pragma unroll
                  for (int k = 0; k < 8; ++k) aN = __builtin_amdgcn_mfma_f32_16x16x32_bf16(nf[k], qf[k], aN, 0, 0, 0);
                  if (g == 0) qnL[16 * ti + li] = aN[0]; }
              __builtin_amdgcn_sched_barrier(0);
              if (need1) {
#pragma unroll
                  for (int k = 0; k < 8; ++k) a1 = __builtin_amdgcn_mfma_f32_16x16x32_bf16(kf[k], qf[k], a1, 0, 0, 0); }
              const int tau = 16 * ti + li; const float Mt = ML_[t0 + tau]; float dsum = 0.f;
#pragma unroll
              for (int x = 0; x < 2; ++x) { const f32x4 acc = x ? a1 : a0; const int sb = 16 * (si0 + x) + 4 * g; const f32x4 as = *(const LAS f32x4*)(aL + t0 + sb); float v[4];
#pragma unroll
                  for (int r = 0; r < 4; ++r) { const float wgt = (sb + r <= tau) ? __expf(as[r] - Mt) : 0.f; v[r] = acc[r] * wgt; dsum += v[r]; }
                  u32x2 sw; sw.x = pk2(v[0], v[1]); sw.y = pk2(v[2], v[3]);
                  *(LAS u32x2*)(lds + ML_SW + tau * ML_VS + sb * 2) = sw; }
              dsum += __shfl_xor(dsum, 16); dsum += __shfl_xor(dsum, 32);
              if (g == 0) denL[tau * 2 + (w & 1)] = dsum; }
            { const int dv0 = tid >> 4, sp = tid & 15; const f32x4 as = *(const LAS f32x4*)(aL + t0 + 4 * sp);
              const f32x4 wk = {__expf(as.x - MT), __expf(as.y - MT), __expf(as.z - MT), __expf(as.w - MT)};
              if (dv0 == 0) *(LAS f32x4*)(wkL + 4 * sp) = wk;
#pragma unroll
              for (int x = 0; x < 2; ++x) { const int dv = dv0 + 32 * x; const u32x2 vv = *(const LAS u32x2*)(lds + ML_VT + vt_off(dv, sp >> 1) + (sp & 1) * 8);
                  u32x2 o; o.x = pk2(bflo(vv.x) * wk.x, bfhi(vv.x) * wk.y); o.y = pk2(bflo(vv.y) * wk.z, bfhi(vv.y) * wk.w);
                  *(LAS u32x2*)(lds + ML_WV + dv * ML_VS + sp * 8) = o; } }
            __syncthreads();
            { const int ti = w >> 1;
              bf16x8 sf[2];
#pragma unroll
              for (int k = 0; k < 2; ++k) sf[k] = *(const LAS bf16x8*)(lds + ML_SW + (16 * ti + li) * ML_VS + (32 * k + 8 * g) * 2);
#pragma unroll
              for (int x = 0; x < 2; ++x) { const int vi = (w & 1) + 2 * x; f32x4 acc = {0.f, 0.f, 0.f, 0.f}, acc2 = {0.f, 0.f, 0.f, 0.f};
              bf16x8 cf[8], vf[2];
#pragma unroll
              for (int k = 0; k < 8; ++k) cf[k] = *(const LAS bf16x8*)(lds + ML_CT + (16 * vi + li) * ML_RS + (32 * k + 8 * g) * 2);
#pragma unroll
              for (int k = 0; k < 2; ++k) vf[k] = *(const LAS bf16x8*)(lds + ML_VT + vt_off(16 * vi + li, 4 * k + g));
              const int tau = 16 * ti + li; const float Mt = ML_[t0 + tau], Bt = BL[t0 + tau], qn = qnL[tau]; const float d0 = denL[tau * 2], d1 = denL[tau * 2 + 1];
              __builtin_amdgcn_sched_barrier(0);
#pragma unroll
              for (int k = 0; k < 8; ++k) acc = __builtin_amdgcn_mfma_f32_16x16x32_bf16(cf[k], qf[k], acc, 0, 0, 0);
#pragma unroll
              for (int k = 0; k < 2; ++k) acc2 = __builtin_amdgcn_mfma_f32_16x16x32_bf16(vf[k], sf[k], acc2, 0, 0, 0);
              const float ei = __expf(Mprev - Mt);
              acc = acc * ei + acc2;
              const float den = d0 + d1 + ei * qn;
              const float inv = __builtin_amdgcn_rcpf(fmaxf(fabsf(den), __expf(-(Bt + Mt))));
              acc = acc * inv;
              if (t0 + tau < L) { u32x2 hw; hw.x = pk2(acc[0], acc[1]); hw.y = pk2(acc[2], acc[3]); *(u32x2*)(ACAT + (size_t)(row0 + t0 + tau) * 2048 + 1024 + hh * DH + j * 64 + 16 * vi + 4 * g) = hw; } } }
            { const float decay = __expf(Mprev - MT);
#pragma unroll
              for (int di = 0; di < 2; ++di) { nacc[di] = nacc[di] * decay;
#pragma unroll
                  for (int vi = 0; vi < 4; ++vi) cacc[di][vi] = cacc[di][vi] * decay; }
              const int q = li >> 2, pp = li & 3;
              bf16x8 ak[2][2], bw[2][4], bnf[2];
#pragma unroll
              for (int k = 0; k < 2; ++k) {
#pragma unroll
                  for (int di = 0; di < 2; ++di) {
                      const v4s lo = __builtin_amdgcn_ds_read_tr16_b64_v4i16((LAS v4s*)(lds + ML_K + (32 * k + 8 * g + q) * ML_RS + (32 * w + 16 * di + 4 * pp) * 2));
                      const v4s hi = __builtin_amdgcn_ds_read_tr16_b64_v4i16((LAS v4s*)(lds + ML_K + (32 * k + 8 * g + 4 + q) * ML_RS + (32 * w + 16 * di + 4 * pp) * 2));
                      ak[k][di] = (bf16x8){lo.x, lo.y, lo.z, lo.w, hi.x, hi.y, hi.z, hi.w}; }
#pragma unroll
                  for (int vi = 0; vi < 4; ++vi) bw[k][vi] = *(const LAS bf16x8*)(lds + ML_WV + (16 * vi + li) * ML_VS + (32 * k + 8 * g) * 2);
                  { const f32x4 w0 = *(const LAS f32x4*)(wkL + 32 * k + 8 * g), w1 = *(const LAS f32x4*)(wkL + 32 * k + 8 * g + 4);
                    u32x4 bn; bn.x = pk2(w0.x, w0.y); bn.y = pk2(w0.z, w0.w); bn.z = pk2(w1.x, w1.y); bn.w = pk2(w1.z, w1.w);
                    if (li != 0) bn = (u32x4){0u, 0u, 0u, 0u};
                    bnf[k] = __builtin_bit_cast(bf16x8, bn); } }
              __builtin_amdgcn_sched_barrier(0);
#pragma unroll
              for (int k = 0; k < 2; ++k) {
#pragma unroll
                  for (int vi = 0; vi < 4; ++vi)
#pragma unroll
                      for (int di = 0; di < 2; ++di) cacc[di][vi] = __builtin_amdgcn_mfma_f32_16x16x32_bf16(ak[k][di], bw[k][vi], cacc[di][vi], 0, 0, 0);
#pragma unroll
                  for (int di = 0; di < 2; ++di) nacc[di] = __builtin_amdgcn_mfma_f32_16x16x32_bf16(ak[k][di], bnf[k], nacc[di], 0, 0, 0); } }
            __syncthreads();
        }
#undef ML_LOAD
        { const int lane = lane_id_volatile(), g = lane >> 4, li = lane & 15;
          float* oC = p.out + O_PC + ((size_t)s * NH + hh) * DH * DH; float* oN = p.out + O_PN + ((size_t)s * NH + hh) * DH; float* oM = p.out + O_PM + (size_t)s * NH + hh;
#pragma unroll
          for (int di = 0; di < 2; ++di)
#pragma unroll
              for (int vi = 0; vi < 4; ++vi)
#pragma unroll
                  for (int r = 0; r < 4; ++r) oC[(size_t)(32 * w + 16 * di + 4 * g + r) * DH + j * 64 + 16 * vi + li] = cacc[di][vi][r];
          if (j == 0 && li == 0) {
#pragma unroll
              for (int di = 0; di < 2; ++di) *(f32x4*)(oN + 32 * w + 16 * di + 4 * g) = nacc[di]; }
          if (j == 0 && w == 0 && lane == 0) oM[0] = BL[L - 1] + ML_[L - 1]; }
        __syncthreads();
    }
}

constexpr int MS_NP = 0, MS_QF = 0, MS_KF = 8192, MS_QT = 32768, MS_WT = 40960, MS_SS = 49152, MS_HALF = 65536;
__device__ __forceinline__ void mlstm_sample(const P& p, LAS unsigned char* lds, int bid, int nb, int wv) {
    const int tid = opaque_tid(wv), half = tid >> 8, lt = tid & 255, lane = tid & 63, wq = (tid >> 6) & 3;
    const bf16_t* Z = (const bf16_t*)(p.ws + WS_Z); bf16_t* ACAT = (bf16_t*)(p.ws + WS_ACAT); const float* gates = (const float*)(p.ws + WS_SMALL + 65536);
    LAS unsigned char* hb = lds + half * MS_HALF;
    LAS float* NP = (LAS float*)(hb + MS_NP); LAS float* QF = (LAS float*)(hb + MS_QF); LAS float* KF = (LAS float*)(hb + MS_KF); LAS float* QT = (LAS float*)(hb + MS_QT); LAS float* WT = (LAS float*)(hb + MS_WT); LAS float* SS = (LAS float*)(hb + MS_SS);
    for (int pp = bid; pp < DECB * NH / 2; pp += nb) {
        const int pr = pp * 2 + half, b = pr >> 2, hh = pr & 3; const int rowb = MP + b * DECS;
        const float* C0 = p.in[I_SC] + (size_t)pr * DH * DH; float* OC = p.out + O_SC + (size_t)pr * DH * DH;
        float aG[8], MtG[8], BtG[8], wk[8]; const float m0 = p.in[I_SM][pr];
        { float Bc = 0.f, Mc = m0;
#pragma unroll
          for (int t = 0; t < 8; ++t) { const float* gr = gates + (size_t)(rowb + t) * 8 + hh; const float ig = gr[0], lf = logsigmoidf_(gr[4]); Bc += lf; BtG[t] = Bc; aG[t] = ig - Bc; Mc = fmaxf(Mc, aG[t]); MtG[t] = Mc; } }
        const float MT = MtG[7], decay = __expf(m0 - MT);
#pragma unroll
        for (int t = 0; t < 8; ++t) wk[t] = __expf(aG[t] - MT);
        { float kq[8], kk[8]; const bf16_t* zr = Z + (size_t)rowb * NZ + hh * DH + lt;
#pragma unroll
          for (int t = 0; t < 8; ++t) { kq[t] = bf2f(zr[(size_t)t * NZ + ZC_Q]); kk[t] = bf2f(zr[(size_t)t * NZ + ZC_K]); QF[t * 256 + lt] = kq[t]; KF[t * 256 + lt] = kk[t]; }
          const float n0 = p.in[I_SN][(size_t)pr * DH + lt]; KF[8 * 256 + lt] = n0;
          *(LAS f32x4*)(QT + lt * 8) = (f32x4){kq[0], kq[1], kq[2], kq[3]}; *(LAS f32x4*)(QT + lt * 8 + 4) = (f32x4){kq[4], kq[5], kq[6], kq[7]};
          float nn = decay * n0;
#pragma unroll
          for (int t = 0; t < 8; ++t) { kk[t] *= wk[t]; nn += kk[t]; }
          *(LAS f32x4*)(WT + lt * 8) = (f32x4){kk[0], kk[1], kk[2], kk[3]}; *(LAS f32x4*)(WT + lt * 8 + 4) = (f32x4){kk[4], kk[5], kk[6], kk[7]};
          p.out[O_SN + (size_t)pr * DH + lt] = nn;
          if (lt == 0) { p.out[O_SM + pr] = BtG[7] + MT;
#pragma unroll
              for (int t = 0; t < 8; ++t) { SS[80 + t] = aG[t]; SS[88 + t] = MtG[t]; SS[96 + t] = BtG[t]; } } }
        f32x4 vv[8];
#pragma unroll
        for (int t = 0; t < 8; ++t) { const u32x2 w = *(const u32x2*)(Z + (size_t)(rowb + t) * NZ + ZC_V + hh * DH + 4 * lane); vv[t] = (f32x4){bflo(w.x), bfhi(w.x), bflo(w.y), bfhi(w.y)}; }
        const f32x4* cp = (const f32x4*)(C0 + (size_t)(64 * wq) * DH) + lane; f32x4* op = (f32x4*)(OC + (size_t)(64 * wq) * DH) + lane;
        f32x4 cr[4];
#pragma unroll
        for (int i = 0; i < 4; ++i) cr[i] = __builtin_nontemporal_load(cp + i * 64);
        __syncthreads();
        if (lt < 144) { const int pair = lt >> 1, part = lt & 1, t = pair / 9, sp = pair - 9 * t; float acc = 0.f;
#pragma unroll 8
            for (int i = 0; i < 32; ++i) { const f32x4 a = *(const LAS f32x4*)(QF + t * 256 + part * 128 + 4 * i), bq = *(const LAS f32x4*)(KF + sp * 256 + part * 128 + 4 * i); acc += (a.x * bq.x + a.y * bq.y) + (a.z * bq.z + a.w * bq.w); }
            acc += __shfl_xor(acc, 1);
            if (part == 0) SS[pair] = acc; }
        __syncthreads();
        f32x4 num[8];
#pragma unroll
        for (int t = 0; t < 8; ++t) num[t] = (f32x4){0.f, 0.f, 0.f, 0.f};
        const LAS float* qtp = QT + 64 * wq * 8; const LAS float* wtp = WT + 64 * wq * 8;
#pragma unroll 1
        for (int rb = 0; rb < 64; rb += 4) {
            f32x4 cn[4];
            cp += 4 * 64;
            if (rb + 4 < 64) {
#pragma unroll
                for (int i = 0; i < 4; ++i) cn[i] = __builtin_nontemporal_load(cp + i * 64); }
#pragma unroll
            for (int i = 0; i < 4; ++i) {
                const f32x4 q0 = *(const LAS f32x4*)(qtp + i * 8), q1 = *(const LAS f32x4*)(qtp + i * 8 + 4), w0 = *(const LAS f32x4*)(wtp + i * 8), w1 = *(const LAS f32x4*)(wtp + i * 8 + 4);
                const f32x4 c = cr[i];
                num[0] += q0.x * c; num[1] += q0.y * c; num[2] += q0.z * c; num[3] += q0.w * c; num[4] += q1.x * c; num[5] += q1.y * c; num[6] += q1.z * c; num[7] += q1.w * c;
                f32x4 o = decay * c + w0.x * vv[0]; o += w0.y * vv[1]; o += w0.z * vv[2]; o += w0.w * vv[3]; o += w1.x * vv[4]; o += w1.y * vv[5]; o += w1.z * vv[6]; o += w1.w * vv[7];
                __builtin_nontemporal_store(o, op + i * 64); }
            op += 4 * 64; qtp += 32; wtp += 32;
            if (rb + 4 < 64) {
#pragma unroll
                for (int i = 0; i < 4; ++i) cr[i] = cn[i]; }
        }
#pragma unroll
        for (int t = 0; t < 8; ++t) *(LAS f32x4*)(NP + (wq * 8 + t) * 256 + 4 * lane) = num[t];
        __syncthreads();
        { const int t = lt >> 5, d8 = (lt & 31) * 8; float nc[8];
#pragma unroll
          for (int i = 0; i < 8; ++i) nc[i] = 0.f;
#pragma unroll
          for (int x = 0; x < 4; ++x) { const f32x4 a = *(const LAS f32x4*)(NP + (x * 8 + t) * 256 + d8), c2 = *(const LAS f32x4*)(NP + (x * 8 + t) * 256 + d8 + 4);
              nc[0] += a.x; nc[1] += a.y; nc[2] += a.z; nc[3] += a.w; nc[4] += c2.x; nc[5] += c2.y; nc[6] += c2.z; nc[7] += c2.w; }
          const float Mt = SS[88 + t], Bt = SS[96 + t]; const float eint = __expf(m0 - Mt);
          float den = eint * SS[t * 9 + 8];
#pragma unroll
          for (int i = 0; i < 8; ++i) nc[i] *= eint;
#pragma unroll
          for (int sI = 0; sI < 8; ++sI) { const float sw = (sI <= t) ? SS[t * 9 + sI] * __expf(SS[80 + sI] - Mt) : 0.f; den += sw;
              float v8[8]; unpack8(*(const u32x4*)(Z + (size_t)(rowb + sI) * NZ + ZC_V + hh * DH + d8), v8);
#pragma unroll
              for (int i = 0; i < 8; ++i) nc[i] += sw * v8[i]; }
          const float dinv = 1.0f / fmaxf(fabsf(den), __expf(-(Bt + Mt)));
          u32x4 w; w.x = pk2(nc[0] * dinv, nc[1] * dinv); w.y = pk2(nc[2] * dinv, nc[3] * dinv); w.z = pk2(nc[4] * dinv, nc[5] * dinv); w.w = pk2(nc[6] * dinv, nc[7] * dinv);
          *(u32x4*)(ACAT + (size_t)(rowb + t) * 2048 + 1024 + hh * DH + d8) = w; }
        __syncthreads();
    }
}

__device__ __forceinline__ void phase_headnorm(const P& p, int bid, int nb, int wv) {
    const int tid = opaque_tid(wv), lane = tid & 63, wave = tid >> 6;
    const bf16_t* Z = (const bf16_t*)(p.ws + WS_Z); bf16_t* ACAT = (bf16_t*)(p.ws + WS_ACAT); const float* hg = p.in[I_HG];
    const bf16_t* PCUM = (const bf16_t*)(p.ws + WS_PCUM); const float* CARRY = (const float*)(p.ws + WS_CARRY);
    f32x4 gg[4];
#pragma unroll
    for (int j = 0; j < 4; ++j) gg[j] = ((const f32x4*)hg)[lane + 64 * j];
    for (int m = wave * nb + bid; m < MTOK; m += nb * 8) {
        u32x2* ap = (u32x2*)(ACAT + (size_t)m * 2048) + lane; u32x2* hp = ap + 256; const unsigned* op = (const unsigned*)((const unsigned char*)Z + (size_t)m * ZG_PITCH + ZG_OFF) + lane;
        bool fix = false; int sq = 0, seg = 0;
        if (m < MP) { sq = m / LP; seg = (m - sq * LP) >> 6; fix = seg > 0; }
        u32x2 hv[4], av[4]; unsigned ov[4], pv[4]; f32x4 cv[4];
#pragma unroll
        for (int j = 0; j < 4; ++j) { hv[j] = hp[64 * j]; ov[j] = op[64 * j]; }
        if (fix) { const unsigned* pp = (const unsigned*)((const unsigned char*)PCUM + (size_t)m * D) + lane; const f32x4* cp = (const f32x4*)(CARRY + (size_t)(sq * NSEGP + seg) * D) + lane;
#pragma unroll
            for (int j = 0; j < 4; ++j) { av[j] = ap[64 * j]; pv[j] = pp[64 * j]; cv[j] = cp[64 * j]; } }
        if (fix) {
#pragma unroll
            for (int j = 0; j < 4; ++j) { const f32x4 c = cv[j] * (1.0f / 255.0f); u32x2 o; o.x = pk2(bflo(av[j].x) + ub0(pv[j]) * c.x, bfhi(av[j].x) + ub1(pv[j]) * c.y); o.y = pk2(bflo(av[j].y) + ub2(pv[j]) * c.z, bfhi(av[j].y) + ub3(pv[j]) * c.w); ap[64 * j] = o; } }
#pragma unroll
        for (int j = 0; j < 4; ++j) {
            float v0 = bflo(hv[j].x), v1 = bfhi(hv[j].x), v2 = bflo(hv[j].y), v3 = bfhi(hv[j].y);
            const float ssq = wave_sum((v0 * v0 + v1 * v1) + (v2 * v2 + v3 * v3));
            const float rstd = 1.0f / sqrtf(ssq * (1.0f / DH) + EPS);
            const float rq = rstd * (1.0f / 255.0f);
            v0 = v0 * rq * gg[j].x * ub0(ov[j]); v1 = v1 * rq * gg[j].y * ub1(ov[j]); v2 = v2 * rq * gg[j].z * ub2(ov[j]); v3 = v3 * rq * gg[j].w * ub3(ov[j]);
            u32x2 o; o.x = pk2(v0, v1); o.y = pk2(v2, v3); hp[64 * j] = o; }
    }
}

__device__ __forceinline__ void phase_norm2(const P& p, int bid, int nb, int wv) {
    const int tid = opaque_tid(wv), lane = tid & 63, wave = tid >> 6;
    const float* X1 = (const float*)(p.ws + WS_X1); bf16_t* XN = (bf16_t*)(p.ws + WS_XN);
    for (int m = wave * nb + bid; m < MTOK; m += nb * 8) {
        const f32x4* xr = (const f32x4*)(X1 + (size_t)m * D) + lane; f32x4 v[4]; float s = 0.f;
#pragma unroll
        for (int j = 0; j < 4; ++j) { v[j] = xr[64 * j]; s += (v[j].x * v[j].x + v[j].y * v[j].y) + (v[j].z * v[j].z + v[j].w * v[j].w); }
        const float rstd = 1.0f / sqrtf(wave_sum(s) * (1.0f / D) + EPS);
        unsigned long long* o8 = (unsigned long long*)(XN + (size_t)m * D) + lane;
#pragma unroll
        for (int j = 0; j < 4; ++j) { v[j] = v[j] * rstd; o8[64 * j] = (unsigned long long)pk2(v[j].x, v[j].y) | ((unsigned long long)pk2(v[j].z, v[j].w) << 32); }
    }
}

__device__ __forceinline__ float gelu_tanh(float x) { const float u2 = -1.5957691216057308f * (x + 0.044715f * x * x * x); return x * __builtin_amdgcn_rcpf(1.0f + __expf(u2)); }
__device__ __forceinline__ void phase_convffn(const P& p, int bid, int nb, int wv) {
    const int gid = bid * NTHREADS + opaque_tid(wv), nruns = (nb * NTHREADS) / (DFF / 8);
    const int run = gid / (DFF / 8), c0 = (gid - run * (DFF / 8)) * 8;
    if (run >= nruns) return;
    const int rpr = (MTOK + nruns - 1) / nruns, r0 = run * rpr, r1 = (r0 + rpr < MTOK) ? r0 + rpr : MTOK;
    if (r0 >= r1) return;
    const bf16_t* __restrict__ UP = (const bf16_t*)(p.ws + WS_Z); bf16_t* __restrict__ HMID = (bf16_t*)(p.ws + WS_ACAT);
    const float* __restrict__ cw = p.in[I_FCW]; const float* __restrict__ cbv = p.in[I_FCB]; const float* __restrict__ sf = p.in[I_SF]; float* __restrict__ out = p.out;
    float wvt[3][8], wg[3][8], bv[8], bg[8];
#pragma unroll
    for (int q = 0; q < 8; ++q) { bv[q] = cbv[c0 + q]; bg[q] = cbv[DFF + c0 + q];
#pragma unroll
        for (int jx = 0; jx < 3; ++jx) { wvt[jx][q] = cw[(size_t)jx * NUP + c0 + q]; wg[jx][q] = cw[(size_t)jx * NUP + DFF + c0 + q]; } }
    int s, t, L, row0;
    if (r0 < MP) s = r0 / LP; else s = NBP + (r0 - MP) / DECS;
    seq_info(s, row0, L); t = r0 - row0;
    float x0v[8], x1v[8], x0g[8], x1g[8];
#pragma unroll
    for (int q = 0; q < 8; ++q) { x0v[q] = 0.f; x1v[q] = 0.f; x0g[q] = 0.f; x1g[q] = 0.f; }
    if (t >= 1) { unpack8(*(const u32x4*)(UP + (size_t)(r0 - 1) * NUP + c0), x1v); unpack8(*(const u32x4*)(UP + (size_t)(r0 - 1) * NUP + DFF + c0), x1g); }
    if (t >= 2) { unpack8(*(const u32x4*)(UP + (size_t)(r0 - 2) * NUP + c0), x0v); unpack8(*(const u32x4*)(UP + (size_t)(r0 - 2) * NUP + DFF + c0), x0g); }
    else if (t == 1 && s >= NBP) { const float* b1 = sf + ((size_t)(s - NBP) * 2 + 1) * NUP;
#pragma unroll
        for (int q = 0; q < 8; ++q) { x0v[q] = b1[c0 + q]; x0g[q] = b1[DFF + c0 + q]; } }
    u32x4 nv[4], ng[4];
#pragma unroll
    for (int i = 0; i < 4; ++i) { const int rr = (r0 + i < r1) ? r0 + i : r1 - 1; nv[i] = *(const u32x4*)(UP + (size_t)rr * NUP + c0); ng[i] = *(const u32x4*)(UP + (size_t)rr * NUP + DFF + c0); }
    for (int rb = r0; rb < r1; rb += 4) {
        u32x4 lv[4], lg[4];
#pragma unroll
        for (int i = 0; i < 4; ++i) { lv[i] = nv[i]; lg[i] = ng[i]; }
        if (rb + 4 < r1) {
#pragma unroll
            for (int i = 0; i < 4; ++i) { const int rr = (rb + 4 + i < r1) ? rb + 4 + i : r1 - 1; nv[i] = *(const u32x4*)(UP + (size_t)rr * NUP + c0); ng[i] = *(const u32x4*)(UP + (size_t)rr * NUP + DFF + c0); } }
#pragma unroll
        for (int i = 0; i < 4; ++i) { const int r = rb + i;
            if (r < r1) {
                if (t == 0) {
                    if (s >= NBP) { const float* b0 = sf + (size_t)(s - NBP) * 2 * NUP; const float* b1 = b0 + NUP;
#pragma unroll
                        for (int q = 0; q < 8; ++q) { x0v[q] = b0[c0 + q]; x0g[q] = b0[DFF + c0 + q]; x1v[q] = b1[c0 + q]; x1g[q] = b1[DFF + c0 + q]; } }
                    else {
#pragma unroll
                        for (int q = 0; q < 8; ++q) { x0v[q] = 0.f; x0g[q] = 0.f; x1v[q] = 0.f; x1g[q] = 0.f; } } }
                float x2v[8], x2g[8], o[8]; unpack8(lv[i], x2v); unpack8(lg[i], x2g);
#pragma unroll
                for (int q = 0; q < 8; ++q) { const float val = bv[q] + wvt[0][q] * x0v[q] + wvt[1][q] * x1v[q] + wvt[2][q] * x2v[q]; const float gt = bg[q] + wg[0][q] * x0g[q] + wg[1][q] * x1g[q] + wg[2][q] * x2g[q];
                    o[q] = gelu_tanh(gt) * val; }
                u32x4 w; w.x = pk2(o[0], o[1]); w.y = pk2(o[2], o[3]); w.z = pk2(o[4], o[5]); w.w = pk2(o[6], o[7]);
                *(u32x4*)(HMID + (size_t)r * DFF + c0) = w;
                if (t >= L - 2) {
                    float* of = (s < NBP ? out + O_PF + (size_t)s * 2 * NUP : out + O_SF + (size_t)(s - NBP) * 2 * NUP) + (size_t)(t - (L - 2)) * NUP;
                    *(f32x4*)(of + c0) = (f32x4){x2v[0], x2v[1], x2v[2], x2v[3]}; *(f32x4*)(of + c0 + 4) = (f32x4){x2v[4], x2v[5], x2v[6], x2v[7]};
                    *(f32x4*)(of + DFF + c0) = (f32x4){x2g[0], x2g[1], x2g[2], x2g[3]}; *(f32x4*)(of + DFF + c0 + 4) = (f32x4){x2g[4], x2g[5], x2g[6], x2g[7]}; }
#pragma unroll
                for (int q = 0; q < 8; ++q) { x0v[q] = x1v[q]; x1v[q] = x2v[q]; x0g[q] = x1g[q]; x1g[q] = x2g[q]; }
                if (++t == L) { ++s; t = 0; seq_info(s, row0, L); }
            } }
    }
}

__device__ __forceinline__ void phase_final(const P& p, LAS unsigned char* lds, int bid, int nb, int wv) {
    const int tid = opaque_tid(wv), lane = tid & 63, wave = tid >> 6;
    const bf16_t* X2B = (const bf16_t*)(p.ws + WS_X1); const bf16_t* X1B = (const bf16_t*)(p.ws + WS_XN); const float* gf = p.in[I_GF]; const float* PART = (const float*)(p.ws + WS_Z);
    LAS int* tailmap = (LAS int*)lds;
    constexpr int DS = 11;
    for (int i = tid; i < (MPAD / 256) * 4; i += NTHREADS) tailmap[i] = -1;
    __syncthreads();
    { pg8::SplitTailOrder S; S.init(MPAD, D, DFF, nb, 0); const int R = (nb == 256) ? S.nwg - nb : 0;
      if (tid < R) { pg8::Unit u; pg8::StaticOrder t = S; t.c = tid; if (t.next(1, u)) tailmap[u.pm * 4 + u.pn] = tid; } }
    __syncthreads();
    constexpr int FU = 3;
    for (int m0 = wave * nb + bid; m0 < MTOK; m0 += nb * 8 * FU) {
        float* o[FU]; bool ok[FU]; f32x4 v[FU][4]; int tix[FU][4];
#pragma unroll
        for (int u = 0; u < FU; ++u) { const int m = m0 + u * nb * 8; ok[u] = m < MTOK; o[u] = p.out;
            if (ok[u]) { if (m < MP) { const int b = m / LP, t = m - b * LP; if (t < NMETA) ok[u] = false; else o[u] = p.out + O_YP + ((size_t)b * SEQ + (t - NMETA)) * D; }
                         else o[u] = p.out + O_YS + (size_t)(m - MP) * D; }
#pragma unroll
            for (int j = 0; j < 4; ++j) { tix[u][j] = ok[u] ? tailmap[(m >> 8) * 4 + j] : -1;
                u32x2 xw = {0u, 0u}; if (ok[u]) xw = *((const u32x2*)((tix[u][j] >= 0 ? X1B : X2B) + (size_t)m * D) + lane + 64 * j);
                v[u][j] = (f32x4){bflo(xw.x), bfhi(xw.x), bflo(xw.y), bfhi(xw.y)}; } }
#pragma unroll
        for (int u = 0; u < FU; ++u) { const int m = m0 + u * nb * 8; float s = 0.f;
            if (!ok[u]) continue;
#pragma unroll
            for (int j = 0; j < 4; ++j) {
                const int ti = tix[u][j];
                if (ti >= 0) { const u32x2* pp = (const u32x2*)((const bf16_t*)PART + (size_t)(ti * DS) * 65536 + (size_t)(m & 255) * 256) + lane;
#pragma unroll
                    for (int sl = 0; sl < DS; ++sl) { const u32x2 pw = pp[(size_t)sl * 16384]; v[u][j] += (f32x4){bflo(pw.x), bfhi(pw.x), bflo(pw.y), bfhi(pw.y)}; } }
                s += (v[u][j].x * v[u][j].x + v[u][j].y * v[u][j].y) + (v[u][j].z * v[u][j].z + v[u][j].w * v[u][j].w); }
            const float rstd = 1.0f / sqrtf(wave_sum(s) * (1.0f / D) + EPS);
#pragma unroll
            for (int j = 0; j < 4; ++j) __builtin_nontemporal_store(v[u][j] * rstd * ((const f32x4*)gf)[lane + 64 * j], (f32x4*)o[u] + lane + 64 * j); }
    }
}

__device__ __forceinline__ void late_transposes(const P& p, LAS unsigned char* lds, int gw, int NGW, int wv) {
    const int lane = lane_id_volatile(); unsigned char* ws = p.ws;
    LAS float* scr = (LAS float*)(lds + wv * 8448);
    constexpr int I_SQ = 16 * 32, I_UP = 16 * 176, I_DN = 44 * 32, NITEMS = 3 * I_SQ + I_UP + I_DN;
    for (int it = gw; it < NITEMS; it += NGW) {
        int r = it;
        if (r < I_SQ) { tr_item(p.in[I_WA], 1024, (r / 32) * 64, (r % 32) * 32, (bf16_t*)(ws + WS_WCAT), 2048, (r % 32) * 32, 0, nullptr, 1.f, scr, lane); continue; } r -= I_SQ;
        if (r < I_SQ) { tr_item(p.in[I_WB], 1024, (r / 32) * 64, (r % 32) * 32, (bf16_t*)(ws + WS_WCAT), 2048, (r % 32) * 32, 1024, nullptr, 1.f, scr, lane); continue; } r -= I_SQ;
        if (r < I_SQ) { tr_item(p.in[I_WOUT], 1024, (r / 32) * 64, (r % 32) * 32, (bf16_t*)(ws + WS_WOUT), 1024, (r % 32) * 32, 0, nullptr, 1.f, scr, lane); continue; } r -= I_SQ;
        if (r < I_UP) { const int n0 = (r % 176) * 32, ns0 = ((n0 >> 7) & 1) * DFF + (n0 >> 8) * 128 + (n0 & 127);
            tr_item(p.in[I_WUP], NUP, (r / 176) * 64, ns0, (bf16_t*)(ws + WS_WUP), 1024, n0, 0, p.in[I_G2], 1.f, scr, lane); continue; } r -= I_UP;
        tr_item(p.in[I_WDOWN], 1024, (r / 32) * 64, (r % 32) * 32, (bf16_t*)(ws + WS_WDOWN), DFF, (r % 32) * 32, 0, nullptr, 1.f, scr, lane);
    }
}
__device__ __forceinline__ void phase_gemm1(const P& p, LAS unsigned char* lds, int bid, int nb, int wv) {
    pg8::Gemm g{(const bf16_t*)(p.ws + WS_XN), (const bf16_t*)(p.ws + WS_WIN), MPAD, NZ, D, 0}; pg8::StaticOrder S; S.init(MPAD, NZ, D, nb, bid);
    pg8::EpiBf16 E{(bf16_t*)(p.ws + WS_Z), NZ, (const float*)(p.ws + WS_SMALL), nullptr};
    pg8::gemm_phase<pg8::EpiBf16, pg8::StaticOrder, true, true>(lds, g, S, E, wv);
    { const int rem = S.nwg % nb, idle0 = (rem == 0) ? 0 : rem, nidle = nb - idle0;
      if (bid >= idle0) { late_transposes(p, lds, wv * nidle + (bid - idle0), nidle * 8, wv); } }
}
__device__ __forceinline__ void phase_gemm_merge(const P& p, LAS unsigned char* lds, int bid, int nb, int wv) {
    pg8::Gemm g{(const bf16_t*)(p.ws + WS_ACAT), (const bf16_t*)(p.ws + WS_WCAT), MPAD, D, 2048, 0}; pg8::SplitTailOrder S; S.init(MPAD, D, 2048, nb, bid); S.S = (nb == 256) ? 8 : 0;
    pg8::EpiMerge E{(bf16_t*)(p.ws + WS_MERGED), (const bf16_t*)(p.ws + WS_Z), (float*)(p.ws + WS_X1), (unsigned*)(p.ws + WS_CTL) + 1024, 8};
    pg8::gemm_phase<pg8::EpiMerge, pg8::SplitTailOrder, true, true>(lds, g, S, E, wv);
}
__device__ __forceinline__ void phase_gemm_out(const P& p, LAS unsigned char* lds, int bid, int nb, int wv) {
    pg8::Gemm g{(const bf16_t*)(p.ws + WS_MERGED), (const bf16_t*)(p.ws + WS_WOUT), MPAD, D, D, 0}; pg8::SplitTailOrder S; S.init(MPAD, D, D, nb, bid); S.S = (nb == 256) ? 4 : 0;
    pg8::EpiX1 E{p.in[I_META], p.in[I_XP], p.in[I_XS], nullptr, (bf16_t*)(p.ws + WS_XN), (float*)(p.ws + WS_SSQ), (float*)(p.ws + WS_Z), (unsigned*)(p.ws + WS_CTL) + 1088, 4};
    pg8::gemm_phase<pg8::EpiX1, pg8::SplitTailOrder, true, true>(lds, g, S, E, wv);
}
__device__ __forceinline__ void phase_gemm_up(const P& p, LAS unsigned char* lds, int bid, int nb, int wv) {
    pg8::Gemm g{(const bf16_t*)(p.ws + WS_XN), (const bf16_t*)(p.ws + WS_WUP), MPAD, NUP, D, 1}; pg8::StaticOrder S; S.init(MPAD, NUP, D, nb, bid);
    pg8::EpiUp E{(bf16_t*)(p.ws + WS_ACAT), (const float*)(p.ws + WS_SSQ), p.in[I_FCW], p.in[I_FCB], p.in[I_SF], p.out, (LAS float*)(lds + 131072)};
    pg8::gemm_phase<pg8::EpiUp, pg8::StaticOrder, true, true>(lds, g, S, E, wv);
}
__device__ __forceinline__ void phase_gemm_down(const P& p, LAS unsigned char* lds, int bid, int nb, int wv) {
    pg8::Gemm g{(const bf16_t*)(p.ws + WS_ACAT), (const bf16_t*)(p.ws + WS_WDOWN), MPAD, D, DFF, 0}; pg8::SplitTailOrder S; S.init(MPAD, D, DFF, nb, bid); S.S = (nb == 256) ? 11 : 0;
    pg8::EpiAcc E{(const bf16_t*)(p.ws + WS_XN), (bf16_t*)(p.ws + WS_X1), (float*)(p.ws + WS_Z)};
    pg8::gemm_phase<pg8::EpiAcc, pg8::SplitTailOrder, true, true>(lds, g, S, E, wv);
}


#define XB_TMO      128
#define XB_XCNT(j)  (256  + 64 * (j))
#define XB_XSUB(j)  (1280 + 64 * (j))
#define XB_XGEN(j)  (2304 + 64 * (j))
#define XB_TOP      3328
#define XB_TOPGEN   3392
#define XCD_BAR_WORDS 3456
#define XB_SPIN_CAP (1u << 22)
constexpr int CW_BAR = 4096;
__device__ __forceinline__ unsigned xb_ld(unsigned* p)              { return __hip_atomic_load(p, __ATOMIC_RELAXED, __HIP_MEMORY_SCOPE_AGENT); }
__device__ __forceinline__ unsigned xb_add(unsigned* p, unsigned v) { return __hip_atomic_fetch_add(p, v, __ATOMIC_RELAXED, __HIP_MEMORY_SCOPE_AGENT); }
__device__ __forceinline__ unsigned xb_xcc_id() { return (unsigned)__builtin_amdgcn_s_getreg((3 << 11) | 20) & 0xFu; }
#define XB_SPIN(cond, bar) do { unsigned _sp = 0; while (cond) { __builtin_amdgcn_s_sleep(1); \
    if ((++_sp & 255u) == 0u) { if (xb_ld(&(bar)[XB_TMO])) break; if (_sp > XB_SPIN_CAP) { atomicAdd(&(bar)[XB_TMO], 1u); break; } } } } while (0)
struct XcdBarrier { unsigned* bar; unsigned x; volatile LAS unsigned* st; };
__device__ __forceinline__ XcdBarrier xcd_barrier_post(unsigned* bar, volatile LAS unsigned* st) {
    XcdBarrier b; b.bar = bar; b.x = xb_xcc_id(); b.st = st;
    if (threadIdx.x == 0) (void)xb_add(&bar[XB_XCNT(b.x)], 1u);
    return b;
}
__device__ __forceinline__ void xcd_barrier_complete(unsigned* bar, unsigned x, unsigned& nloc, unsigned& nx) {
    const unsigned G = gridDim.x * gridDim.y * gridDim.z;
    unsigned sum, cnt, mine, sp = 0u;
    for (;;) {
        sum = 0u; cnt = 0u; mine = 0u;
#pragma unroll
        for (unsigned j = 0; j < 16; ++j) { const unsigned c = xb_ld(&bar[XB_XCNT(j)]); sum += c; cnt += (c > 0u) ? 1u : 0u; mine = (j == x) ? c : mine; }
        if (sum == G) break;
        __builtin_amdgcn_s_sleep(1);
        if ((++sp & 255u) == 0u) { if (xb_ld(&bar[XB_TMO])) break; if (sp > XB_SPIN_CAP) { atomicAdd(&bar[XB_TMO], 1u); break; } }
    }
    nloc = mine > 0u ? mine : 1u; nx = cnt > 0u ? cnt : 1u;
}
__device__ __forceinline__ void xcd_barrier(const XcdBarrier& b, int wv);
__device__ __forceinline__ void xcd_barrier_at(unsigned* bar, volatile LAS unsigned* st, int wv) { XcdBarrier b; b.bar = bar; b.x = xb_xcc_id(); b.st = st; xcd_barrier(b, wv); }
__device__ __forceinline__ void xcd_barrier(const XcdBarrier& b, int wv) {
    asm volatile("s_waitcnt vmcnt(0)" ::: "memory");
    __syncthreads();
    if (wv == 0 && lane_id_volatile() == 0) {
        unsigned* bar = b.bar;
        __builtin_amdgcn_s_waitcnt(0);
        unsigned nloc = b.st[0], nx = b.st[1];
        if (nloc == 0u) { xcd_barrier_complete(bar, b.x, nloc, nx); b.st[0] = nloc; b.st[1] = nx; }
        const unsigned old = xb_add(&bar[XB_XSUB(b.x)], 1u);
        const unsigned gen = old / nloc;
        if (old + 1u == (gen + 1u) * nloc) {
            __builtin_amdgcn_fence(__ATOMIC_RELEASE, "agent");
            asm volatile("s_waitcnt vmcnt(0)" ::: "memory");
            const unsigned og = xb_add(&bar[XB_TOP], 1u);
            const unsigned tg = og / nx;
            if (og + 1u == (tg + 1u) * nx) xb_add(&bar[XB_TOPGEN], 1u);
            else XB_SPIN(xb_ld(&bar[XB_TOPGEN]) == tg, bar);
            __builtin_amdgcn_fence(__ATOMIC_ACQUIRE, "agent");
            xb_add(&bar[XB_XGEN(b.x)], 1u);
            asm volatile("s_waitcnt vmcnt(0)" ::: "memory");
        } else {
            XB_SPIN(xb_ld(&bar[XB_XGEN(b.x)]) == gen, bar);
            __builtin_amdgcn_fence(__ATOMIC_ACQUIRE, "agent");
            asm volatile("s_waitcnt vmcnt(0)" ::: "memory");
        }
    }
    __syncthreads();
}

constexpr int NPHASES = 12;
template <int PH> __device__ __forceinline__ void run_phase(const P& p, LAS unsigned char* lds, int bid, int nb, int wv) {
    if constexpr (PH == 0) phase_prep(p, lds, bid, nb, wv);
    if constexpr (PH == 1) phase_gemm1(p, lds, bid, nb, wv);
    constexpr int LRU_SPLIT = NBP * NSEGP + DECB / 2;
    if constexpr (PH == 2) { if (bid >= (nb >> 1)) phase_lru(p, lds, bid - (nb >> 1), nb >> 1, wv, 0, LRU_SPLIT); __syncthreads(); }
    if constexpr (PH == 3) {
        if (bid < (nb >> 1)) { phase_mlstm(p, lds, bid, nb >> 1, wv); if (MK_DUP == 30) phase_mlstm(p, lds, bid, nb >> 1, wv); __syncthreads(); phase_lru(p, lds, bid, nb >> 1, wv, LRU_SPLIT, 1 << 30); __syncthreads(); }
        else { mlstm_sample(p, lds, bid - (nb >> 1), nb >> 1, wv); if (MK_DUP == 31) mlstm_sample(p, lds, bid - (nb >> 1), nb >> 1, wv); } }
    if constexpr (PH == 4) phase_headnorm(p, bid, nb, wv);
    if constexpr (PH == 5) phase_gemm_merge(p, lds, bid, nb, wv);
    if constexpr (PH == 6) phase_gemm_out(p, lds, bid, nb, wv);
    if constexpr (PH == 7) phase_norm2(p, bid, nb, wv);
    if constexpr (PH == 8) phase_gemm_up(p, lds, bid, nb, wv);
    if constexpr (PH == 9) phase_convffn(p, bid, nb, wv);
    if constexpr (PH == 10) phase_gemm_down(p, lds, bid, nb, wv);
    if constexpr (PH == 11) phase_final(p, lds, bid, nb, wv);
}
#if MK_ONE_LAUNCH
__global__ void __launch_bounds__(NTHREADS, 2) k_fwd(P p) {
    extern __shared__ __attribute__((aligned(16))) unsigned char lds_raw[];
    LAS unsigned char* lds = (LAS unsigned char*)lds_raw;
    cg::grid_group grid = cg::this_grid();
    const int bid = (int)blockIdx.x, nb = (int)gridDim.x;
    const int wv = __builtin_amdgcn_readfirstlane((int)(threadIdx.x >> 6));
#define RUNP(X) do { run_phase<X>(p, lds, bid, nb, wv); if (MK_DUP == X) { xcd_barrier_at((unsigned*)(p.ws + WS_CTL) + CW_BAR, (volatile LAS unsigned*)(lds + LDS_BYTES - 64), wv); run_phase<X>(p, lds, bid, nb, wv); } } while (0)
    volatile LAS unsigned* bst = (volatile LAS unsigned*)(lds + LDS_BYTES - 64);
    if (threadIdx.x < 16) bst[threadIdx.x] = 0u;
    (void)xcd_barrier_post((unsigned*)(p.ws + WS_CTL) + CW_BAR, bst);
    if (nb == 0x7fffffff) grid.sync();
    run_phase<0>(p, lds, bid, nb, wv); xcd_barrier_at((unsigned*)(p.ws + WS_CTL) + CW_BAR, (volatile LAS unsigned*)(lds + LDS_BYTES - 64), wv);
    RUNP(1); xcd_barrier_at((unsigned*)(p.ws + WS_CTL) + CW_BAR, (volatile LAS unsigned*)(lds + LDS_BYTES - 64), wv);
    RUNP(2);
    RUNP(3); xcd_barrier_at((unsigned*)(p.ws + WS_CTL) + CW_BAR, (volatile LAS unsigned*)(lds + LDS_BYTES - 64), wv);
    run_phase<4>(p, lds, bid, nb, wv); xcd_barrier_at((unsigned*)(p.ws + WS_CTL) + CW_BAR, (volatile LAS unsigned*)(lds + LDS_BYTES - 64), wv);
    RUNP(5); xcd_barrier_at((unsigned*)(p.ws + WS_CTL) + CW_BAR, (volatile LAS unsigned*)(lds + LDS_BYTES - 64), wv);
    RUNP(6); xcd_barrier_at((unsigned*)(p.ws + WS_CTL) + CW_BAR, (volatile LAS unsigned*)(lds + LDS_BYTES - 64), wv);
    RUNP(8); xcd_barrier_at((unsigned*)(p.ws + WS_CTL) + CW_BAR, (volatile LAS unsigned*)(lds + LDS_BYTES - 64), wv);
    run_phase<10>(p, lds, bid, nb, wv); xcd_barrier_at((unsigned*)(p.ws + WS_CTL) + CW_BAR, (volatile LAS unsigned*)(lds + LDS_BYTES - 64), wv);
    RUNP(11);
}
#endif

#if !MK_ONE_LAUNCH
template <int PH> __global__ void __launch_bounds__(NTHREADS, 2) k_phase(P p) {
    extern __shared__ __attribute__((aligned(16))) unsigned char lds_raw[];
    run_phase<PH>(p, (LAS unsigned char*)lds_raw, (int)blockIdx.x, (int)gridDim.x, __builtin_amdgcn_readfirstlane((int)(threadIdx.x >> 6)));
}
template <int PH> static void launch_phase(const P& p, int grid, hipStream_t stream) {
    static bool attr = false;
    if (!attr) { (void)hipFuncSetAttribute((const void*)k_phase<PH>, hipFuncAttributeMaxDynamicSharedMemorySize, LDS_BYTES); attr = true; }
    hipLaunchKernelGGL(k_phase<PH>, dim3(grid), dim3(NTHREADS), LDS_BYTES, stream, p);
}
#endif

extern "C" void kernel_launch(void* const* d_in, const int* in_sizes, int n_in, void* d_out, int out_size, void* d_ws, size_t ws_size, hipStream_t stream) {
    if (n_in != 29 || (size_t)out_size != O_END || ws_size < WS_END) { fprintf(stderr, "kernel_launch: unexpected shapes (n_in %d, out %d, ws %zu)\n", n_in, out_size, ws_size); return; }
    P p{};
    for (int i = 0; i < 29; ++i) p.in[i] = (const float*)d_in[i];
    p.out = (float*)d_out; p.ws = (unsigned char*)d_ws;
#if MK_ONE_LAUNCH
    static int grid = 0;
    if (grid == 0) {
        int dev = 0, cus = 0, per_cu = 0;
        (void)hipGetDevice(&dev); (void)hipDeviceGetAttribute(&cus, hipDeviceAttributeMultiprocessorCount, dev);
        (void)hipFuncSetAttribute((const void*)k_fwd, hipFuncAttributeMaxDynamicSharedMemorySize, LDS_BYTES);
        if (hipOccupancyMaxActiveBlocksPerMultiprocessor(&per_cu, (const void*)k_fwd, NTHREADS, LDS_BYTES) != hipSuccess || per_cu < 1) { fprintf(stderr, "kernel_launch: occupancy query failed (%d)\n", per_cu); per_cu = 1; }
        grid = cus * 1;
        if (grid <= 0) grid = 256;
    }
    if (hipMemsetAsync(d_ws, 0, 32768, stream) != hipSuccess) { fprintf(stderr, "kernel_launch: memset of control words failed\n"); return; }
    void* args[] = {(void*)&p};
    hipError_t e = hipLaunchCooperativeKernel((const void*)k_fwd, dim3(grid), dim3(NTHREADS), args, LDS_BYTES, stream);
    if (e != hipSuccess) fprintf(stderr, "cooperative launch failed: %s (grid %d)\n", hipGetErrorString(e), grid);
#else
    const int grid = 256;
    launch_phase<0>(p, grid, stream); launch_phase<1>(p, grid, stream); launch_phase<2>(p, grid, stream); launch_phase<3>(p, grid, stream);
    launch_phase<4>(p, grid, stream); launch_phase<5>(p, grid, stream); launch_phase<6>(p, grid, stream); launch_phase<7>(p, grid, stream);
    launch_phase<8>(p, grid, stream); launch_phase<9>(p, grid, stream); launch_phase<10>(p, grid, stream); launch_phase<11>(p, grid, stream);
#endif
}
```

```cpp
#include <hip/hip_runtime.h>
#include <hip/hip_cooperative_groups.h>
#include <cstdio>
#include <cstdint>
namespace cg = cooperative_groups;

#ifndef MK_ONE_LAUNCH
#define MK_ONE_LAUNCH 1
#endif

#ifndef MK_KROT
#define MK_KROT 0
#endif
#ifndef MK_DUP
#define MK_DUP -1
#endif
#define LAS __attribute__((address_space(3)))
typedef unsigned short bf16_t;
typedef short bf16x8 __attribute__((ext_vector_type(8)));
typedef float f32x4 __attribute__((ext_vector_type(4)));
typedef float f32x2 __attribute__((ext_vector_type(2)));
typedef unsigned u32x4 __attribute__((ext_vector_type(4)));
typedef unsigned u32x2 __attribute__((ext_vector_type(2)));

constexpr int D = 1024, NBP = 8, SEQ = 2048, NMETA = 16, LP = SEQ + NMETA, DECB = 128, DECS = 8;
constexpr int MP = NBP * LP, MS = DECB * DECS, MTOK = MP + MS, MPAD = 17664;
constexpr int NSEQ = NBP + DECB;
constexpr int NIN = 7176, NZ = 7168;
constexpr int ZC_U = 0, ZC_Q = 1024, ZC_K = 2048, ZC_V = 3072, ZC_O = 4096, ZC_GA = 5120, ZC_GB = 6144;
constexpr int DFF = 2816, NUP = 5632, NH = 4, DH = 256;
constexpr float EPS = 1e-6f;
constexpr size_t O_YP = 0;
constexpr size_t O_YS = O_YP + (size_t)NBP * SEQ * D;
constexpr size_t O_PLC = O_YS + (size_t)DECB * DECS * D;
constexpr size_t O_PLH = O_PLC + (size_t)NBP * 3 * D;
constexpr size_t O_PC = O_PLH + (size_t)NBP * D;
constexpr size_t O_PN = O_PC + (size_t)NBP * NH * DH * DH;
constexpr size_t O_PM = O_PN + (size_t)NBP * NH * DH;
constexpr size_t O_PF = O_PM + (size_t)NBP * NH;
constexpr size_t O_SLC = O_PF + (size_t)NBP * 2 * NUP;
constexpr size_t O_SLH = O_SLC + (size_t)DECB * 3 * D;
constexpr size_t O_SC = O_SLH + (size_t)DECB * D;
constexpr size_t O_SN = O_SC + (size_t)DECB * NH * DH * DH;
constexpr size_t O_SM = O_SN + (size_t)DECB * NH * DH;
constexpr size_t O_SF = O_SM + (size_t)DECB * NH;
constexpr size_t O_END = O_SF + (size_t)DECB * 2 * NUP;
constexpr size_t MiB = 1u << 20;
constexpr size_t WS_CTL = 0, WS_WIN = 1 * MiB, WS_WCAT = 15 * MiB, WS_WOUT = 19 * MiB, WS_WUP = 21 * MiB, WS_WDOWN = 32 * MiB;
constexpr size_t WS_SMALL = 38 * MiB;
constexpr size_t WS_XN = 40 * MiB;
constexpr size_t WS_Z = 75 * MiB;
constexpr size_t WS_ACAT = 317 * MiB;
constexpr size_t WS_MERGED = 386 * MiB;
constexpr size_t WS_X1 = 421 * MiB;
constexpr size_t WS_END = 490 * MiB;
constexpr int LSEG = 64, NSEGP = 33;
constexpr size_t WS_WLRU = 39 * MiB;
constexpr size_t WS_SSQ = 39 * MiB + 512 * 1024;
constexpr size_t WS_PCUM = WS_MERGED;
constexpr size_t WS_AGG = WS_X1;
constexpr size_t WS_CARRY = WS_X1 + 4 * MiB;

struct P {
    const float* in[29];
    float* out;
    unsigned char* ws;
};
enum { I_XP = 0, I_XS, I_SLC, I_SLH, I_SC, I_SN, I_SM, I_SF, I_META, I_G1, I_WIN, I_BIN, I_LCW, I_LCB, I_LWR, I_LBR, I_LWI, I_LBI, I_LAM, I_HG, I_WA, I_WB, I_WOUT, I_G2, I_WUP, I_FCW, I_FCB, I_WDOWN, I_GF };

__device__ __forceinline__ unsigned pk2(float lo, float hi) { unsigned r; asm("v_cvt_pk_bf16_f32 %0, %1, %2" : "=v"(r) : "v"(lo), "v"(hi)); return r; }
__device__ __forceinline__ unsigned f2bf(float f) { return pk2(f, 0.f) & 0xffffu; }
__device__ __forceinline__ float bf2f(unsigned short b) { return __builtin_bit_cast(float, ((unsigned)b) << 16); }
__device__ __forceinline__ float bflo(unsigned w) { return __builtin_bit_cast(float, w << 16); }
__device__ __forceinline__ float bfhi(unsigned w) { return __builtin_bit_cast(float, w & 0xffff0000u); }
__device__ __forceinline__ void unpack8(const u32x4 w, float (&o)[8]) { o[0] = bflo(w.x); o[1] = bfhi(w.x); o[2] = bflo(w.y); o[3] = bfhi(w.y); o[4] = bflo(w.z); o[5] = bfhi(w.z); o[6] = bflo(w.w); o[7] = bfhi(w.w); }
__device__ __forceinline__ float wave_sum(float v) {
#pragma unroll
    for (int o = 1; o < 64; o <<= 1) v += __shfl_xor(v, o);
    return v;
}
__device__ __forceinline__ int lane_id_volatile() { int l; asm volatile("v_mbcnt_lo_u32_b32 %0, -1, 0\n\tv_mbcnt_hi_u32_b32 %0, -1, %0" : "=v"(l)); return l; }
__device__ __forceinline__ int opaque_tid(int wv) { return wv * 64 + lane_id_volatile(); }
__device__ __forceinline__ float sigmoidf_(float x) { return __builtin_amdgcn_rcpf(1.0f + __expf(-x)); }
constexpr int ZG_OFF = 8192, ZG_PITCH = 14336;
__device__ __forceinline__ float ub0(unsigned w) { return (float)(w & 0xffu); }
__device__ __forceinline__ float ub1(unsigned w) { return (float)((w >> 8) & 0xffu); }
__device__ __forceinline__ float ub2(unsigned w) { return (float)((w >> 16) & 0xffu); }
__device__ __forceinline__ float ub3(unsigned w) { return (float)(w >> 24); }
__device__ __forceinline__ unsigned q8(float s, unsigned lo) { const unsigned q = (unsigned)(s * 255.0f + 0.5f); return q < lo ? lo : q; }
__device__ __forceinline__ float logsigmoidf_(float x) { return fminf(x, 0.f) - log1pf(__expf(-fabsf(x))); }
__device__ __forceinline__ void seq_info(int s, int& row0, int& L) { if (s < NBP) { row0 = s * LP; L = LP; } else { row0 = MP + (s - NBP) * DECS; L = DECS; } }
__device__ __forceinline__ const float* xrow3(const float* meta, const float* xp, const float* xs, int r) {
    if (r < MP) { const int b = r / LP, t = r - b * LP; return t < NMETA ? meta + (size_t)t * D : xp + ((size_t)b * SEQ + (t - NMETA)) * D; }
    return xs + (size_t)(r - MP) * D;
}
__device__ __forceinline__ const float* xrow_ptr(const P& p, int r) {
    if (r < MP) { const int b = r / LP, t = r - b * LP; return t < NMETA ? p.in[I_META] + (size_t)t * D : p.in[I_XP] + ((size_t)b * SEQ + (t - NMETA)) * D; }
    return p.in[I_XS] + (size_t)(r - MP) * D;
}

namespace pg8 {
constexpr int BM = 256, BK = 64, HALF = 128, HTB = HALF * BK * 2, STAGE_BYTES = 8 * HTB, NXCD = 8, WGM = 8;
__host__ __device__ __forceinline__ int lds_byte(int r, int c) { const int st = (r >> 4) * 2 + (c >> 5), rr = r & 15, cc = c & 31, ob = rr * 64 + cc * 2; return st * 1024 + (ob ^ (((ob >> 9) & 1) << 5)); }
__host__ __device__ __forceinline__ void stage_rc(int b, int& R, int& C) { const int st = b / 1024, sb = b % 1024, swz = sb ^ (((sb >> 9) & 1) << 5); R = (st >> 1) * 16 + swz / 64; C = (st & 1) * 32 + (swz % 64) / 2; }
__host__ __device__ __forceinline__ int perm32(int rho) { const int n = rho >> 4, i = rho & 15; return 8 * (i >> 2) + 4 * n + (i & 3); }
__host__ __device__ __forceinline__ int up_row0(int pm) { return pm < 65 ? 254 * pm : MP + 256 * (pm - 65); }
struct Unit { int pm, pn, kt0, nt, kind, slot; };
struct Gemm { const bf16_t* A; const bf16_t* Bt; int M, N, K; int a_mode; };
struct StaticOrder {
    int nM, nN, nwg, G, c, ntk;
    __host__ __device__ void init(int M, int N, int K, int G_, int c_) { nM = M / BM; nN = N / BM; nwg = nM * nN; G = G_; c = c_; ntk = K / BK; }
    __host__ __device__ bool next(int i, Unit& u) const {
        const long L = (long)i * G + c; if (L >= nwg) return false;
        int wgid = (int)L; { const int q = nwg / NXCD, r = nwg % NXCD, xcd = wgid % NXCD, off = wgid / NXCD; wgid = (xcd < r ? xcd * (q + 1) : r * (q + 1) + (xcd - r) * q) + off; }
        const int nig = WGM * nN, gid = wgid / nig, fm = gid * WGM, gsz = (nM - fm) < WGM ? (nM - fm) : WGM;
        u.pm = fm + ((wgid % nig) % gsz); u.pn = (wgid % nig) / gsz; u.kt0 = 0; u.nt = ntk; u.kind = 0; u.slot = 0; return true;
    }
    __device__ __forceinline__ void a_ready(const Unit&) const {}
    __device__ __forceinline__ void done(const Unit&) const {}
};
struct SplitTailOrder : StaticOrder {
    int S;
    __host__ __device__ bool next(int i, Unit& u) const {
        if (S <= 0 || i == 0) return StaticOrder::next(i, u);
        if (i > 1) return false;
        const int R = nwg - G; if (R <= 0 || c >= R * S) return false;
        StaticOrder t = *this; t.c = c / S; if (!t.StaticOrder::next(1, u)) return false;
        const int sl = c % S, per = ntk / S; u.kt0 = sl * per; u.nt = per; u.kind = 1; u.slot = c; return true;
    }
};
__device__ __forceinline__ unsigned cvt_pk_bf16(float lo, float hi) { unsigned r; asm volatile("v_cvt_pk_bf16_f32 %0, %1, %2" : "=v"(r) : "v"(lo), "v"(hi)); return r; }

struct EpiBf16 {
    static constexpr bool PERM = true, APERM = false, AFTER_DRAIN = false, HAS_MID = false, TAIL_REDUCE = false;
    bf16_t* O; int ldc; const float* bias; const float* ssq;
    __device__ __forceinline__ void mid(f32x4 (&acc)[2][2][4][2], const Unit& u, int wr, int wc, int fr, int fq) const {}
    __device__ __forceinline__ void operator()(const f32x4 (&acc)[2][2][4][2], const Unit& u, int wr, int wc, int fr, int fq) const {
        const int row0 = u.pm * BM + wr * 64 + fr; const int col0 = u.pn * BM + wc * 32 + 8 * fq;
        f32x4 bv[2][2];
#pragma unroll
        for (int bj = 0; bj < 2; ++bj)
#pragma unroll
            for (int n = 0; n < 2; ++n) bv[bj][n] = bias ? *(const f32x4*)(bias + col0 + bj * HALF + 4 * n) : (f32x4){0.f, 0.f, 0.f, 0.f};
        if (u.pn >= 16) {
            const unsigned lo = (u.pn >= 24) ? 1u : 0u; unsigned char* zb = (unsigned char*)O + ZG_OFF + (col0 - 4096);
#pragma unroll
            for (int ai = 0; ai < 2; ++ai)
#pragma unroll
                for (int m = 0; m < 4; ++m) { unsigned char* rowp = zb + (size_t)(row0 + ai * HALF + m * 16) * ZG_PITCH;
#pragma unroll
                    for (int bj = 0; bj < 2; ++bj) { u32x2 w;
#pragma unroll
                        for (int n = 0; n < 2; ++n) {
                            const f32x4 t = (acc[ai][bj][m][n] + bv[bj][n]) * (-1.4426950408889634f);
                            const f32x4 d = (f32x4){__builtin_amdgcn_exp2f(t[0]), __builtin_amdgcn_exp2f(t[1]), __builtin_amdgcn_exp2f(t[2]), __builtin_amdgcn_exp2f(t[3])} + 1.0f;
                            const f32x4 sq = (f32x4){__builtin_amdgcn_rcpf(d[0]), __builtin_amdgcn_rcpf(d[1]), __builtin_amdgcn_rcpf(d[2]), __builtin_amdgcn_rcpf(d[3])} * 255.0f + 0.5f;
                            unsigned q0 = (unsigned)sq[0], q1 = (unsigned)sq[1], q2 = (unsigned)sq[2], q3 = (unsigned)sq[3];
                            if (lo) { q0 = q0 < 1u ? 1u : q0; q1 = q1 < 1u ? 1u : q1; q2 = q2 < 1u ? 1u : q2; q3 = q3 < 1u ? 1u : q3; }
                            const unsigned pw = q0 | (q1 << 8) | (q2 << 16) | (q3 << 24); if (n == 0) w.x = pw; else w.y = pw; }
                        *(u32x2*)(rowp + bj * HALF) = w; } }
            return; }
#pragma unroll
        for (int ai = 0; ai < 2; ++ai)
#pragma unroll
            for (int m = 0; m < 4; ++m) { bf16_t* rowp = O + (size_t)(row0 + ai * HALF + m * 16) * ldc + col0;
                const float rs = ssq ? 1.0f / sqrtf(ssq[row0 + ai * HALF + m * 16] * (1.0f / D) + EPS) : 1.0f;
#pragma unroll
                for (int bj = 0; bj < 2; ++bj) { const f32x4 v0 = acc[ai][bj][m][0] * rs + bv[bj][0], v1 = acc[ai][bj][m][1] * rs + bv[bj][1];
                    u32x4 w; w.x = cvt_pk_bf16(v0[0], v0[1]); w.y = cvt_pk_bf16(v0[2], v0[3]); w.z = cvt_pk_bf16(v1[0], v1[1]); w.w = cvt_pk_bf16(v1[2], v1[3]);
                    __builtin_nontemporal_store(w, (u32x4*)(rowp + bj * HALF)); } }
    }
};
template <int CTRL> __device__ __forceinline__ float dppmovz(float src) { return __builtin_bit_cast(float, __builtin_amdgcn_update_dpp(0, __builtin_bit_cast(int, src), CTRL, 0xf, 0xf, true)); }
__device__ __forceinline__ float gelu_tanh_e(float x) { const float u2 = -1.5957691216057308f * (x + 0.044715f * x * x * x); return x * __builtin_amdgcn_rcpf(1.0f + __expf(u2)); }
struct EpiUp {
    static constexpr bool PERM = true, APERM = true, AFTER_DRAIN = false, HAS_MID = false, TAIL_REDUCE = false;
    bf16_t* HM; const float* ssq; const float* cw; const float* cb; const float* sf; float* out; LAS float* EX;
    __device__ __forceinline__ void mid(f32x4 (&acc)[2][2][4][2], const Unit& u, int wr, int wc, int fr, int fq) const {}
    __device__ __forceinline__ void operator()(f32x4 (&acc)[2][2][4][2], const Unit& u, int wr, int wc, int fr_, int fq_) const {
        int fr = fr_, fq = fq_; asm volatile("" : "+v"(fr), "+v"(fq));
        const int rbase = up_row0(u.pm) + wr * 64 + 4 * fr;
        const bool sample = u.pm >= 65;
#pragma unroll
        for (int ai = 0; ai < 2; ++ai) { const f32x4 sq = *(const f32x4*)(ssq + rbase + ai * HALF);
#pragma unroll
            for (int m = 0; m < 4; ++m) { const float rs = __builtin_amdgcn_rsqf(sq[m] * (1.0f / D) + EPS);
#pragma unroll
                for (int bj = 0; bj < 2; ++bj)
#pragma unroll
                    for (int n = 0; n < 2; ++n) acc[ai][bj][m][n] = acc[ai][bj][m][n] * rs; } }
        const int cl = wc * 32 + 8 * fq;
        if (fr == 15) {
#pragma unroll
            for (int ai = 0; ai < 2; ++ai)
#pragma unroll
                for (int bj = 0; bj < 2; ++bj)
#pragma unroll
                    for (int n = 0; n < 2; ++n) { *(LAS f32x4*)(EX + ((ai * 2 + wr) * 2 + 0) * 256 + bj * 128 + cl + 4 * n) = acc[ai][bj][2][n]; *(LAS f32x4*)(EX + ((ai * 2 + wr) * 2 + 1) * 256 + bj * 128 + cl + 4 * n) = acc[ai][bj][3][n]; } }
        asm volatile("s_waitcnt lgkmcnt(0)" ::: "memory"); __builtin_amdgcn_s_barrier(); asm volatile("" ::: "memory");
        const float mk0 = (fr == 0) ? 1.f : 0.f;
        const int hal = (u.pm >= 1 && u.pm < 65) ? 2 : 0;
        const int ch0 = u.pn * 128 + cl;
#pragma unroll
        for (int n = 0; n < 2; ++n) {
            const int ch = ch0 + 4 * n;
            const f32x4 wv0 = *(const f32x4*)(cw + ch), wv1 = *(const f32x4*)(cw + NUP + ch), wv2 = *(const f32x4*)(cw + 2 * NUP + ch), bv = *(const f32x4*)(cb + ch);
            const f32x4 wg0 = *(const f32x4*)(cw + DFF + ch), wg1 = *(const f32x4*)(cw + NUP + DFF + ch), wg2 = *(const f32x4*)(cw + 2 * NUP + DFF + ch), bg = *(const f32x4*)(cb + DFF + ch);
#pragma unroll
            for (int ai = 0; ai < 2; ++ai) {
                const int r0 = rbase + ai * HALF;
                const int t0 = sample ? ((r0 - MP) & 7) : (r0 - (r0 / LP) * LP);
                f32x4 p1v = {0.f, 0.f, 0.f, 0.f}, p2v = p1v, p1g = p1v, p2g = p1v;
                if (ai + wr > 0) { const int pb = (wr == 1) ? (ai * 2) : 1;
                    p2v = *(const LAS f32x4*)(EX + (pb * 2 + 0) * 256 + cl + 4 * n) * mk0; p1v = *(const LAS f32x4*)(EX + (pb * 2 + 1) * 256 + cl + 4 * n) * mk0;
                    p2g = *(const LAS f32x4*)(EX + (pb * 2 + 0) * 256 + 128 + cl + 4 * n) * mk0; p1g = *(const LAS f32x4*)(EX + (pb * 2 + 1) * 256 + 128 + cl + 4 * n) * mk0; }
#pragma unroll
                for (int j = 0; j < 4; ++j) { p1v[j] += dppmovz<0x111>(acc[ai][0][3][n][j]); p2v[j] += dppmovz<0x111>(acc[ai][0][2][n][j]); p1g[j] += dppmovz<0x111>(acc[ai][1][3][n][j]); p2g[j] += dppmovz<0x111>(acc[ai][1][2][n][j]); }
                if (sample) {
                    if ((fr & 1) == 0) { const float* b0 = sf + (size_t)((r0 - MP) >> 3) * 2 * NUP; p2v = *(const f32x4*)(b0 + ch); p2g = *(const f32x4*)(b0 + DFF + ch); p1v = *(const f32x4*)(b0 + NUP + ch); p1g = *(const f32x4*)(b0 + NUP + DFF + ch); } }
                if (!sample && __builtin_amdgcn_ballot_w64(t0 == 0) != 0ull) { const float keep = (t0 == 0) ? 0.f : 1.f; p1v = p1v * keep; p2v = p2v * keep; p1g = p1g * keep; p2g = p2g * keep; }
                const bool zmid = !sample && __builtin_amdgcn_ballot_w64(t0 == LP - 2) != 0ull; const float z2 = (!sample && t0 == LP - 2) ? 1.f : 0.f;
#pragma unroll
                for (int m = 0; m < 4; ++m) {
                    const f32x4 xv = acc[ai][0][m][n], xg = acc[ai][1][m][n];
                    const f32x4 av = (m == 0) ? p1v : acc[ai][0][m > 0 ? m - 1 : 0][n], ag = (m == 0) ? p1g : acc[ai][1][m > 0 ? m - 1 : 0][n];
                    const f32x4 bv2 = (m == 0) ? p2v : (m == 1) ? p1v : acc[ai][0][m > 1 ? m - 2 : 0][n], bg2 = (m == 0) ? p2g : (m == 1) ? p1g : acc[ai][1][m > 1 ? m - 2 : 0][n];
                    f32x4 cv = bv + wv2 * xv + wv1 * av + wv0 * bv2, cg = bg + wg2 * xg + wg1 * ag + wg0 * bg2;
                    if (zmid && m == 2) { cv -= z2 * (wv1 * av + wv0 * bv2); cg -= z2 * (wg1 * ag + wg0 * bg2); }
                    if (zmid && m == 3) { cv -= z2 * (wv0 * bv2); cg -= z2 * (wg0 * bg2); }
                    if ((ai == 1 || m >= 2) ? true : (wr * 64 + 4 * fr + m >= hal)) {
                        const f32x4 tg = cg * ((cg * cg) * 0.044715f + 1.0f), ug = tg * (-1.5957691216057308f * 1.4426950408889634f);
                        const f32x4 dg = (f32x4){__builtin_amdgcn_exp2f(ug[0]), __builtin_amdgcn_exp2f(ug[1]), __builtin_amdgcn_exp2f(ug[2]), __builtin_amdgcn_exp2f(ug[3])} + 1.0f;
                        const f32x4 og = (cg * cv) * (f32x4){__builtin_amdgcn_rcpf(dg[0]), __builtin_amdgcn_rcpf(dg[1]), __builtin_amdgcn_rcpf(dg[2]), __builtin_amdgcn_rcpf(dg[3])};
                        u32x2 w; w.x = cvt_pk_bf16(og[0], og[1]); w.y = cvt_pk_bf16(og[2], og[3]);
                        *(u32x2*)(HM + (size_t)(r0 + m) * DFF + ch) = w; }
                    __builtin_amdgcn_sched_barrier(0); }
            }
        }
#pragma unroll
        for (int ai = 0; ai < 2; ++ai) {
            int r0s = rbase + ai * HALF; asm volatile("" : "+v"(r0s));
            const int t0 = sample ? ((r0s - MP) & 7) : (r0s - (r0s / LP) * LP), Lq = sample ? DECS : LP;
            if (__builtin_amdgcn_ballot_w64(t0 + 3 >= Lq - 2) != 0ull) {
                float* ob = sample ? out + O_SF + (size_t)((r0s - MP) >> 3) * 2 * NUP : out + O_PF + (size_t)(r0s / LP) * 2 * NUP;
#pragma unroll
                for (int m = 0; m < 4; ++m) { const int t = t0 + m, i = ai * HALF + wr * 64 + 4 * fr + m;
                    if (t >= Lq - 2 && t < Lq && i >= hal) { float* of = ob + (size_t)(t - (Lq - 2)) * NUP + ch0;
                        *(f32x4*)(of) = acc[ai][0][m][0]; *(f32x4*)(of + 4) = acc[ai][0][m][1]; *(f32x4*)(of + DFF) = acc[ai][1][m][0]; *(f32x4*)(of + DFF + 4) = acc[ai][1][m][1]; } } }
        }
    }
};
struct EpiMerge {
    static constexpr bool PERM = true, APERM = false, AFTER_DRAIN = false, HAS_MID = true, TAIL_REDUCE = true;
    bf16_t* O; const bf16_t* Z; float* PART; unsigned* tcnt; int S;
    __device__ __forceinline__ void mid(f32x4 (&acc)[2][2][4][2], const Unit& u, int wr, int wc, int fr, int fq) const {
        int row0 = u.pm * BM + wr * 64 + fr; const int col0 = u.pn * BM + wc * 32 + 8 * fq;
        asm volatile("" : "+v"(row0));
#pragma unroll
        for (int ai = 0; ai < 2; ++ai)
#pragma unroll
            for (int m = 0; m < 4; ++m) { const unsigned char* zr = (const unsigned char*)Z + (size_t)(row0 + ai * HALF + m * 16) * ZG_PITCH + ZG_OFF + col0;
#pragma unroll
                for (int bj = 0; bj < 2; ++bj) {
                    const u32x2 qa = *(const u32x2*)(zr + 1024 + bj * HALF), qb = *(const u32x2*)(zr + 2048 + bj * HALF);
                    const unsigned qaw[2] = {qa.x, qa.y}, qbw[2] = {qb.x, qb.y};
#pragma unroll
                    for (int n = 0; n < 2; ++n) { const unsigned wa = qaw[n], wb = qbw[n];
                        acc[ai][bj][m][n][0] *= ub0(wa) * __builtin_amdgcn_rcpf(ub0(wb)); acc[ai][bj][m][n][1] *= ub1(wa) * __builtin_amdgcn_rcpf(ub1(wb));
                        acc[ai][bj][m][n][2] *= ub2(wa) * __builtin_amdgcn_rcpf(ub2(wb)); acc[ai][bj][m][n][3] *= ub3(wa) * __builtin_amdgcn_rcpf(ub3(wb)); } }
                asm volatile("" ::: "memory"); }
    }
    __device__ __forceinline__ void operator()(const f32x4 (&acc)[2][2][4][2], const Unit& u, int wr, int wc, int fr, int fq) const {
        const int row0 = u.pm * BM + wr * 64 + fr; const int col0 = u.pn * BM + wc * 32 + 8 * fq;
#pragma unroll
        for (int ai = 0; ai < 2; ++ai)
#pragma unroll
            for (int m = 0; m < 4; ++m) { const size_t r = (size_t)(row0 + ai * HALF + m * 16);
#pragma unroll
                for (int bj = 0; bj < 2; ++bj) {
                    const u32x2 qb = *(const u32x2*)((const unsigned char*)Z + r * ZG_PITCH + ZG_OFF + 2048 + col0 + bj * HALF); const unsigned qbw[2] = {qb.x, qb.y};
                    float v[8];
#pragma unroll
                    for (int n = 0; n < 2; ++n) { const unsigned wb = qbw[n]; const f32x4 a = acc[ai][bj][m][n] * (1.0f / 255.0f);
                        v[4 * n + 0] = a[0] * ub0(wb); v[4 * n + 1] = a[1] * ub1(wb); v[4 * n + 2] = a[2] * ub2(wb); v[4 * n + 3] = a[3] * ub3(wb); }
                    u32x4 w; w.x = cvt_pk_bf16(v[0], v[1]); w.y = cvt_pk_bf16(v[2], v[3]); w.z = cvt_pk_bf16(v[4], v[5]); w.w = cvt_pk_bf16(v[6], v[7]);
                    *(u32x4*)(O + r * D + col0 + bj * HALF) = w; }
                asm volatile("" ::: "memory"); }
    }
    __device__ __forceinline__ void strip(const f32x4 (&sA)[4][2], const f32x4 (&sB)[4][2], const Unit& u, int wr, int wc, int fr, int fq, int a, int b, int m0, int nm) const {
        const int row0 = u.pm * BM + a * HALF + wr * 64 + fr, col0 = u.pn * BM + b * HALF + wc * 32 + 8 * fq;
#pragma unroll
        for (int mi = 0; mi < 4; ++mi) if (mi < nm) { const size_t r = (size_t)(row0 + (m0 + mi) * 16);
            const unsigned char* zr = (const unsigned char*)Z + r * ZG_PITCH + ZG_OFF + col0; const u32x2 qa = *(const u32x2*)(zr + 1024), qb = *(const u32x2*)(zr + 2048); const unsigned qaw[2] = {qa.x, qa.y}, qbw[2] = {qb.x, qb.y};
            float v[8];
#pragma unroll
            for (int n = 0; n < 2; ++n) { const unsigned wa = qaw[n], wb = qbw[n]; const f32x4 xa = sA[mi][n] * (1.0f / 255.0f), xb = sB[mi][n] * (1.0f / 255.0f);
                v[4 * n + 0] = ub0(wa) * xa[0] + ub0(wb) * xb[0]; v[4 * n + 1] = ub1(wa) * xa[1] + ub1(wb) * xb[1]; v[4 * n + 2] = ub2(wa) * xa[2] + ub2(wb) * xb[2]; v[4 * n + 3] = ub3(wa) * xa[3] + ub3(wb) * xb[3]; }
            u32x4 w; w.x = cvt_pk_bf16(v[0], v[1]); w.y = cvt_pk_bf16(v[2], v[3]); w.z = cvt_pk_bf16(v[4], v[5]); w.w = cvt_pk_bf16(v[6], v[7]);
            *(u32x4*)(O + r * D + col0) = w; }
    }
};
struct EpiX1 {
    static constexpr bool PERM = true, APERM = false, AFTER_DRAIN = false, HAS_MID = false, TAIL_REDUCE = true;
    const float *meta, *xp, *xs; float* X1; bf16_t* XN; float* ssq; float* PART; unsigned* tcnt; int S;
    __device__ __forceinline__ void mid(f32x4 (&acc)[2][2][4][2], const Unit& u, int wr, int wc, int fr, int fq) const {}
    __device__ __forceinline__ void operator()(const f32x4 (&acc)[2][2][4][2], const Unit& u, int wr, int wc, int fr, int fq) const {
        const int row0 = u.pm * BM + wr * 64 + fr, col0 = u.pn * BM + wc * 32 + 8 * fq;
#pragma unroll
        for (int ai = 0; ai < 2; ++ai)
#pragma unroll
            for (int m = 0; m < 4; ++m) { const int r = row0 + ai * HALF + m * 16; float sq = 0.f;
                if (r < MTOK) { const float* xr = xrow3(meta, xp, xs, r) + col0; bf16_t* ob = XN + (size_t)r * D + col0;
#pragma unroll
                    for (int bj = 0; bj < 2; ++bj) { const f32x4 v0 = *(const f32x4*)(xr + bj * HALF) + acc[ai][bj][m][0], v1 = *(const f32x4*)(xr + bj * HALF + 4) + acc[ai][bj][m][1];
                        u32x4 w; w.x = cvt_pk_bf16(v0[0], v0[1]); w.y = cvt_pk_bf16(v0[2], v0[3]); w.z = cvt_pk_bf16(v1[0], v1[1]); w.w = cvt_pk_bf16(v1[2], v1[3]); *(u32x4*)(ob + bj * HALF) = w;
                        sq += ((v0[0] * v0[0] + v0[1] * v0[1]) + (v0[2] * v0[2] + v0[3] * v0[3])) + ((v1[0] * v1[0] + v1[1] * v1[1]) + (v1[2] * v1[2] + v1[3] * v1[3])); } }
                sq += __shfl_xor(sq, 16); sq += __shfl_xor(sq, 32);
                if (fq == 0 && r < MTOK) atomicAdd(ssq + r, sq); }
    }
    __device__ __forceinline__ void strip(const f32x4 (&sA)[4][2], const f32x4 (&sB)[4][2], const Unit& u, int wr, int wc, int fr, int fq, int a, int b, int m0, int nm) const {
        const int row0 = u.pm * BM + a * HALF + wr * 64 + fr, col0 = u.pn * BM + b * HALF + wc * 32 + 8 * fq;
#pragma unroll
        for (int mi = 0; mi < 4; ++mi) if (mi < nm) { const int r = row0 + (m0 + mi) * 16; float sq = 0.f;
            if (r < MTOK) { const float* xr = xrow3(meta, xp, xs, r) + col0; bf16_t* ob = XN + (size_t)r * D + col0;
                const f32x4 v0 = *(const f32x4*)(xr) + sA[mi][0], v1 = *(const f32x4*)(xr + 4) + sA[mi][1];
                u32x4 w; w.x = cvt_pk_bf16(v0[0], v0[1]); w.y = cvt_pk_bf16(v0[2], v0[3]); w.z = cvt_pk_bf16(v1[0], v1[1]); w.w = cvt_pk_bf16(v1[2], v1[3]); *(u32x4*)ob = w;
                sq += ((v0[0] * v0[0] + v0[1] * v0[1]) + (v0[2] * v0[2] + v0[3] * v0[3])) + ((v1[0] * v1[0] + v1[1] * v1[1]) + (v1[2] * v1[2] + v1[3] * v1[3])); }
            sq += __shfl_xor(sq, 16); sq += __shfl_xor(sq, 32);
            if (fq == 0 && r < MTOK) atomicAdd(ssq + r, sq); }
    }
};
struct EpiAcc {
    static constexpr bool PERM = true, APERM = false, AFTER_DRAIN = false, HAS_MID = false, TAIL_REDUCE = false;
    const bf16_t* X1B; bf16_t* X2B; float* PART;
    __device__ __forceinline__ void mid(f32x4 (&acc)[2][2][4][2], const Unit& u, int wr, int wc, int fr, int fq) const {}
    __device__ __forceinline__ void operator()(const f32x4 (&acc)[2][2][4][2], const Unit& u, int wr, int wc, int fr, int fq) const {
        const int rl0 = wr * 64 + fr, cl0 = wc * 32 + 8 * fq;
        if (u.kind == 0) {
#pragma unroll
            for (int ai = 0; ai < 2; ++ai)
#pragma unroll
                for (int m = 0; m < 4; ++m) { const int r = u.pm * BM + rl0 + ai * HALF + m * 16;
                    if (r < MTOK) { const size_t e = (size_t)r * D + u.pn * BM + cl0;
#pragma unroll
                        for (int bj = 0; bj < 2; ++bj) { const u32x4 xw = *(const u32x4*)(X1B + e + bj * HALF); const f32x4 a0 = acc[ai][bj][m][0], a1 = acc[ai][bj][m][1];
                            u32x4 w; w.x = cvt_pk_bf16(bflo(xw.x) + a0[0], bfhi(xw.x) + a0[1]); w.y = cvt_pk_bf16(bflo(xw.y) + a0[2], bfhi(xw.y) + a0[3]);
                            w.z = cvt_pk_bf16(bflo(xw.z) + a1[0], bfhi(xw.z) + a1[1]); w.w = cvt_pk_bf16(bflo(xw.w) + a1[2], bfhi(xw.w) + a1[3]);
                            *(u32x4*)(X2B + e + bj * HALF) = w; } } }
        } else {
            bf16_t* pt = (bf16_t*)PART + (size_t)u.slot * 65536;
#pragma unroll
            for (int ai = 0; ai < 2; ++ai)
#pragma unroll
                for (int m = 0; m < 4; ++m) { bf16_t* o = pt + (size_t)(rl0 + ai * HALF + m * 16) * 256 + cl0;
#pragma unroll
                    for (int bj = 0; bj < 2; ++bj) { const f32x4 a0 = acc[ai][bj][m][0], a1 = acc[ai][bj][m][1];
                        u32x4 w; w.x = cvt_pk_bf16(a0[0], a0[1]); w.y = cvt_pk_bf16(a0[2], a0[3]); w.z = cvt_pk_bf16(a1[0], a1[1]); w.w = cvt_pk_bf16(a1[2], a1[3]); *(u32x4*)(o + bj * HALF) = w; } }
        }
    }
};

template <class Epi, class Sched, bool ALIGN_EPI = false, bool SP2 = false>
__device__ __forceinline__ void gemm_phase(LAS unsigned char* lds, const Gemm g, const Sched& S, const Epi& E, int wv) {
    int tid_ = opaque_tid(wv);
    const int tid = tid_, wid = __builtin_amdgcn_readfirstlane(tid >> 6), lane = tid & 63, wr = wid >> 2, wc = wid & 3, fr = lane & 15, fq = lane >> 4;
    const int K = g.K;
    unsigned voffA[2], voffB[2];
#pragma unroll
    for (int i = 0; i < 2; ++i) { int R, C; stage_rc(tid * 16 + i * 8192, R, C); const int Rb = Epi::PERM ? ((R & ~31) + perm32(R & 31)) : R;
        const int Ra = Epi::APERM ? ((R & ~63) + 4 * (R & 15) + ((R >> 4) & 3)) : R;
        voffA[i] = (unsigned)(Ra * K + C) * 2u; voffB[i] = (unsigned)(Rb * K + C) * 2u; }
    const size_t kstep = (size_t)(BK * 2);
    const size_t hstep = (size_t)HALF * K * 2;
    const size_t tstep = 2 * hstep;
    const unsigned ldsw = (unsigned)wid * 1024u;
    const int aoff = lds_byte(wr * 64 + fr, fq * 8), boff = lds_byte(wc * 32 + fr, fq * 8);
#define PG8_SA(b, h) (((b) * 2 + (h)) * HTB)
#define PG8_SB(b, h) ((4 + (b) * 2 + (h)) * HTB)
#define PG8_STAGE(bufoff, gbase, voff) do { _Pragma("unroll") for (int _i = 0; _i < 2; ++_i) \
        __builtin_amdgcn_global_load_lds((const unsigned*)((const char*)(gbase) + (voff)[_i]), (LAS unsigned*)(lds + (bufoff) + ldsw + _i * 8192), 16, 0, 0); } while (0)
#define PG8_LDA(dst, b, h) do { _Pragma("unroll") for (int m = 0; m < 4; ++m) _Pragma("unroll") for (int k = 0; k < 2; ++k) dst[m][k] = *(const LAS bf16x8*)(lds + PG8_SA(b, h) + aoff + m * 2048 + k * 1024); } while (0)
#define PG8_LDB(dst, b, h) do { _Pragma("unroll") for (int n = 0; n < 2; ++n) _Pragma("unroll") for (int k = 0; k < 2; ++k) dst[n][k] = *(const LAS bf16x8*)(lds + PG8_SB(b, h) + boff + n * 2048 + k * 1024); } while (0)
#define PG8_MMA(ai, bj, At, Bt) do { __builtin_amdgcn_s_setprio(1); _Pragma("unroll") for (int m = 0; m < 4; ++m) _Pragma("unroll") for (int n = 0; n < 2; ++n) _Pragma("unroll") for (int k = 0; k < 2; ++k) \
        acc[ai][bj][m][n] = __builtin_amdgcn_mfma_f32_16x16x32_bf16(Bt[n][k], At[m][k], acc[ai][bj][m][n], 0, 0, 0); __builtin_amdgcn_s_setprio(0); } while (0)
#define PG8_WAIT_V(n) asm volatile("s_waitcnt vmcnt(" #n ")" ::: "memory")
#define PG8_WAIT_L(n) asm volatile("s_waitcnt lgkmcnt(" #n ")" ::: "memory")
#define PG8_BAR __builtin_amdgcn_s_barrier()
#define PG8_SCHED __builtin_amdgcn_sched_barrier(0)
    Unit cur, nxt; int ui = 0;
    if (!S.next(0, cur)) return;
    f32x4 acc[2][2][4][2];
#pragma unroll
    for (int a = 0; a < 2; ++a)
#pragma unroll
        for (int b = 0; b < 2; ++b)
#pragma unroll
            for (int m = 0; m < 4; ++m)
#pragma unroll
                for (int n = 0; n < 2; ++n) acc[a][b][m][n] = (f32x4){0.f, 0.f, 0.f, 0.f};
    bf16x8 At[4][2], B0[2][2], B1[2][2];
    const char* cA = (const char*)g.A + (size_t)(g.a_mode ? up_row0(cur.pm) : cur.pm * BM) * K * 2 + (size_t)cur.kt0 * kstep; const char* cB = (const char*)g.Bt + (size_t)cur.pn * tstep + (size_t)cur.kt0 * kstep;
    S.a_ready(cur);
    auto krot = [](const Unit& u) -> int { return (MK_KROT && !Epi::HAS_MID && u.kind == 0) ? (((((u.pm + 2 * u.pn) & 7) * u.nt) >> 3) & ~1) : 0; };
    int crot = krot(cur);
    { const char* fA = cA + (size_t)crot * kstep; const char* fB = cB + (size_t)crot * kstep;
    if constexpr (SP2) {
        PG8_STAGE(PG8_SB(0, 0), fB, voffB); PG8_STAGE(PG8_SB(0, 1), fB + hstep, voffB); PG8_STAGE(PG8_SA(0, 0), fA, voffA); PG8_STAGE(PG8_SA(0, 1), fA + hstep, voffA);
        if (wr == 1) PG8_BAR;
        PG8_WAIT_V(2); PG8_BAR;
        PG8_STAGE(PG8_SB(1, 0), fB + kstep, voffB); PG8_STAGE(PG8_SA(1, 0), fA + kstep, voffA); PG8_STAGE(PG8_SB(1, 1), fB + hstep + kstep, voffB);
        PG8_WAIT_V(6); PG8_BAR;
    } else {
        PG8_STAGE(PG8_SB(0, 0), fB, voffB); PG8_STAGE(PG8_SA(0, 0), fA, voffA); PG8_STAGE(PG8_SB(0, 1), fB + hstep, voffB); PG8_STAGE(PG8_SA(0, 1), fA + hstep, voffA);
        if (wr == 1) PG8_BAR;
        PG8_WAIT_V(4); PG8_BAR;
        PG8_STAGE(PG8_SB(1, 0), fB + kstep, voffB); PG8_STAGE(PG8_SA(1, 0), fA + kstep, voffA); PG8_STAGE(PG8_SB(1, 1), fB + hstep + kstep, voffB);
        PG8_WAIT_V(6); PG8_BAR;
    } }
    for (;;) {
        const bool has_next = S.next(ui + 1, nxt);
        const char* nA = has_next ? (const char*)g.A + (size_t)(g.a_mode ? up_row0(nxt.pm) : nxt.pm * BM) * K * 2 + (size_t)nxt.kt0 * kstep : cA; const char* nB = has_next ? (const char*)g.Bt + (size_t)nxt.pn * tstep + (size_t)nxt.kt0 * kstep : cB;
        const int nt = cur.nt; const int nrot = has_next ? krot(nxt) : 0;
        for (int t = 0; t < nt; t += 2) {
            const bool last = (t == nt - 2);
            int k1 = crot + t + 1, k2 = crot + t + 2; if (k1 >= nt) k1 -= nt; if (k2 >= nt) k2 -= nt;
            const char* a1 = cA + (size_t)k1 * kstep;
            const char* a2 = last ? nA + (size_t)nrot * kstep : cA + (size_t)k2 * kstep; const char* b2 = last ? nB + (size_t)nrot * kstep : cB + (size_t)k2 * kstep;
            const char* a3 = a2 + kstep; const char* b3 = b2 + kstep;
            if (last && has_next) S.a_ready(nxt);
            if constexpr (Epi::HAS_MID) { if (cur.kind == 0 && t == (nt >> 1)) E.mid(acc, cur, wr, wc, fr, fq); }
            if constexpr (SP2) {
            PG8_LDB(B0, 0, 0); PG8_LDB(B1, 0, 1); PG8_SCHED; PG8_LDA(At, 0, 0); PG8_STAGE(PG8_SA(1, 1), a1 + hstep, voffA);
            PG8_WAIT_V(8); PG8_WAIT_L(0); PG8_BAR; PG8_MMA(0, 0, At, B0); PG8_MMA(0, 1, At, B1); PG8_BAR; PG8_SCHED;
            PG8_LDA(At, 0, 1); PG8_STAGE(PG8_SB(0, 0), b2, voffB); PG8_STAGE(PG8_SB(0, 1), b2 + hstep, voffB); PG8_STAGE(PG8_SA(0, 0), a2, voffA);
            PG8_WAIT_V(8); PG8_WAIT_L(0); PG8_BAR; PG8_MMA(1, 0, At, B0); PG8_MMA(1, 1, At, B1); PG8_BAR; PG8_SCHED;
            PG8_LDB(B0, 1, 0); PG8_LDB(B1, 1, 1); PG8_SCHED; PG8_LDA(At, 1, 0); PG8_STAGE(PG8_SA(0, 1), a2 + hstep, voffA);
            PG8_WAIT_V(8); PG8_WAIT_L(0); PG8_BAR; PG8_MMA(0, 0, At, B0); PG8_MMA(0, 1, At, B1); PG8_BAR; PG8_SCHED;
            PG8_LDA(At, 1, 1); PG8_STAGE(PG8_SB(1, 0), b3, voffB); PG8_STAGE(PG8_SB(1, 1), b3 + hstep, voffB); PG8_STAGE(PG8_SA(1, 0), a3, voffA);
            PG8_WAIT_V(8); PG8_WAIT_L(0); PG8_BAR; PG8_MMA(1, 0, At, B0); PG8_MMA(1, 1, At, B1); PG8_BAR; PG8_SCHED;
            } else {
            PG8_LDB(B0, 0, 0); PG8_SCHED; PG8_LDA(At, 0, 0); PG8_STAGE(PG8_SA(1, 1), a1 + hstep, voffA);
            PG8_WAIT_L(8); PG8_BAR; PG8_WAIT_L(0); PG8_MMA(0, 0, At, B0); PG8_BAR; PG8_SCHED;
            PG8_LDB(B1, 0, 1); PG8_STAGE(PG8_SB(0, 0), b2, voffB);
            PG8_BAR; PG8_WAIT_L(0); PG8_MMA(0, 1, At, B1); PG8_BAR;
            PG8_LDA(At, 0, 1); PG8_STAGE(PG8_SA(0, 0), a2, voffA);
            PG8_BAR; PG8_WAIT_L(0); PG8_MMA(1, 0, At, B0); PG8_BAR; PG8_SCHED;
            PG8_STAGE(PG8_SB(0, 1), b2 + hstep, voffB);
            PG8_WAIT_V(6); PG8_BAR; PG8_MMA(1, 1, At, B1); PG8_BAR;
            PG8_LDB(B0, 1, 0); PG8_SCHED; PG8_LDA(At, 1, 0); PG8_STAGE(PG8_SA(0, 1), a2 + hstep, voffA);
            PG8_WAIT_L(8); PG8_BAR; PG8_WAIT_L(0); PG8_MMA(0, 0, At, B0); PG8_BAR; PG8_SCHED;
            PG8_LDB(B1, 1, 1); PG8_STAGE(PG8_SB(1, 0), b3, voffB);
            PG8_BAR; PG8_WAIT_L(0); PG8_MMA(0, 1, At, B1); PG8_BAR;
            PG8_LDA(At, 1, 1); PG8_STAGE(PG8_SA(1, 0), a3, voffA);
            PG8_BAR; PG8_WAIT_L(0); PG8_MMA(1, 0, At, B0); PG8_BAR; PG8_SCHED;
            PG8_STAGE(PG8_SB(1, 1), b3 + hstep, voffB);
            PG8_WAIT_V(6); PG8_BAR; PG8_MMA(1, 1, At, B1); PG8_BAR;
            }
        }
        if constexpr (ALIGN_EPI) { if (wr == 0) PG8_BAR; }
        if constexpr (Epi::TAIL_REDUCE) {
            if (cur.kind == 1) {
                const int tix = cur.slot / E.S, sl = cur.slot - tix * E.S; LAS unsigned* bw = (LAS unsigned*)(lds + STAGE_BYTES + 8192);
                { const __amdgpu_buffer_rsrc_t rs = __builtin_amdgcn_make_buffer_rsrc(E.PART, 0, 0x7fffffff, 0x00020000); const unsigned base = ((unsigned)cur.slot * 8192u + (unsigned)tid) * 16u;
#pragma unroll
                  for (int a = 0; a < 2; ++a)
#pragma unroll
                      for (int b = 0; b < 2; ++b)
#pragma unroll
                          for (int m = 0; m < 4; ++m) { const f32x4 a0 = acc[a][b][m][0], a1 = acc[a][b][m][1];
                              u32x4 w; w.x = cvt_pk_bf16(a0[0], a0[1]); w.y = cvt_pk_bf16(a0[2], a0[3]); w.z = cvt_pk_bf16(a1[0], a1[1]); w.w = cvt_pk_bf16(a1[2], a1[3]);
                              __builtin_amdgcn_raw_buffer_store_b128(w, rs, base + (unsigned)(((a * 2 + b) * 4 + m) * 512 * 16), 0, 16); } }
                asm volatile("s_waitcnt vmcnt(0)" ::: "memory"); PG8_BAR; asm volatile("" ::: "memory");
                if (tid == 0) { (void)__hip_atomic_fetch_add(E.tcnt + tix, 1u, __ATOMIC_RELAXED, __HIP_MEMORY_SCOPE_AGENT);
                    unsigned sp = 0; while (__hip_atomic_load(E.tcnt + tix, __ATOMIC_RELAXED, __HIP_MEMORY_SCOPE_AGENT) < (unsigned)E.S) { __builtin_amdgcn_s_sleep(2); if (++sp > (1u << 22)) break; }
                    __builtin_amdgcn_fence(__ATOMIC_ACQUIRE, "agent"); }
                asm volatile("s_waitcnt vmcnt(0) lgkmcnt(0)" ::: "memory"); PG8_BAR; asm volatile("" ::: "memory");
                __builtin_amdgcn_fence(__ATOMIC_ACQUIRE, "agent"); asm volatile("s_waitcnt vmcnt(0)" ::: "memory");
                const int per = 32 / E.S, i0 = sl * per, sa_ = i0 >> 4, sb_ = (i0 >> 3) & 1, m0 = (i0 >> 1) & 3, nm = per >> 1;
                f32x4 sA[4][2], sB[4][2];
#pragma unroll
                for (int mi = 0; mi < 4; ++mi)
#pragma unroll
                    for (int n = 0; n < 2; ++n) { sA[mi][n] = (f32x4){0.f, 0.f, 0.f, 0.f}; sB[mi][n] = (f32x4){0.f, 0.f, 0.f, 0.f}; }
#pragma unroll 1
                for (int s2 = 0; s2 < E.S; ++s2) {
                    const u32x4* pp = (const u32x4*)((const char*)E.PART + (size_t)(tix * E.S + s2) * 131072) + tid + (i0 >> 1) * 512; f32x4 tq[4][2];
#pragma unroll
                    for (int mi = 0; mi < 4; ++mi) { u32x4 pw = {0u, 0u, 0u, 0u}; if (mi < nm) pw = pp[mi * 512];
                        tq[mi][0] = (f32x4){__builtin_bit_cast(float, pw.x << 16), __builtin_bit_cast(float, pw.x & 0xffff0000u), __builtin_bit_cast(float, pw.y << 16), __builtin_bit_cast(float, pw.y & 0xffff0000u)};
                        tq[mi][1] = (f32x4){__builtin_bit_cast(float, pw.z << 16), __builtin_bit_cast(float, pw.z & 0xffff0000u), __builtin_bit_cast(float, pw.w << 16), __builtin_bit_cast(float, pw.w & 0xffff0000u)}; }
                    const bool second = Epi::HAS_MID && (s2 >= (E.S >> 1));
#pragma unroll
                    for (int mi = 0; mi < 4; ++mi)
#pragma unroll
                        for (int n = 0; n < 2; ++n) { if (second) sB[mi][n] += tq[mi][n]; else sA[mi][n] += tq[mi][n]; } }
                E.strip(sA, sB, cur, wr, wc, fr, fq, sa_, sb_, m0, nm);
            } else E(acc, cur, wr, wc, fr, fq);
        } else E(acc, cur, wr, wc, fr, fq);
        S.done(cur);
        if (!has_next) break;
#pragma unroll
        for (int a = 0; a < 2; ++a)
#pragma unroll
            for (int b = 0; b < 2; ++b)
#pragma unroll
                for (int m = 0; m < 4; ++m)
#pragma unroll
                    for (int n = 0; n < 2; ++n) acc[a][b][m][n] = (f32x4){0.f, 0.f, 0.f, 0.f};
        cur = nxt; cA = nA; cB = nB; crot = nrot; ++ui;
        if constexpr (ALIGN_EPI) { if (wr == 1) PG8_BAR; }
    }
    PG8_WAIT_V(0);
    if constexpr (!ALIGN_EPI) { if (wr == 0) PG8_BAR; }
    PG8_BAR;
#undef PG8_SA
#undef PG8_SB
#undef PG8_STAGE
#undef PG8_LDA
#undef PG8_LDB
#undef PG8_MMA
#undef PG8_WAIT_V
#undef PG8_WAIT_L
#undef PG8_BAR
#undef PG8_SCHED
}
}

constexpr int LDS_BYTES = 159744;
constexpr int NTHREADS = 512;

__device__ __forceinline__ void tr_item(const float* W, int ldw, int k0, int ns0, bf16_t* WT, int ldt, int nd0, int kd0, const float* kscale, float cs, LAS float* scr, int lane) {
    float wv_[32];
#pragma unroll
    for (int i = 0; i < 32; ++i) wv_[i] = W[(size_t)(k0 + 2 * i + (lane >> 5)) * ldw + ns0 + (lane & 31)];
#pragma unroll
    for (int i = 0; i < 32; ++i) { const int kk = 2 * i + (lane >> 5); const float s = kscale ? kscale[k0 + kk] * cs : cs; scr[kk * 33 + (lane & 31)] = wv_[i] * s; }
    asm volatile("s_waitcnt lgkmcnt(0)" ::: "memory");
    const int c = lane & 7;
#pragma unroll
    for (int j = 0; j < 4; ++j) { const int n = (lane >> 3) + 8 * j; const LAS float* s = scr + (8 * c) * 33 + n;
        u32x4 o; o.x = pk2(s[0 * 33], s[1 * 33]); o.y = pk2(s[2 * 33], s[3 * 33]); o.z = pk2(s[4 * 33], s[5 * 33]); o.w = pk2(s[6 * 33], s[7 * 33]);
        *(u32x4*)(WT + (size_t)(nd0 + n) * ldt + kd0 + k0 + 8 * c) = o; }
    asm volatile("s_waitcnt lgkmcnt(0)" ::: "memory");
}
__device__ __forceinline__ void phase_prep(const P& p, LAS unsigned char* lds, int bid, int nb, int wv) {
    const int tid = opaque_tid(wv), lane = tid & 63, wave = tid >> 6;
    unsigned char* ws = p.ws;
    LAS float* scr = (LAS float*)(lds + wave * 8448);
    LAS float* wg = (LAS float*)(lds + 8 * 8448);
    const float* w_in = p.in[I_WIN];
    for (int i = tid; i < 8192; i += NTHREADS) { const int k = i >> 3, j = i & 7; wg[j * 1024 + k] = w_in[(size_t)k * NIN + 5120 + j]; }
    __syncthreads();
    const int gw = wave * nb + bid, NGW = nb * 8;
    constexpr int I_IN = 16 * 224;
    for (int it = gw; it < I_IN; it += NGW) { const int kb = it / 224, nbk = it % 224, n0 = nbk * 32; const int ns0 = n0 + (n0 >= 5120 ? 8 : 0); const float cs = (n0 >= ZC_Q && n0 < ZC_K) ? 0.0625f : 1.0f;
        tr_item(w_in, NIN, kb * 64, ns0, (bf16_t*)(ws + WS_WIN), 1024, n0, 0, nullptr, cs, scr, lane); }
    { bf16_t* WL = (bf16_t*)(ws + WS_WLRU);
      for (int e = bid * NTHREADS + tid; e < 2 * 65536; e += nb * NTHREADS) { const int gate = e >> 16, n = (e >> 12) & 15, d = (e >> 6) & 63, c = e & 63;
          WL[e] = (bf16_t)f2bf((gate ? p.in[I_LWI] : p.in[I_LWR])[(size_t)(n * 64 + c) * 64 + d]); }
    }
    { float* ssq = (float*)(ws + WS_SSQ); for (int i = bid * NTHREADS + tid; i < MPAD; i += nb * NTHREADS) ssq[i] = 0.f; }
    { float* bias1 = (float*)(ws + WS_SMALL); const float* b_in = p.in[I_BIN];
      for (int n = bid * NTHREADS + tid; n < NZ; n += nb * NTHREADS) { const float cs = (n >= ZC_Q && n < ZC_K) ? 0.0625f : 1.0f; bias1[n] = b_in[n + (n >= 5120 ? 8 : 0)] * cs; } }
    { bf16_t* XN = (bf16_t*)(ws + WS_XN); float* gates = (float*)(ws + WS_SMALL + 65536); const float* g1 = p.in[I_G1]; const float* b_in = p.in[I_BIN];
      f32x4 vn[4];
      if (gw < MTOK) { const f32x4* xr = (const f32x4*)xrow_ptr(p, gw) + lane;
#pragma unroll
          for (int j = 0; j < 4; ++j) vn[j] = xr[64 * j]; }
      for (int m = gw; m < MTOK; m += NGW) {
          f32x4 v[4]; float s = 0.f;
#pragma unroll
          for (int j = 0; j < 4; ++j) v[j] = vn[j];
          if (m + NGW < MTOK) { const f32x4* xr = (const f32x4*)xrow_ptr(p, m + NGW) + lane;
#pragma unroll
              for (int j = 0; j < 4; ++j) vn[j] = xr[64 * j]; }
#pragma unroll
          for (int j = 0; j < 4; ++j) s += (v[j].x * v[j].x + v[j].y * v[j].y) + (v[j].z * v[j].z + v[j].w * v[j].w);
          const float rstd = 1.0f / sqrtf(wave_sum(s) * (1.0f / D) + EPS);
          unsigned long long* o8 = (unsigned long long*)(XN + (size_t)m * D) + lane;
          float ga[8];
#pragma unroll
          for (int q = 0; q < 8; ++q) ga[q] = 0.f;
#pragma unroll
          for (int j = 0; j < 4; ++j) { const f32x4 gg = ((const f32x4*)g1)[lane + 64 * j]; v[j] = v[j] * rstd * gg;
              o8[64 * j] = (unsigned long long)pk2(v[j].x, v[j].y) | ((unsigned long long)pk2(v[j].z, v[j].w) << 32);
#pragma unroll
              for (int q = 0; q < 8; ++q) { const f32x4 w = *(const LAS f32x4*)(wg + q * 1024 + 4 * (lane + 64 * j)); ga[q] += (v[j].x * w.x + v[j].y * w.y) + (v[j].z * w.z + v[j].w * w.w); } }
#pragma unroll
          for (int q = 0; q < 8; ++q) ga[q] = wave_sum(ga[q]);
          if (lane < 8) { float r = ga[0];
#pragma unroll
              for (int q = 1; q < 8; ++q) r = (lane == q) ? ga[q] : r;
              gates[(size_t)m * 8 + lane] = r + b_in[5120 + lane]; }
      } }
}

__device__ __forceinline__ void lru_load8(const bf16_t* Z, const float* st, int row0, int L, int tok, int ch, float (&o)[8]) {
    if (tok >= 0) { const int tc = tok < L ? tok : L - 1; const u32x4 w = *(const u32x4*)(Z + (size_t)(row0 + tc) * NZ + ZC_U + ch);
        o[0] = bflo(w.x); o[1] = bfhi(w.x); o[2] = bflo(w.y); o[3] = bfhi(w.y); o[4] = bflo(w.z); o[5] = bfhi(w.z); o[6] = bflo(w.w); o[7] = bfhi(w.w); }
    else if (st) { const f32x4 a = *(const f32x4*)(st + (size_t)(3 + tok) * D + ch), b = *(const f32x4*)(st + (size_t)(3 + tok) * D + ch + 4);
        o[0] = a.x; o[1] = a.y; o[2] = a.z; o[3] = a.w; o[4] = b.x; o[5] = b.y; o[6] = b.z; o[7] = b.w; }
    else {
#pragma unroll
        for (int q = 0; q < 8; ++q) o[q] = 0.f; }
}
__device__ __forceinline__ void phase_lru(const P& p, LAS unsigned char* lds, int bid, int nb, int wv, int it_lo, int it_hi) {
    const int tid = opaque_tid(wv), lane = tid & 63, w = __builtin_amdgcn_readfirstlane(tid >> 6), g = lane >> 4, li = lane & 15;
    const bf16_t* Z = (const bf16_t*)(p.ws + WS_Z); bf16_t* ACAT = (bf16_t*)(p.ws + WS_ACAT); bf16_t* PCUM = (bf16_t*)(p.ws + WS_PCUM);
    float* AGG = (float*)(p.ws + WS_AGG); float* CARRY = (float*)(p.ws + WS_CARRY); const bf16_t* WL = (const bf16_t*)(p.ws + WS_WLRU); unsigned* cnt = (unsigned*)(p.ws + WS_CTL);
    LAS float* cwL = (LAS float*)(lds + w * 6400);
    LAS float* ucL = cwL + 320;
    LAS float* gbL = cwL + 1408;
    const int n = bid & 15;
    LAS unsigned char* wls = lds + 8 * 6400;
    for (int i = tid; i < 1024; i += NTHREADS) { const int row = i >> 3, ch8 = i & 7; *(LAS u32x4*)(wls + row * 144 + ch8 * 16) = *(const u32x4*)(WL + (size_t)((row >> 6) * 16 + n) * 4096 + (row & 63) * 64 + ch8 * 8); }
    __syncthreads();
    constexpr int NPI = NBP * NSEGP, NIT = NPI + DECB;
    const int nwv = (nb >> 4) * 8;
    for (int it = it_lo + (bid >> 4) * 8 + w; it < (it_hi < NIT ? it_hi : NIT); it += nwv) {
        int s, seg;
        constexpr int NFULL = NBP * (NSEGP - 1);
        if (it < NFULL) { seg = it % (NSEGP - 1); s = it / (NSEGP - 1); } else if (it < NPI) { s = it - NFULL; seg = NSEGP - 1; } else { s = NBP + (it - NPI); seg = 0; }
        int row0, L; seq_info(s, row0, L);
        const int tb = seg * LSEG, te = (tb + LSEG < L) ? tb + LSEG : L, ntile = (te - tb + 15) >> 4;
        const float* st = (s >= NBP) ? p.in[I_SLC] + (size_t)(s - NBP) * 3 * D : nullptr;
        { const int ch = n * 64 + lane; cwL[lane] = p.in[I_LCW][ch]; cwL[64 + lane] = p.in[I_LCW][D + ch]; cwL[128 + lane] = p.in[I_LCW][2 * D + ch]; cwL[192 + lane] = p.in[I_LCW][3 * D + ch]; cwL[256 + lane] = p.in[I_LCB][ch]; }
        { const int ch = n * 64 + lane; const float lam = p.in[I_LAM][ch]; gbL[lane] = p.in[I_LBR][ch]; gbL[64 + lane] = p.in[I_LBI][ch]; gbL[128 + lane] = 8.0f * (fmaxf(-lam, 0.f) + log1pf(__expf(-fabsf(lam)))); }
        float hc[4], pc[4];
#pragma unroll
        for (int q = 0; q < 4; ++q) { const int ch = n * 64 + 16 * q + li; hc[q] = (s >= NBP) ? p.in[I_SLH][(size_t)(s - NBP) * D + ch] : 0.f; pc[q] = 1.f; }
        const int cA = n * 64 + 8 * g, cB = cA + 32;
        u32x4 rwa[4], rwb[4];
#define LRU_LOADRAW(tt0_) do { _Pragma("unroll") for (int d = 0; d < 4; ++d) { int tok = (tt0_) + li - 3 + d; tok = tok < 0 ? 0 : (tok < L ? tok : L - 1); \
            const bf16_t* zr = Z + (size_t)(row0 + tok) * NZ + ZC_U; rwa[d] = *(const u32x4*)(zr + cA); rwb[d] = *(const u32x4*)(zr + cB); } } while (0)
        LRU_LOADRAW(tb);
        for (int tile = 0; tile < ntile; ++tile) {
            const int tt0 = tb + tile * 16, t = tt0 + li;
            float ucA[8], ucB[8];
            { const f32x4 b0 = *(const LAS f32x4*)(cwL + 256 + 8 * g), b1 = *(const LAS f32x4*)(cwL + 256 + 8 * g + 4), b2 = *(const LAS f32x4*)(cwL + 256 + 32 + 8 * g), b3 = *(const LAS f32x4*)(cwL + 256 + 32 + 8 * g + 4);
              ucA[0] = b0.x; ucA[1] = b0.y; ucA[2] = b0.z; ucA[3] = b0.w; ucA[4] = b1.x; ucA[5] = b1.y; ucA[6] = b1.z; ucA[7] = b1.w;
              ucB[0] = b2.x; ucB[1] = b2.y; ucB[2] = b2.z; ucB[3] = b2.w; ucB[4] = b3.x; ucB[5] = b3.y; ucB[6] = b3.z; ucB[7] = b3.w; }
#pragma unroll
            for (int d = 0; d < 4; ++d) { float ua[8], ub[8]; unpack8(rwa[d], ua); unpack8(rwb[d], ub);
                if (tt0 == 0 && t - 3 + d < 0) { lru_load8(Z, st, row0, L, t - 3 + d, cA, ua); lru_load8(Z, st, row0, L, t - 3 + d, cB, ub); }
                const f32x4 w0 = *(const LAS f32x4*)(cwL + d * 64 + 8 * g), w1 = *(const LAS f32x4*)(cwL + d * 64 + 8 * g + 4), w2 = *(const LAS f32x4*)(cwL + d * 64 + 32 + 8 * g), w3 = *(const LAS f32x4*)(cwL + d * 64 + 32 + 8 * g + 4);
                ucA[0] += w0.x * ua[0]; ucA[1] += w0.y * ua[1]; ucA[2] += w0.z * ua[2]; ucA[3] += w0.w * ua[3]; ucA[4] += w1.x * ua[4]; ucA[5] += w1.y * ua[5]; ucA[6] += w1.z * ua[6]; ucA[7] += w1.w * ua[7];
                ucB[0] += w2.x * ub[0]; ucB[1] += w2.y * ub[1]; ucB[2] += w2.z * ub[2]; ucB[3] += w2.w * ub[3]; ucB[4] += w3.x * ub[4]; ucB[5] += w3.y * ub[5]; ucB[6] += w3.z * ub[6]; ucB[7] += w3.w * ub[7]; }
            if (tile + 1 < ntile) LRU_LOADRAW(tt0 + 16);
            *(LAS f32x4*)(ucL + li * 68 + 8 * g) = (f32x4){ucA[0], ucA[1], ucA[2], ucA[3]}; *(LAS f32x4*)(ucL + li * 68 + 8 * g + 4) = (f32x4){ucA[4], ucA[5], ucA[6], ucA[7]};
            *(LAS f32x4*)(ucL + li * 68 + 32 + 8 * g) = (f32x4){ucB[0], ucB[1], ucB[2], ucB[3]}; *(LAS f32x4*)(ucL + li * 68 + 32 + 8 * g + 4) = (f32x4){ucB[4], ucB[5], ucB[6], ucB[7]};
            bf16x8 af[2];
            { u32x4 a0, a1; a0.x = pk2(ucA[0], ucA[1]); a0.y = pk2(ucA[2], ucA[3]); a0.z = pk2(ucA[4], ucA[5]); a0.w = pk2(ucA[6], ucA[7]);
              a1.x = pk2(ucB[0], ucB[1]); a1.y = pk2(ucB[2], ucB[3]); a1.z = pk2(ucB[4], ucB[5]); a1.w = pk2(ucB[6], ucB[7]);
              af[0] = __builtin_bit_cast(bf16x8, a0); af[1] = __builtin_bit_cast(bf16x8, a1); }
            f32x4 ra[4], ia[4];
#pragma unroll
            for (int q = 0; q < 4; ++q) { ra[q] = (f32x4){0.f, 0.f, 0.f, 0.f}; ia[q] = (f32x4){0.f, 0.f, 0.f, 0.f};
#pragma unroll
                for (int k = 0; k < 2; ++k) { const bf16x8 wr0 = *(const LAS bf16x8*)(wls + (16 * q + li) * 144 + (32 * k + 8 * g) * 2), wi0 = *(const LAS bf16x8*)(wls + (64 + 16 * q + li) * 144 + (32 * k + 8 * g) * 2);
                    ra[q] = __builtin_amdgcn_mfma_f32_16x16x32_bf16(af[k], wr0, ra[q], 0, 0, 0); ia[q] = __builtin_amdgcn_mfma_f32_16x16x32_bf16(af[k], wi0, ia[q], 0, 0, 0); } }
            asm volatile("s_waitcnt lgkmcnt(0)" ::: "memory");
#pragma unroll
            for (int q = 0; q < 4; ++q) {
                const float brq = gbL[16 * q + li], biq = gbL[64 + 16 * q + li], sp8q = gbL[128 + 16 * q + li];
                float av[4], hv[4], pv[4];
                {
                    constexpr float L2E = 1.4426950408889634f;
                    const f32x4 uc4 = {ucL[(4 * g + 0) * 68 + 16 * q + li], ucL[(4 * g + 1) * 68 + 16 * q + li], ucL[(4 * g + 2) * 68 + 16 * q + li], ucL[(4 * g + 3) * 68 + 16 * q + li]};
                    const f32x4 xr = (ra[q] + brq) * (-L2E), xi = (ia[q] + biq) * (-L2E);
                    const f32x4 dr = (f32x4){__builtin_amdgcn_exp2f(xr[0]), __builtin_amdgcn_exp2f(xr[1]), __builtin_amdgcn_exp2f(xr[2]), __builtin_amdgcn_exp2f(xr[3])} + 1.0f;
                    const f32x4 di = (f32x4){__builtin_amdgcn_exp2f(xi[0]), __builtin_amdgcn_exp2f(xi[1]), __builtin_amdgcn_exp2f(xi[2]), __builtin_amdgcn_exp2f(xi[3])} + 1.0f;
                    const f32x4 rg = {__builtin_amdgcn_rcpf(dr[0]), __builtin_amdgcn_rcpf(dr[1]), __builtin_amdgcn_rcpf(dr[2]), __builtin_amdgcn_rcpf(dr[3])};
                    const f32x4 ig = {__builtin_amdgcn_rcpf(di[0]), __builtin_amdgcn_rcpf(di[1]), __builtin_amdgcn_rcpf(di[2]), __builtin_amdgcn_rcpf(di[3])};
                    const f32x4 la = rg * (-sp8q), y = la + la, le = la * L2E;
                    const f32x4 a4 = {__builtin_amdgcn_exp2f(le[0]), __builtin_amdgcn_exp2f(le[1]), __builtin_amdgcn_exp2f(le[2]), __builtin_amdgcn_exp2f(le[3])};
                    const f32x4 ser = (0.0f - y) * (1.0f + y * (0.5f + y * (0.16666667f + y * (0.041666668f + y * 0.0083333338f)))), dir = 1.0f - a4 * a4;
                    const f32x4 iu = ig * uc4;
#pragma unroll
                    for (int r = 0; r < 4; ++r) { const float om = (y[r] > -0.125f) ? ser[r] : dir[r]; float a = a4[r], inp = __builtin_amdgcn_sqrtf(om) * iu[r];
                        if (tt0 + 4 * g + r >= te) { a = 1.f; inp = 0.f; }
                        av[r] = a; hv[r] = inp; } }
                pv[0] = av[0];
#pragma unroll
                for (int r = 1; r < 4; ++r) { hv[r] = av[r] * hv[r - 1] + hv[r]; pv[r] = av[r] * pv[r - 1]; }
                float Pg[4], Hg[4];
#pragma unroll
                for (int x = 0; x < 4; ++x) { Pg[x] = __shfl(pv[3], li + 16 * x); Hg[x] = __shfl(hv[3], li + 16 * x); }
                float cin = hc[q], pin = pc[q], mycin = cin, mypin = pin;
#pragma unroll
                for (int x = 0; x < 4; ++x) { cin = Hg[x] + Pg[x] * cin; pin = Pg[x] * pin; if (g == x + 1) { mycin = cin; mypin = pin; } }
                hc[q] = cin; pc[q] = pin;
                { const unsigned ao = ((unsigned)(row0 + tt0 + 4 * g) * 2048u + (unsigned)(n * 64 + li)) * 2u, po = ((unsigned)(row0 + tt0 + 4 * g) * (unsigned)D + (unsigned)(n * 64 + li)) * 2u;
                  if (tt0 + 16 <= te) {
#pragma unroll
                      for (int r = 0; r < 4; ++r) { *(bf16_t*)((char*)ACAT + (ao + (unsigned)(r * 4096 + q * 32))) = (bf16_t)f2bf(hv[r] + pv[r] * mycin);
                          if (seg > 0) *((unsigned char*)PCUM + ((po >> 1) + (unsigned)(r * D + q * 16))) = (unsigned char)q8(pv[r] * mypin, 0u); }
                  } else {
#pragma unroll
                      for (int r = 0; r < 4; ++r) { if (tt0 + 4 * g + r < te) { *(bf16_t*)((char*)ACAT + (ao + (unsigned)(r * 4096 + q * 32))) = (bf16_t)f2bf(hv[r] + pv[r] * mycin);
                          if (seg > 0) *((unsigned char*)PCUM + ((po >> 1) + (unsigned)(r * D + q * 16))) = (unsigned char)q8(pv[r] * mypin, 0u); } } } }
            }
        }
        const int lane = lane_id_volatile(), g = lane >> 4, li = lane & 15;
        if (te == L) { float* oc = (s < NBP) ? p.out + O_PLC + (size_t)s * 3 * D : p.out + O_SLC + (size_t)(s - NBP) * 3 * D; const int ch = n * 64 + lane;
#pragma unroll
            for (int i = 0; i < 3; ++i) oc[(size_t)i * D + ch] = bf2f(Z[(size_t)(row0 + L - 3 + i) * NZ + ZC_U + ch]); }
        if (s >= NBP) { if (g == 0) {
#pragma unroll
            for (int q = 0; q < 4; ++q) p.out[O_SLH + (size_t)(s - NBP) * D + n * 64 + 16 * q + li] = hc[q]; } }
        else {
            if (g == 0) {
#pragma unroll
                for (int q = 0; q < 4; ++q) { float* ag = AGG + ((size_t)(s * NSEGP + seg) * D + n * 64 + 16 * q + li) * 2;
                    __hip_atomic_store(ag, pc[q], __ATOMIC_RELAXED, __HIP_MEMORY_SCOPE_AGENT); __hip_atomic_store(ag + 1, hc[q], __ATOMIC_RELAXED, __HIP_MEMORY_SCOPE_AGENT); } }
            asm volatile("s_waitcnt vmcnt(0)" ::: "memory");
            unsigned old = 0; if (lane == 0) old = __hip_atomic_fetch_add(cnt + s * 16 + n, 1u, __ATOMIC_RELAXED, __HIP_MEMORY_SCOPE_AGENT);
            old = (unsigned)__builtin_amdgcn_readfirstlane((int)old);
            if (old == NSEGP - 1) {
                __builtin_amdgcn_fence(__ATOMIC_ACQUIRE, "agent");
                const int ch = n * 64 + lane; const float* ag0 = AGG + ((size_t)(s * NSEGP) * D + ch) * 2;
                float Pv[NSEGP], Ev[NSEGP];
#pragma unroll
                for (int sg = 0; sg < NSEGP; ++sg) { Pv[sg] = __hip_atomic_load(ag0 + (size_t)sg * D * 2, __ATOMIC_RELAXED, __HIP_MEMORY_SCOPE_AGENT); Ev[sg] = __hip_atomic_load(ag0 + (size_t)sg * D * 2 + 1, __ATOMIC_RELAXED, __HIP_MEMORY_SCOPE_AGENT); }
                float c = 0.f;
#pragma unroll
                for (int sg = 0; sg < NSEGP; ++sg) { CARRY[(size_t)(s * NSEGP + sg) * D + ch] = c; c = Ev[sg] + Pv[sg] * c; }
                p.out[O_PLH + (size_t)s * D + ch] = c; }
        }
        asm volatile("s_waitcnt lgkmcnt(0)" ::: "memory");
    }
#undef LRU_LOADRAW
}

constexpr int ML_RS = 528, ML_VS = 144;
constexpr int ML_Q = 0, ML_K = 33792, ML_CT = 67584, ML_VT = 101376, ML_WV = 110592, ML_SW = 119808, ML_N = 129024, ML_GA = 130048, ML_QN = 131328, ML_DEN = 131584, ML_SC = 132096;
typedef short v4s __attribute__((ext_vector_type(4)));
__device__ __forceinline__ int vt_off(int R, int gi) { return R * ML_VS + ((gi ^ ((R >> 3) & 7)) << 4); }
__device__ __forceinline__ float scan_sum64(float x, int lane) {
#pragma unroll
    for (int o = 1; o < 64; o <<= 1) { const float t = __shfl_up(x, o); if (lane >= o) x += t; }
    return x;
}
__device__ __forceinline__ float scan_max64(float x, int lane) {
#pragma unroll
    for (int o = 1; o < 64; o <<= 1) { const float t = __shfl_up(x, o); if (lane >= o) x = fmaxf(x, t); }
    return x;
}
constexpr int ML_AL = 132160, ML_BL = ML_AL + 8448, ML_ML = ML_BL + 8448, ML_NT = ML_ML + 8448;
__device__ __forceinline__ void phase_mlstm(const P& p, LAS unsigned char* lds, int bid, int nb, int wv) {
    const int tid = opaque_tid(wv), lane = tid & 63, w = __builtin_amdgcn_readfirstlane(tid >> 6), g = lane >> 4, li = lane & 15;
    const bf16_t* Z = (const bf16_t*)(p.ws + WS_Z); bf16_t* ACAT = (bf16_t*)(p.ws + WS_ACAT); const float* gates = (const float*)(p.ws + WS_SMALL + 65536);
    LAS float* nL = (LAS float*)(lds + ML_N); LAS float* wkL = (LAS float*)(lds + ML_GA); LAS float* totL = wkL + 64; LAS float* cmxL = wkL + 128;
    LAS float* qnL = (LAS float*)(lds + ML_QN); LAS float* denL = (LAS float*)(lds + ML_DEN);
    LAS float* aL = (LAS float*)(lds + ML_AL); LAS float* BL = (LAS float*)(lds + ML_BL); LAS float* ML_ = (LAS float*)(lds + ML_ML);
    for (int it = bid; it < NBP * 16; it += nb) {
        const int lane = lane_id_volatile(), tid = w * 64 + lane, g = lane >> 4, li = lane & 15;
        const int sh = (it & 7) + 8 * (it >> 5), s = sh >> 2, hh = sh & 3, j = (it >> 3) & 3;
        int row0, L; seq_info(s, row0, L);
        const int nch = (L + 63) >> 6;
        const float m0 = 0.f;
        f32x4 cacc[2][4], nacc[2];
#pragma unroll
        for (int di = 0; di < 2; ++di) { nacc[di] = (f32x4){0.f, 0.f, 0.f, 0.f};
#pragma unroll
            for (int vi = 0; vi < 4; ++vi) cacc[di][vi] = (f32x4){0.f, 0.f, 0.f, 0.f}; }
        {
#pragma unroll 1
          for (int c = w; c < nch; c += 8) { const int t = c * 64 + lane; const bool valid = t < L; const float* gr = gates + (size_t)(row0 + t) * 8 + hh;
              const float lf = valid ? logsigmoidf_(gr[4]) : 0.f; const float sl = scan_sum64(lf, lane); aL[t] = valid ? gr[0] : -INFINITY; BL[t] = sl; if (lane == 63) totL[c] = sl; }
          __syncthreads();
          { const float x = (lane < nch) ? totL[lane] : 0.f; const float inc = scan_sum64(x, lane);
#pragma unroll 1
            for (int c = w; c < nch; c += 8) { const int t = c * 64 + lane; const float boff = (c > 0) ? __shfl(inc, c - 1) : 0.f; const float Bt = boff + BL[t]; const float a = aL[t] - Bt;
                const float ml = scan_max64(a, lane); aL[t] = a; BL[t] = Bt; ML_[t] = ml; if (lane == 63) cmxL[c] = ml; } }
          __syncthreads();
          { const float x = (lane < nch) ? cmxL[lane] : -INFINITY; const float pm = scan_max64(x, lane);
#pragma unroll 1
            for (int c = w; c < nch; c += 8) { const int t = c * 64 + lane; const float mp = (c > 0) ? fmaxf(m0, __shfl(pm, c - 1)) : m0; ML_[t] = fmaxf(mp, ML_[t]); } }
        }
        u32x4 pq[4], pk[4], pv;
#define ML_LOAD(t0_) do { const int t0__ = (t0_); \
            _Pragma("unroll") for (int i = 0; i < 4; ++i) { const int id = tid + 512 * i, rr = id >> 5, ch = id & 31; const bf16_t* zr = Z + (size_t)(row0 + t0__ + rr) * NZ + hh * DH + ch * 8; \
                pq[i] = *(const u32x4*)(zr + ZC_Q); pk[i] = *(const u32x4*)(zr + ZC_K); } \
            { const int rr = tid >> 3, ch = tid & 7; pv = *(const u32x4*)(Z + (size_t)(row0 + t0__ + rr) * NZ + ZC_V + hh * DH + j * 64 + ch * 8); } } while (0)
        ML_LOAD(0);
        for (int c = 0; c < nch; ++c) {
            const int t0 = c * 64;
            int tid_c = tid; asm volatile("" : "+v"(tid_c));
            const int tid = tid_c, lane = tid & 63, g = lane >> 4, li = lane & 15;
#pragma unroll
            for (int i = 0; i < 4; ++i) { const int id = tid + 512 * i, rr = id >> 5, ch = id & 31;
                *(LAS u32x4*)(lds + ML_Q + rr * ML_RS + ch * 16) = pq[i]; *(LAS u32x4*)(lds + ML_K + rr * ML_RS + ch * 16) = pk[i]; }
            { const int rr = tid >> 3, ch = tid & 7; const unsigned vw[4] = {pv.x, pv.y, pv.z, pv.w};
#pragma unroll
                for (int q = 0; q < 4; ++q) { *(LAS unsigned short*)(lds + ML_VT + vt_off(ch * 8 + 2 * q, rr >> 3) + (rr & 7) * 2) = (unsigned short)(vw[q] & 0xffffu);
                                              *(LAS unsigned short*)(lds + ML_VT + vt_off(ch * 8 + 2 * q + 1, rr >> 3) + (rr & 7) * 2) = (unsigned short)(vw[q] >> 16); } }
#pragma unroll
            for (int di = 0; di < 2; ++di) {
#pragma unroll
                for (int vi = 0; vi < 4; ++vi) { u32x2 cw; cw.x = pk2(cacc[di][vi][0], cacc[di][vi][1]); cw.y = pk2(cacc[di][vi][2], cacc[di][vi][3]);
                    *(LAS u32x2*)(lds + ML_CT + (16 * vi + li) * ML_RS + (32 * w + 16 * di + 4 * g) * 2) = cw; }
                if (li == 0) { u32x2 nw; nw.x = pk2(nacc[di][0], nacc[di][1]); nw.y = pk2(nacc[di][2], nacc[di][3]); *(LAS u32x2*)(lds + ML_NT + (32 * w + 16 * di + 4 * g) * 2) = nw; } }
            __syncthreads();
            if (c + 1 < nch) ML_LOAD(t0 + 64);
            const float Mprev = (c > 0) ? ML_[t0 - 1] : m0, MT = ML_[t0 + 63];
            bf16x8 qf[8];
            { const int ti = w >> 1, si0 = 2 * (w & 1); const bool need0 = si0 <= ti, need1 = si0 + 1 <= ti, needn = (w & 1) == 0;
              f32x4 a0 = {0.f, 0.f, 0.f, 0.f}, a1 = {0.f, 0.f, 0.f, 0.f}, aN = {0.f, 0.f, 0.f, 0.f};
              bf16x8 kf[8], nf[8];
#pragma unroll
              for (int k = 0; k < 8; ++k) qf[k] = *(const LAS bf16x8*)(lds + ML_Q + (16 * ti + li) * ML_RS + (32 * k + 8 * g) * 2);
              if (need0) {
#pragma unroll
                  for (int k = 0; k < 8; ++k) kf[k] = *(const LAS bf16x8*)(lds + ML_K + (16 * si0 + li) * ML_RS + (32 * k + 8 * g) * 2); }
              if (needn) {
#pragma unroll
                  for (int k = 0; k < 8; ++k) { const u32x4 t = *(const LAS u32x4*)(lds + ML_NT + (32 * k + 8 * g) * 2); nf[k] = __builtin_bit_cast(bf16x8, (li == 0) ? t : (u32x4){0u, 0u, 0u, 0u}); } }
              __builtin_amdgcn_sched_barrier(0);
              if (need0) {
#pragma unroll
                  for (int k = 0; k < 8; ++k) a0 = __builtin_amdgcn_mfma_f32_16x16x32_bf16(kf[k], qf[k], a0, 0, 0, 0); }
              __builtin_amdgcn_sched_barrier(0);
              if (need1) {
#pragma unroll
                  for (int k = 0; k < 8; ++k) kf[k] = *(const LAS bf16x8*)(lds + ML_K + (16 * si0 + 16 + li) * ML_RS + (32 * k + 8 * g) * 2); }
              if (needn) {
#pragma unroll
                  for (int k = 0; k < 8; ++k) aN = __builtin_amdgcn_mfma_f32_16x16x32_bf16(nf[k], qf[k], aN, 0, 0, 0);
                  if (g == 0) qnL[16 * ti + li] = aN[0]; }
              __builtin_amdgcn_sched_barrier(0);
              if (need1) {
#pragma unroll
                  for (int k = 0; k < 8; ++k) a1 = __builtin_amdgcn_mfma_f32_16x16x32_bf16(kf[k], qf[k], a1, 0, 0, 0); }
              const int tau = 16 * ti + li; const float Mt = ML_[t0 + tau]; float dsum = 0.f;
#pragma unroll
              for (int x = 0; x < 2; ++x) { const f32x4 acc = x ? a1 : a0; const int sb = 16 * (si0 + x) + 4 * g; const f32x4 as = *(const LAS f32x4*)(aL + t0 + sb); float v[4];
#pragma unroll
                  for (int r = 0; r < 4; ++r) { const float wgt = (sb + r <= tau) ? __expf(as[r] - Mt) : 0.f; v[r] = acc[r] * wgt; dsum += v[r]; }
                  u32x2 sw; sw.x = pk2(v[0], v[1]); sw.y = pk2(v[2], v[3]);
                  *(LAS u32x2*)(lds + ML_SW + tau * ML_VS + sb * 2) = sw; }
              dsum += __shfl_xor(dsum, 16); dsum += __shfl_xor(dsum, 32);
              if (g == 0) denL[tau * 2 + (w & 1)] = dsum; }
            { const int dv0 = tid >> 4, sp = tid & 15; const f32x4 as = *(const LAS f32x4*)(aL + t0 + 4 * sp);
              const f32x4 wk = {__expf(as.x - MT), __expf(as.y - MT), __expf(as.z - MT), __expf(as.w - MT)};
              if (dv0 == 0) *(LAS f32x4*)(wkL + 4 * sp) = wk;
#pragma unroll
              for (int x = 0; x < 2; ++x) { const int dv = dv0 + 32 * x; const u32x2 vv = *(const LAS u32x2*)(lds + ML_VT + vt_off(dv, sp >> 1) + (sp & 1) * 8);
                  u32x2 o; o.x = pk2(bflo(vv.x) * wk.x, bfhi(vv.x) * wk.y); o.y = pk2(bflo(vv.y) * wk.z, bfhi(vv.y) * wk.w);
                  *(LAS u32x2*)(lds + ML_WV + dv * ML_VS + sp * 8) = o; } }
            __syncthreads();
            { const int ti = w >> 1;
              bf16x8 sf[2];
#pragma unroll
              for (int k = 0; k < 2; ++k) sf[k] = *(const LAS bf16x8*)(lds + ML_SW + (16 * ti + li) * ML_VS + (32 * k + 8 * g) * 2);
#pragma unroll
              for (int x = 0; x < 2; ++x) { const int vi = (w & 1) + 2 * x; f32x4 acc = {0.f, 0.f, 0.f, 0.f}, acc2 = {0.f, 0.f, 0.f, 0.f};
              bf16x8 cf[8], vf[2];
#pragma unroll
              for (int k = 0; k < 8; ++k) cf[k] = *(const LAS bf16x8*)(lds + ML_CT + (16 * vi + li) * ML_RS + (32 * k + 8 * g) * 2);
#pragma unroll
              for (int k = 0; k < 2; ++k) vf[k] = *(const LAS bf16x8*)(lds + ML_VT + vt_off(16 * vi + li, 4 * k + g));
              const int tau = 16 * ti + li; const float Mt = ML_[t0 + tau], Bt = BL[t0 + tau], qn = qnL[tau]; const float d0 = denL[tau * 2], d1 = denL[tau * 2 + 1];
              __builtin_amdgcn_sched_barrier(0);
#pragma unroll
              for (int k = 0; k < 8; ++k) acc = __builtin_amdgcn_mfma_f32_16x16x32_bf16(cf[k], qf[k], acc, 0, 0, 0);
#pragma unroll
              for (int k = 0; k < 2; ++k) acc2 = __builtin_amdgcn_mfma_f32_16x16x32_bf16(vf[k], sf[k], acc2, 0, 0, 0);
              const float ei = __expf(Mprev - Mt);
              acc = acc * ei + acc2;
              const float den = d0 + d1 + ei * qn;
              const float inv = __builtin_amdgcn_rcpf(fmaxf(fabsf(den), __expf(-(Bt + Mt))));
              acc = acc * inv;
              if (t0 + tau < L) { u32x2 hw; hw.x = pk2(acc[0], acc[1]); hw.y = pk2(acc[2], acc[3]); *(u32x2*)(ACAT + (size_t)(row0 + t0 + tau) * 2048 + 1024 + hh * DH + j * 64 + 16 * vi + 4 * g) = hw; } } }
            { const float decay = __expf(Mprev - MT);
#pragma unroll
              for (int di = 0; di < 2; ++di) { nacc[di] = nacc[di] * decay;
#pragma unroll
                  for (int vi = 0; vi < 4; ++vi) cacc[di][vi] = cacc[di][vi] * decay; }
              const int q = li >> 2, pp = li & 3;
              bf16x8 ak[2][2], bw[2][4], bnf[2];
#pragma unroll
              for (int k = 0; k < 2; ++k) {
#pragma unroll
                  for (int di = 0; di < 2; ++di) {
                      const v4s lo = __builtin_amdgcn_ds_read_tr16_b64_v4i16((LAS v4s*)(lds + ML_K + (32 * k + 8 * g + q) * ML_RS + (32 * w + 16 * di + 4 * pp) * 2));
                      const v4s hi = __builtin_amdgcn_ds_read_tr16_b64_v4i16((LAS v4s*)(lds + ML_K + (32 * k + 8 * g + 4 + q) * ML_RS + (32 * w + 16 * di + 4 * pp) * 2));
                      ak[k][di] = (bf16x8){lo.x, lo.y, lo.z, lo.w, hi.x, hi.y, hi.z, hi.w}; }
#pragma unroll
                  for (int vi = 0; vi < 4; ++vi) bw[k][vi] = *(const LAS bf16x8*)(lds + ML_WV + (16 * vi + li) * ML_VS + (32 * k + 8 * g) * 2);
                  { const f32x4 w0 = *(const LAS f32x4*)(wkL + 32 * k + 8 * g), w1 = *(const LAS f32x4*)(wkL + 32 * k + 8 * g + 4);
                    u32x4 bn; bn.x = pk2(w0.x, w0.y); bn.y = pk2(w0.z, w0.w); bn.z = pk2(w1.x, w1.y); bn.w = pk2(w1.z, w1.w);
                    if (li != 0) bn = (u32x4){0u, 0u, 0u, 0u};
                    bnf[k] = __builtin_bit_cast(bf16x8, bn); } }
              __builtin_amdgcn_sched_barrier(0);
#pragma unroll
              for (int k = 0; k < 2; ++k) {
#pragma unroll
                  for (int vi = 0; vi < 4; ++vi)
#pragma unroll
                      for (int di = 0; di < 2; ++di) cacc[di][vi] = __builtin_amdgcn_mfma_f32_16x16x32_bf16(ak[k][di], bw[k][vi], cacc[di][vi], 0, 0, 0);
#pragma unroll
                  for (int di = 0; di < 2; ++di) nacc[di] = __builtin_amdgcn_mfma_f32_16x16x32_bf16(ak[k][di], bnf[k], nacc[di], 0, 0, 0); } }
            __syncthreads();
        }
#undef ML_LOAD
        { const int lane = lane_id_volatile(), g = lane >> 4, li = lane & 15;
          float* oC = p.out + O_PC + ((size_t)s * NH + hh) * DH * DH; float* oN = p.out + O_PN + ((size_t)s * NH + hh) * DH; float* oM = p.out + O_PM + (size_t)s * NH + hh;
#pragma unroll
          for (int di = 0; di < 2; ++di)
#pragma unroll
              for (int vi = 0; vi < 4; ++vi)
#pragma unroll
                  for (int r = 0; r < 4; ++r) oC[(size_t)(32 * w + 16 * di + 4 * g + r) * DH + j * 64 + 16 * vi + li] = cacc[di][vi][r];
          if (j == 0 && li == 0) {
#pragma unroll
              for (int di = 0; di < 2; ++di) *(f32x4*)(oN + 32 * w + 16 * di + 4 * g) = nacc[di]; }
          if (j == 0 && w == 0 && lane == 0) oM[0] = BL[L - 1] + ML_[L - 1]; }
        __syncthreads();
    }
}

constexpr int MS_NP = 0, MS_QF = 0, MS_KF = 8192, MS_QT = 32768, MS_WT = 40960, MS_SS = 49152, MS_HALF = 65536;
__device__ __forceinline__ void mlstm_sample(const P& p, LAS unsigned char* lds, int bid, int nb, int wv) {
    const int tid = opaque_tid(wv), half = tid >> 8, lt = tid & 255, lane = tid & 63, wq = (tid >> 6) & 3;
    const bf16_t* Z = (const bf16_t*)(p.ws + WS_Z); bf16_t* ACAT = (bf16_t*)(p.ws + WS_ACAT); const float* gates = (const float*)(p.ws + WS_SMALL + 65536);
    LAS unsigned char* hb = lds + half * MS_HALF;
    LAS float* NP = (LAS float*)(hb + MS_NP); LAS float* QF = (LAS float*)(hb + MS_QF); LAS float* KF = (LAS float*)(hb + MS_KF); LAS float* QT = (LAS float*)(hb + MS_QT); LAS float* WT = (LAS float*)(hb + MS_WT); LAS float* SS = (LAS float*)(hb + MS_SS);
    for (int pp = bid; pp < DECB * NH / 2; pp += nb) {
        const int pr = pp * 2 + half, b = pr >> 2, hh = pr & 3; const int rowb = MP + b * DECS;
        const float* C0 = p.in[I_SC] + (size_t)pr * DH * DH; float* OC = p.out + O_SC + (size_t)pr * DH * DH;
        float aG[8], MtG[8], BtG[8], wk[8]; const float m0 = p.in[I_SM][pr];
        { float Bc = 0.f, Mc = m0;
#pragma unroll
          for (int t = 0; t < 8; ++t) { const float* gr = gates + (size_t)(rowb + t) * 8 + hh; const float ig = gr[0], lf = logsigmoidf_(gr[4]); Bc += lf; BtG[t] = Bc; aG[t] = ig - Bc; Mc = fmaxf(Mc, aG[t]); MtG[t] = Mc; } }
        const float MT = MtG[7], decay = __expf(m0 - MT);
#pragma unroll
        for (int t = 0; t < 8; ++t) wk[t] = __expf(aG[t] - MT);
        { float kq[8], kk[8]; const bf16_t* zr = Z + (size_t)rowb * NZ + hh * DH + lt;
#pragma unroll
          for (int t = 0; t < 8; ++t) { kq[t] = bf2f(zr[(size_t)t * NZ + ZC_Q]); kk[t] = bf2f(zr[(size_t)t * NZ + ZC_K]); QF[t * 256 + lt] = kq[t]; KF[t * 256 + lt] = kk[t]; }
          const float n0 = p.in[I_SN][(size_t)pr * DH + lt]; KF[8 * 256 + lt] = n0;
          *(LAS f32x4*)(QT + lt * 8) = (f32x4){kq[0], kq[1], kq[2], kq[3]}; *(LAS f32x4*)(QT + lt * 8 + 4) = (f32x4){kq[4], kq[5], kq[6], kq[7]};
          float nn = decay * n0;
#pragma unroll
          for (int t = 0; t < 8; ++t) { kk[t] *= wk[t]; nn += kk[t]; }
          *(LAS f32x4*)(WT + lt * 8) = (f32x4){kk[0], kk[1], kk[2], kk[3]}; *(LAS f32x4*)(WT + lt * 8 + 4) = (f32x4){kk[4], kk[5], kk[6], kk[7]};
          p.out[O_SN + (size_t)pr * DH + lt] = nn;
          if (lt == 0) { p.out[O_SM + pr] = BtG[7] + MT;
#pragma unroll
              for (int t = 0; t < 8; ++t) { SS[80 + t] = aG[t]; SS[88 + t] = MtG[t]; SS[96 + t] = BtG[t]; } } }
        f32x4 vv[8];
#pragma unroll
        for (int t = 0; t < 8; ++t) { const u32x2 w = *(const u32x2*)(Z + (size_t)(rowb + t) * NZ + ZC_V + hh * DH + 4 * lane); vv[t] = (f32x4){bflo(w.x), bfhi(w.x), bflo(w.y), bfhi(w.y)}; }
        const f32x4* cp = (const f32x4*)(C0 + (size_t)(64 * wq) * DH) + lane; f32x4* op = (f32x4*)(OC + (size_t)(64 * wq) * DH) + lane;
        f32x4 cr[4];
#pragma unroll
        for (int i = 0; i < 4; ++i) cr[i] = __builtin_nontemporal_load(cp + i * 64);
        __syncthreads();
        if (lt < 144) { const int pair = lt >> 1, part = lt & 1, t = pair / 9, sp = pair - 9 * t; float acc = 0.f;
#pragma unroll 8
            for (int i = 0; i < 32; ++i) { const f32x4 a = *(const LAS f32x4*)(QF + t * 256 + part * 128 + 4 * i), bq = *(const LAS f32x4*)(KF + sp * 256 + part * 128 + 4 * i); acc += (a.x * bq.x + a.y * bq.y) + (a.z * bq.z + a.w * bq.w); }
            acc += __shfl_xor(acc, 1);
            if (part == 0) SS[pair] = acc; }
        __syncthreads();
        f32x4 num[8];
#pragma unroll
        for (int t = 0; t < 8; ++t) num[t] = (f32x4){0.f, 0.f, 0.f, 0.f};
        const LAS float* qtp = QT + 64 * wq * 8; const LAS float* wtp = WT + 64 * wq * 8;
#pragma unroll 1
        for (int rb = 0; rb < 64; rb += 4) {
            f32x4 cn[4];
            cp += 4 * 64;
            if (rb + 4 < 64) {
#pragma unroll
                for (int i = 0; i < 4; ++i) cn[i] = __builtin_nontemporal_load(cp + i * 64); }
#pragma unroll
            for (int i = 0; i < 4; ++i) {
                const f32x4 q0 = *(const LAS f32x4*)(qtp + i * 8), q1 = *(const LAS f32x4*)(qtp + i * 8 + 4), w0 = *(const LAS f32x4*)(wtp + i * 8), w1 = *(const LAS f32x4*)(wtp + i * 8 + 4);
                const f32x4 c = cr[i];
                num[0] += q0.x * c; num[1] += q0.y * c; num[2] += q0.z * c; num[3] += q0.w * c; num[4] += q1.x * c; num[5] += q1.y * c; num[6] += q1.z * c; num[7] += q1.w * c;
                f32x4 o = decay * c + w0.x * vv[0]; o += w0.y * vv[1]; o += w0.z * vv[2]; o += w0.w * vv[3]; o += w1.x * vv[4]; o += w1.y * vv[5]; o += w1.z * vv[6]; o += w1.w * vv[7];
                __builtin_nontemporal_store(o, op + i * 64); }
            op += 4 * 64; qtp += 32; wtp += 32;
            if (rb + 4 < 64) {
#pragma unroll
                for (int i = 0; i < 4; ++i) cr[i] = cn[i]; }
        }
#pragma unroll
        for (int t = 0; t < 8; ++t) *(LAS f32x4*)(NP + (wq * 8 + t) * 256 + 4 * lane) = num[t];
        __syncthreads();
        { const int t = lt >> 5, d8 = (lt & 31) * 8; float nc[8];
#pragma unroll
          for (int i = 0; i < 8; ++i) nc[i] = 0.f;
#pragma unroll
          for (int x = 0; x < 4; ++x) { const f32x4 a = *(const LAS f32x4*)(NP + (x * 8 + t) * 256 + d8), c2 = *(const LAS f32x4*)(NP + (x * 8 + t) * 256 + d8 + 4);
              nc[0] += a.x; nc[1] += a.y; nc[2] += a.z; nc[3] += a.w; nc[4] += c2.x; nc[5] += c2.y; nc[6] += c2.z; nc[7] += c2.w; }
          const float Mt = SS[88 + t], Bt = SS[96 + t]; const float eint = __expf(m0 - Mt);
          float den = eint * SS[t * 9 + 8];
#pragma unroll
          for (int i = 0; i < 8; ++i) nc[i] *= eint;
#pragma unroll
          for (int sI = 0; sI < 8; ++sI) { const float sw = (sI <= t) ? SS[t * 9 + sI] * __expf(SS[80 + sI] - Mt) : 0.f; den += sw;
              float v8[8]; unpack8(*(const u32x4*)(Z + (size_t)(rowb + sI) * NZ + ZC_V + hh * DH + d8), v8);
#pragma unroll
              for (int i = 0; i < 8; ++i) nc[i] += sw * v8[i]; }
          const float dinv = 1.0f / fmaxf(fabsf(den), __expf(-(Bt + Mt)));
          u32x4 w; w.x = pk2(nc[0] * dinv, nc[1] * dinv); w.y = pk2(nc[2] * dinv, nc[3] * dinv); w.z = pk2(nc[4] * dinv, nc[5] * dinv); w.w = pk2(nc[6] * dinv, nc[7] * dinv);
          *(u32x4*)(ACAT + (size_t)(rowb + t) * 2048 + 1024 + hh * DH + d8) = w; }
        __syncthreads();
    }
}

__device__ __forceinline__ void phase_headnorm(const P& p, int bid, int nb, int wv) {
    const int tid = opaque_tid(wv), lane = tid & 63, wave = tid >> 6;
    const bf16_t* Z = (const bf16_t*)(p.ws + WS_Z); bf16_t* ACAT = (bf16_t*)(p.ws + WS_ACAT); const float* hg = p.in[I_HG];
    const bf16_t* PCUM = (const bf16_t*)(p.ws + WS_PCUM); const float* CARRY = (const float*)(p.ws + WS_CARRY);
    f32x4 gg[4];
#pragma unroll
    for (int j = 0; j < 4; ++j) gg[j] = ((const f32x4*)hg)[lane + 64 * j];
    for (int m = wave * nb + bid; m < MTOK; m += nb * 8) {
        u32x2* ap = (u32x2*)(ACAT + (size_t)m * 2048) + lane; u32x2* hp = ap + 256; const unsigned* op = (const unsigned*)((const unsigned char*)Z + (size_t)m * ZG_PITCH + ZG_OFF) + lane;
        bool fix = false; int sq = 0, seg = 0;
        if (m < MP) { sq = m / LP; seg = (m - sq * LP) >> 6; fix = seg > 0; }
        u32x2 hv[4], av[4]; unsigned ov[4], pv[4]; f32x4 cv[4];
#pragma unroll
        for (int j = 0; j < 4; ++j) { hv[j] = hp[64 * j]; ov[j] = op[64 * j]; }
        if (fix) { const unsigned* pp = (const unsigned*)((const unsigned char*)PCUM + (size_t)m * D) + lane; const f32x4* cp = (const f32x4*)(CARRY + (size_t)(sq * NSEGP + seg) * D) + lane;
#pragma unroll
            for (int j = 0; j < 4; ++j) { av[j] = ap[64 * j]; pv[j] = pp[64 * j]; cv[j] = cp[64 * j]; } }
        if (fix) {
#pragma unroll
            for (int j = 0; j < 4; ++j) { const f32x4 c = cv[j] * (1.0f / 255.0f); u32x2 o; o.x = pk2(bflo(av[j].x) + ub0(pv[j]) * c.x, bfhi(av[j].x) + ub1(pv[j]) * c.y); o.y = pk2(bflo(av[j].y) + ub2(pv[j]) * c.z, bfhi(av[j].y) + ub3(pv[j]) * c.w); ap[64 * j] = o; } }
#pragma unroll
        for (int j = 0; j < 4; ++j) {
            float v0 = bflo(hv[j].x), v1 = bfhi(hv[j].x), v2 = bflo(hv[j].y), v3 = bfhi(hv[j].y);
            const float ssq = wave_sum((v0 * v0 + v1 * v1) + (v2 * v2 + v3 * v3));
            const float rstd = 1.0f / sqrtf(ssq * (1.0f / DH) + EPS);
            const float rq = rstd * (1.0f / 255.0f);
            v0 = v0 * rq * gg[j].x * ub0(ov[j]); v1 = v1 * rq * gg[j].y * ub1(ov[j]); v2 = v2 * rq * gg[j].z * ub2(ov[j]); v3 = v3 * rq * gg[j].w * ub3(ov[j]);
            u32x2 o; o.x = pk2(v0, v1); o.y = pk2(v2, v3); hp[64 * j] = o; }
    }
}

__device__ __forceinline__ void phase_norm2(const P& p, int bid, int nb, int wv) {
    const int tid = opaque_tid(wv), lane = tid & 63, wave = tid >> 6;
    const float* X1 = (const float*)(p.ws + WS_X1); bf16_t* XN = (bf16_t*)(p.ws + WS_XN);
    for (int m = wave * nb + bid; m < MTOK; m += nb * 8) {
        const f32x4* xr = (const f32x4*)(X1 + (size_t)m * D) + lane; f32x4 v[4]; float s = 0.f;
#pragma unroll
        for (int j = 0; j < 4; ++j) { v[j] = xr[64 * j]; s += (v[j].x * v[j].x + v[j].y * v[j].y) + (v[j].z * v[j].z + v[j].w * v[j].w); }
        const float rstd = 1.0f / sqrtf(wave_sum(s) * (1.0f / D) + EPS);
        unsigned long long* o8 = (unsigned long long*)(XN + (size_t)m * D) + lane;
#pragma unroll
        for (int j = 0; j < 4; ++j) { v[j] = v[j] * rstd; o8[64 * j] = (unsigned long long)pk2(v[j].x, v[j].y) | ((unsigned long long)pk2(v[j].z, v[j].w) << 32); }
    }
}

__device__ __forceinline__ float gelu_tanh(float x) { const float u2 = -1.5957691216057308f * (x + 0.044715f * x * x * x); return x * __builtin_amdgcn_rcpf(1.0f + __expf(u2)); }
__device__ __forceinline__ void phase_convffn(const P& p, int bid, int nb, int wv) {
    const int gid = bid * NTHREADS + opaque_tid(wv), nruns = (nb * NTHREADS) / (DFF / 8);
    const int run = gid / (DFF / 8), c0 = (gid - run * (DFF / 8)) * 8;
    if (run >= nruns) return;
    const int rpr = (MTOK + nruns - 1) / nruns, r0 = run * rpr, r1 = (r0 + rpr < MTOK) ? r0 + rpr : MTOK;
    if (r0 >= r1) return;
    const bf16_t* __restrict__ UP = (const bf16_t*)(p.ws + WS_Z); bf16_t* __restrict__ HMID = (bf16_t*)(p.ws + WS_ACAT);
    const float* __restrict__ cw = p.in[I_FCW]; const float* __restrict__ cbv = p.in[I_FCB]; const float* __restrict__ sf = p.in[I_SF]; float* __restrict__ out = p.out;
    float wvt[3][8], wg[3][8], bv[8], bg[8];
#pragma unroll
    for (int q = 0; q < 8; ++q) { bv[q] = cbv[c0 + q]; bg[q] = cbv[DFF + c0 + q];
#pragma unroll
        for (int jx = 0; jx < 3; ++jx) { wvt[jx][q] = cw[(size_t)jx * NUP + c0 + q]; wg[jx][q] = cw[(size_t)jx * NUP + DFF + c0 + q]; } }
    int s, t, L, row0;
    if (r0 < MP) s = r0 / LP; else s = NBP + (r0 - MP) / DECS;
    seq_info(s, row0, L); t = r0 - row0;
    float x0v[8], x1v[8], x0g[8], x1g[8];
#pragma unroll
    for (int q = 0; q < 8; ++q) { x0v[q] = 0.f; x1v[q] = 0.f; x0g[q] = 0.f; x1g[q] = 0.f; }
    if (t >= 1) { unpack8(*(const u32x4*)(UP + (size_t)(r0 - 1) * NUP + c0), x1v); unpack8(*(const u32x4*)(UP + (size_t)(r0 - 1) * NUP + DFF + c0), x1g); }
    if (t >= 2) { unpack8(*(const u32x4*)(UP + (size_t)(r0 - 2) * NUP + c0), x0v); unpack8(*(const u32x4*)(UP + (size_t)(r0 - 2) * NUP + DFF + c0), x0g); }
    else if (t == 1 && s >= NBP) { const float* b1 = sf + ((size_t)(s - NBP) * 2 + 1) * NUP;
#pragma unroll
        for (int q = 0; q < 8; ++q) { x0v[q] = b1[c0 + q]; x0g[q] = b1[DFF + c0 + q]; } }
    u32x4 nv[4], ng[4];
#pragma unroll
    for (int i = 0; i < 4; ++i) { const int rr = (r0 + i < r1) ? r0 + i : r1 - 1; nv[i] = *(const u32x4*)(UP + (size_t)rr * NUP + c0); ng[i] = *(const u32x4*)(UP + (size_t)rr * NUP + DFF + c0); }
    for (int rb = r0; rb < r1; rb += 4) {
        u32x4 lv[4], lg[4];
#pragma unroll
        for (int i = 0; i < 4; ++i) { lv[i] = nv[i]; lg[i] = ng[i]; }
        if (rb + 4 < r1) {
#pragma unroll
            for (int i = 0; i < 4; ++i) { const int rr = (rb + 4 + i < r1) ? rb + 4 + i : r1 - 1; nv[i] = *(const u32x4*)(UP + (size_t)rr * NUP + c0); ng[i] = *(const u32x4*)(UP + (size_t)rr * NUP + DFF + c0); } }
#pragma unroll
        for (int i = 0; i < 4; ++i) { const int r = rb + i;
            if (r < r1) {
                if (t == 0) {
                    if (s >= NBP) { const float* b0 = sf + (size_t)(s - NBP) * 2 * NUP; const float* b1 = b0 + NUP;
#pragma unroll
                        for (int q = 0; q < 8; ++q) { x0v[q] = b0[c0 + q]; x0g[q] = b0[DFF + c0 + q]; x1v[q] = b1[c0 + q]; x1g[q] = b1[DFF + c0 + q]; } }
                    else {
#pragma unroll
                        for (int q = 0; q < 8; ++q) { x0v[q] = 0.f; x0g[q] = 0.f; x1v[q] = 0.f; x1g[q] = 0.f; } } }
                float x2v[8], x2g[8], o[8]; unpack8(lv[i], x2v); unpack8(lg[i], x2g);
#pragma unroll
                for (int q = 0; q < 8; ++q) { const float val = bv[q] + wvt[0][q] * x0v[q] + wvt[1][q] * x1v[q] + wvt[2][q] * x2v[q]; const float gt = bg[q] + wg[0][q] * x0g[q] + wg[1][q] * x1g[q] + wg[2][q] * x2g[q];
                    o[q] = gelu_tanh(gt) * val; }
                u32x4 w; w.x = pk2(o[0], o[1]); w.y = pk2(o[2], o[3]); w.z = pk2(o[4], o[5]); w.w = pk2(o[6], o[7]);
                *(u32x4*)(HMID + (size_t)r * DFF + c0) = w;
                if (t >= L - 2) {
                    float* of = (s < NBP ? out + O_PF + (size_t)s * 2 * NUP : out + O_SF + (size_t)(s - NBP) * 2 * NUP) + (size_t)(t - (L - 2)) * NUP;
                    *(f32x4*)(of + c0) = (f32x4){x2v[0], x2v[1], x2v[2], x2v[3]}; *(f32x4*)(of + c0 + 4) = (f32x4){x2v[4], x2v[5], x2v[6], x2v[7]};
                    *(f32x4*)(of + DFF + c0) = (f32x4){x2g[0], x2g[1], x2g[2], x2g[3]}; *(f32x4*)(of + DFF + c0 + 4) = (f32x4){x2g[4], x2g[5], x2g[6], x2g[7]}; }
#pragma unroll
                for (int q = 0; q < 8; ++q) { x0v[q] = x1v[q]; x1v[q] = x2v[q]; x0g[q] = x1g[q]; x1g[q] = x2g[q]; }
                if (++t == L) { ++s; t = 0; seq_info(s, row0, L); }
            } }
    }
}

__device__ __forceinline__ void phase_final(const P& p, LAS unsigned char* lds, int bid, int nb, int wv) {
    const int tid = opaque_tid(wv), lane = tid & 63, wave = tid >> 6;
    const bf16_t* X2B = (const bf16_t*)(p.ws + WS_X1); const bf16_t* X1B = (const bf16_t*)(p.ws + WS_XN); const float* gf = p.in[I_GF]; const float* PART = (const float*)(p.ws + WS_Z);
    LAS int* tailmap = (LAS int*)lds;
    constexpr int DS = 11;
    for (int i = tid; i < (MPAD / 256) * 4; i += NTHREADS) tailmap[i] = -1;
    __syncthreads();
    { pg8::SplitTailOrder S; S.init(MPAD, D, DFF, nb, 0); const int R = (nb == 256) ? S.nwg - nb : 0;
      if (tid < R) { pg8::Unit u; pg8::StaticOrder t = S; t.c = tid; if (t.next(1, u)) tailmap[u.pm * 4 + u.pn] = tid; } }
    __syncthreads();
    constexpr int FU = 3;
    for (int m0 = wave * nb + bid; m0 < MTOK; m0 += nb * 8 * FU) {
        float* o[FU]; bool ok[FU]; f32x4 v[FU][4]; int tix[FU][4];
#pragma unroll
        for (int u = 0; u < FU; ++u) { const int m = m0 + u * nb * 8; ok[u] = m < MTOK; o[u] = p.out;
            if (ok[u]) { if (m < MP) { const int b = m / LP, t = m - b * LP; if (t < NMETA) ok[u] = false; else o[u] = p.out + O_YP + ((size_t)b * SEQ + (t - NMETA)) * D; }
                         else o[u] = p.out + O_YS + (size_t)(m - MP) * D; }
#pragma unroll
            for (int j = 0; j < 4; ++j) { tix[u][j] = ok[u] ? tailmap[(m >> 8) * 4 + j] : -1;
                u32x2 xw = {0u, 0u}; if (ok[u]) xw = *((const u32x2*)((tix[u][j] >= 0 ? X1B : X2B) + (size_t)m * D) + lane + 64 * j);
                v[u][j] = (f32x4){bflo(xw.x), bfhi(xw.x), bflo(xw.y), bfhi(xw.y)}; } }
#pragma unroll
        for (int u = 0; u < FU; ++u) { const int m = m0 + u * nb * 8; float s = 0.f;
            if (!ok[u]) continue;
#pragma unroll
            for (int j = 0; j < 4; ++j) {
                const int ti = tix[u][j];
                if (ti >= 0) { const u32x2* pp = (const u32x2*)((const bf16_t*)PART + (size_t)(ti * DS) * 65536 + (size_t)(m & 255) * 256) + lane;
#pragma unroll
                    for (int sl = 0; sl < DS; ++sl) { const u32x2 pw = pp[(size_t)sl * 16384]; v[u][j] += (f32x4){bflo(pw.x), bfhi(pw.x), bflo(pw.y), bfhi(pw.y)}; } }
                s += (v[u][j].x * v[u][j].x + v[u][j].y * v[u][j].y) + (v[u][j].z * v[u][j].z + v[u][j].w * v[u][j].w); }
            const float rstd = 1.0f / sqrtf(wave_sum(s) * (1.0f / D) + EPS);
#pragma unroll
            for (int j = 0; j < 4; ++j) __builtin_nontemporal_store(v[u][j] * rstd * ((const f32x4*)gf)[lane + 64 * j], (f32x4*)o[u] + lane + 64 * j); }
    }
}

__device__ __forceinline__ void late_transposes(const P& p, LAS unsigned char* lds, int gw, int NGW, int wv) {
    const int lane = lane_id_volatile(); unsigned char* ws = p.ws;
    LAS float* scr = (LAS float*)(lds + wv * 8448);
    constexpr int I_SQ = 16 * 32, I_UP = 16 * 176, I_DN = 44 * 32, NITEMS = 3 * I_SQ + I_UP + I_DN;
    for (int it = gw; it < NITEMS; it += NGW) {
        int r = it;
        if (r < I_SQ) { tr_item(p.in[I_WA], 1024, (r / 32) * 64, (r % 32) * 32, (bf16_t*)(ws + WS_WCAT), 2048, (r % 32) * 32, 0, nullptr, 1.f, scr, lane); continue; } r -= I_SQ;
        if (r < I_SQ) { tr_item(p.in[I_WB], 1024, (r / 32) * 64, (r % 32) * 32, (bf16_t*)(ws + WS_WCAT), 2048, (r % 32) * 32, 1024, nullptr, 1.f, scr, lane); continue; } r -= I_SQ;
        if (r < I_SQ) { tr_item(p.in[I_WOUT], 1024, (r / 32) * 64, (r % 32) * 32, (bf16_t*)(ws + WS_WOUT), 1024, (r % 32) * 32, 0, nullptr, 1.f, scr, lane); continue; } r -= I_SQ;
        if (r < I_UP) { const int n0 = (r % 176) * 32, ns0 = ((n0 >> 7) & 1) * DFF + (n0 >> 8) * 128 + (n0 & 127);
            tr_item(p.in[I_WUP], NUP, (r / 176) * 64, ns0, (bf16_t*)(ws + WS_WUP), 1024, n0, 0, p.in[I_G2], 1.f, scr, lane); continue; } r -= I_UP;
        tr_item(p.in[I_WDOWN], 1024, (r / 32) * 64, (r % 32) * 32, (bf16_t*)(ws + WS_WDOWN), DFF, (r % 32) * 32, 0, nullptr, 1.f, scr, lane);
    }
}
__device__ __forceinline__ void phase_gemm1(const P& p, LAS unsigned char* lds, int bid, int nb, int wv) {
    pg8::Gemm g{(const bf16_t*)(p.ws + WS_XN), (const bf16_t*)(p.ws + WS_WIN), MPAD, NZ, D, 0}; pg8::StaticOrder S; S.init(MPAD, NZ, D, nb, bid);
    pg8::EpiBf16 E{(bf16_t*)(p.ws + WS_Z), NZ, (const float*)(p.ws + WS_SMALL), nullptr};
    pg8::gemm_phase<pg8::EpiBf16, pg8::StaticOrder, true, true>(lds, g, S, E, wv);
    { const int rem = S.nwg % nb, idle0 = (rem == 0) ? 0 : rem, nidle = nb - idle0;
      if (bid >= idle0) { late_transposes(p, lds, wv * nidle + (bid - idle0), nidle * 8, wv); } }
}
__device__ __forceinline__ void phase_gemm_merge(const P& p, LAS unsigned char* lds, int bid, int nb, int wv) {
    pg8::Gemm g{(const bf16_t*)(p.ws + WS_ACAT), (const bf16_t*)(p.ws + WS_WCAT), MPAD, D, 2048, 0}; pg8::SplitTailOrder S; S.init(MPAD, D, 2048, nb, bid); S.S = (nb == 256) ? 8 : 0;
    pg8::EpiMerge E{(bf16_t*)(p.ws + WS_MERGED), (const bf16_t*)(p.ws + WS_Z), (float*)(p.ws + WS_X1), (unsigned*)(p.ws + WS_CTL) + 1024, 8};
    pg8::gemm_phase<pg8::EpiMerge, pg8::SplitTailOrder, true, true>(lds, g, S, E, wv);
}
__device__ __forceinline__ void phase_gemm_out(const P& p, LAS unsigned char* lds, int bid, int nb, int wv) {
    pg8::Gemm g{(const bf16_t*)(p.ws + WS_MERGED), (const bf16_t*)(p.ws + WS_WOUT), MPAD, D, D, 0}; pg8::SplitTailOrder S; S.init(MPAD, D, D, nb, bid); S.S = (nb == 256) ? 4 : 0;
    pg8::EpiX1 E{p.in[I_META], p.in[I_XP], p.in[I_XS], nullptr, (bf16_t*)(p.ws + WS_XN), (float*)(p.ws + WS_SSQ), (float*)(p.ws + WS_Z), (unsigned*)(p.ws + WS_CTL) + 1088, 4};
    pg8::gemm_phase<pg8::EpiX1, pg8::SplitTailOrder, true, true>(lds, g, S, E, wv);
}
__device__ __forceinline__ void phase_gemm_up(const P& p, LAS unsigned char* lds, int bid, int nb, int wv) {
    pg8::Gemm g{(const bf16_t*)(p.ws + WS_XN), (const bf16_t*)(p.ws + WS_WUP), MPAD, NUP, D, 1}; pg8::StaticOrder S; S.init(MPAD, NUP, D, nb, bid);
    pg8::EpiUp E{(bf16_t*)(p.ws + WS_ACAT), (const float*)(p.ws + WS_SSQ), p.in[I_FCW], p.in[I_FCB], p.in[I_SF], p.out, (LAS float*)(lds + 131072)};
    pg8::gemm_phase<pg8::EpiUp, pg8::StaticOrder, true, true>(lds, g, S, E, wv);
}
__device__ __forceinline__ void phase_gemm_down(const P& p, LAS unsigned char* lds, int bid, int nb, int wv) {
    pg8::Gemm g{(const bf16_t*)(p.ws + WS_ACAT), (const bf16_t*)(p.ws + WS_WDOWN), MPAD, D, DFF, 0}; pg8::SplitTailOrder S; S.init(MPAD, D, DFF, nb, bid); S.S = (nb == 256) ? 11 : 0;
    pg8::EpiAcc E{(const bf16_t*)(p.ws + WS_XN), (bf16_t*)(p.ws + WS_X1), (float*)(p.ws + WS_Z)};
    pg8::gemm_phase<pg8::EpiAcc, pg8::SplitTailOrder, true, true>(lds, g, S, E, wv);
}


#define XB_TMO      128
#define XB_XCNT(j)  (256  + 64 * (j))
#define XB_XSUB(j)  (1280 + 64 * (j))
#define XB_XGEN(j)  (2304 + 64 * (j))
#define XB_TOP      3328
#define XB_TOPGEN   3392
#define XCD_BAR_WORDS 3456
#define XB_SPIN_CAP (1u << 22)
constexpr int CW_BAR = 4096;
__device__ __forceinline__ unsigned xb_ld(unsigned* p)              { return __hip_atomic_load(p, __ATOMIC_RELAXED, __HIP_MEMORY_SCOPE_AGENT); }
__device__ __forceinline__ unsigned xb_add(unsigned* p, unsigned v) { return __hip_atomic_fetch_add(p, v, __ATOMIC_RELAXED, __HIP_MEMORY_SCOPE_AGENT); }
__device__ __forceinline__ unsigned xb_xcc_id() { return (unsigned)__builtin_amdgcn_s_getreg((3 << 11) | 20) & 0xFu; }
#define XB_SPIN(cond, bar) do { unsigned _sp = 0; while (cond) { __builtin_amdgcn_s_sleep(1); \
    if ((++_sp & 255u) == 0u) { if (xb_ld(&(bar)[XB_TMO])) break; if (_sp > XB_SPIN_CAP) { atomicAdd(&(bar)[XB_TMO], 1u); break; } } } } while (0)
struct XcdBarrier { unsigned* bar; unsigned x; volatile LAS unsigned* st; };
__device__ __forceinline__ XcdBarrier xcd_barrier_post(unsigned* bar, volatile LAS unsigned* st) {
    XcdBarrier b; b.bar = bar; b.x = xb_xcc_id(); b.st = st;
    if (threadIdx.x == 0) (void)xb_add(&bar[XB_XCNT(b.x)], 1u);
    return b;
}
__device__ __forceinline__ void xcd_barrier_complete(unsigned* bar, unsigned x, unsigned& nloc, unsigned& nx) {
    const unsigned G = gridDim.x * gridDim.y * gridDim.z;
    unsigned sum, cnt, mine, sp = 0u;
    for (;;) {
        sum = 0u; cnt = 0u; mine = 0u;
#pragma unroll
        for (unsigned j = 0; j < 16; ++j) { const unsigned c = xb_ld(&bar[XB_XCNT(j)]); sum += c; cnt += (c > 0u) ? 1u : 0u; mine = (j == x) ? c : mine; }
        if (sum == G) break;
        __builtin_amdgcn_s_sleep(1);
        if ((++sp & 255u) == 0u) { if (xb_ld(&bar[XB_TMO])) break; if (sp > XB_SPIN_CAP) { atomicAdd(&bar[XB_TMO], 1u); break; } }
    }
    nloc = mine > 0u ? mine : 1u; nx = cnt > 0u ? cnt : 1u;
}
__device__ __forceinline__ void xcd_barrier(const XcdBarrier& b, int wv);
__device__ __forceinline__ void xcd_barrier_at(unsigned* bar, volatile LAS unsigned* st, int wv) { XcdBarrier b; b.bar = bar; b.x = xb_xcc_id(); b.st = st; xcd_barrier(b, wv); }
__device__ __forceinline__ void xcd_barrier(const XcdBarrier& b, int wv) {
    asm volatile("s_waitcnt vmcnt(0)" ::: "memory");
    __syncthreads();
    if (wv == 0 && lane_id_volatile() == 0) {
        unsigned* bar = b.bar;
        __builtin_amdgcn_s_waitcnt(0);
        unsigned nloc = b.st[0], nx = b.st[1];
        if (nloc == 0u) { xcd_barrier_complete(bar, b.x, nloc, nx); b.st[0] = nloc; b.st[1] = nx; }
        const unsigned old = xb_add(&bar[XB_XSUB(b.x)], 1u);
        const unsigned gen = old / nloc;
        if (old + 1u == (gen + 1u) * nloc) {
            __builtin_amdgcn_fence(__ATOMIC_RELEASE, "agent");
            asm volatile("s_waitcnt vmcnt(0)" ::: "memory");
            const unsigned og = xb_add(&bar[XB_TOP], 1u);
            const unsigned tg = og / nx;
            if (og + 1u == (tg + 1u) * nx) xb_add(&bar[XB_TOPGEN], 1u);
            else XB_SPIN(xb_ld(&bar[XB_TOPGEN]) == tg, bar);
            __builtin_amdgcn_fence(__ATOMIC_ACQUIRE, "agent");
            xb_add(&bar[XB_XGEN(b.x)], 1u);
            asm volatile("s_waitcnt vmcnt(0)" ::: "memory");
        } else {
            XB_SPIN(xb_ld(&bar[XB_XGEN(b.x)]) == gen, bar);
            __builtin_amdgcn_fence(__ATOMIC_ACQUIRE, "agent");
            asm volatile("s_waitcnt vmcnt(0)" ::: "memory");
        }
    }
    __syncthreads();
}

constexpr int NPHASES = 12;
template <int PH> __device__ __forceinline__ void run_phase(const P& p, LAS unsigned char* lds, int bid, int nb, int wv) {
    if constexpr (PH == 0) phase_prep(p, lds, bid, nb, wv);
    if constexpr (PH == 1) phase_gemm1(p, lds, bid, nb, wv);
    constexpr int LRU_SPLIT = NBP * NSEGP + DECB / 2;
    if constexpr (PH == 2) { if (bid >= (nb >> 1)) phase_lru(p, lds, bid - (nb >> 1), nb >> 1, wv, 0, LRU_SPLIT); __syncthreads(); }
    if constexpr (PH == 3) {
        if (bid < (nb >> 1)) { phase_mlstm(p, lds, bid, nb >> 1, wv); if (MK_DUP == 30) phase_mlstm(p, lds, bid, nb >> 1, wv); __syncthreads(); phase_lru(p, lds, bid, nb >> 1, wv, LRU_SPLIT, 1 << 30); __syncthreads(); }
        else { mlstm_sample(p, lds, bid - (nb >> 1), nb >> 1, wv); if (MK_DUP == 31) mlstm_sample(p, lds, bid - (nb >> 1), nb >> 1, wv); } }
    if constexpr (PH == 4) phase_headnorm(p, bid, nb, wv);
    if constexpr (PH == 5) phase_gemm_merge(p, lds, bid, nb, wv);
    if constexpr (PH == 6) phase_gemm_out(p, lds, bid, nb, wv);
    if constexpr (PH == 7) phase_norm2(p, bid, nb, wv);
    if constexpr (PH == 8) phase_gemm_up(p, lds, bid, nb, wv);
    if constexpr (PH == 9) phase_convffn(p, bid, nb, wv);
    if constexpr (PH == 10) phase_gemm_down(p, lds, bid, nb, wv);
    if constexpr (PH == 11) phase_final(p, lds, bid, nb, wv);
}
#if MK_ONE_LAUNCH
__global__ void __launch_bounds__(NTHREADS, 2) k_fwd(P p) {
    extern __shared__ __attribute__((aligned(16))) unsigned char lds_raw[];
    LAS unsigned char* lds = (LAS unsigned char*)lds_raw;
    cg::grid_group grid = cg::this_grid();
    const int bid = (int)blockIdx.x, nb = (int)gridDim.x;
    const int wv = __builtin_amdgcn_readfirstlane((int)(threadIdx.x >> 6));
#define RUNP(X) do { run_phase<X>(p, lds, bid, nb, wv); if (MK_DUP == X) { xcd_barrier_at((unsigned*)(p.ws + WS_CTL) + CW_BAR, (volatile LAS unsigned*)(lds + LDS_BYTES - 64), wv); run_phase<X>(p, lds, bid, nb, wv); } } while (0)
    volatile LAS unsigned* bst = (volatile LAS unsigned*)(lds + LDS_BYTES - 64);
    if (threadIdx.x < 16) bst[threadIdx.x] = 0u;
    (void)xcd_barrier_post((unsigned*)(p.ws + WS_CTL) + CW_BAR, bst);
    if (nb == 0x7fffffff) grid.sync();
    run_phase<0>(p, lds, bid, nb, wv); xcd_barrier_at((unsigned*)(p.ws + WS_CTL) + CW_BAR, (volatile LAS unsigned*)(lds + LDS_BYTES - 64), wv);
    RUNP(1); xcd_barrier_at((unsigned*)(p.ws + WS_CTL) + CW_BAR, (volatile LAS unsigned*)(lds + LDS_BYTES - 64), wv);
    RUNP(2);
    RUNP(3); xcd_barrier_at((unsigned*)(p.ws + WS_CTL) + CW_BAR, (volatile LAS unsigned*)(lds + LDS_BYTES - 64), wv);
    run_phase<4>(p, lds, bid, nb, wv); xcd_barrier_at((unsigned*)(p.ws + WS_CTL) + CW_BAR, (volatile LAS unsigned*)(lds + LDS_BYTES - 64), wv);
    RUNP(5); xcd_barrier_at((unsigned*)(p.ws + WS_CTL) + CW_BAR, (volatile LAS unsigned*)(lds + LDS_BYTES - 64), wv);
    RUNP(6); xcd_barrier_at((unsigned*)(p.ws + WS_CTL) + CW_BAR, (volatile LAS unsigned*)(lds + LDS_BYTES - 64), wv);
    RUNP(8); xcd_barrier_at((unsigned*)(p.ws + WS_CTL) + CW_BAR, (volatile LAS unsigned*)(lds + LDS_BYTES - 64), wv);
    run_phase<10>(p, lds, bid, nb, wv); xcd_barrier_at((unsigned*)(p.ws + WS_CTL) + CW_BAR, (volatile LAS unsigned*)(lds + LDS_BYTES - 64), wv);
    RUNP(11);
}
#endif

#if !MK_ONE_LAUNCH
template <int PH> __global__ void __launch_bounds__(NTHREADS, 2) k_phase(P p) {
    extern __shared__ __attribute__((aligned(16))) unsigned char lds_raw[];
    run_phase<PH>(p, (LAS unsigned char*)lds_raw, (int)blockIdx.x, (int)gridDim.x, __builtin_amdgcn_readfirstlane((int)(threadIdx.x >> 6)));
}
template <int PH> static void launch_phase(const P& p, int grid, hipStream_t stream) {
    static bool attr = false;
    if (!attr) { (void)hipFuncSetAttribute((const void*)k_phase<PH>, hipFuncAttributeMaxDynamicSharedMemorySize, LDS_BYTES); attr = true; }
    hipLaunchKernelGGL(k_phase<PH>, dim3(grid), dim3(NTHREADS), LDS_BYTES, stream, p);
}
#endif

extern "C" void kernel_launch(void* const* d_in, const int* in_sizes, int n_in, void* d_out, int out_size, void* d_ws, size_t ws_size, hipStream_t stream) {
    if (n_in != 29 || (size_t)out_size != O_END || ws_size < WS_END) { fprintf(stderr, "kernel_launch: unexpected shapes (n_in %d, out %d, ws %zu)\n", n_in, out_size, ws_size); return; }
    P p{};
    for (int i = 0; i < 29; ++i) p.in[i] = (const float*)d_in[i];
    p.out = (float*)d_out; p.ws = (unsigned char*)d_ws;
#if MK_ONE_LAUNCH
    static int grid = 0;
    if (grid == 0) {
        int dev = 0, cus = 0, per_cu = 0;
        (void)hipGetDevice(&dev); (void)hipDeviceGetAttribute(&cus, hipDeviceAttributeMultiprocessorCount, dev);
        (void)hipFuncSetAttribute((const void*)k_fwd, hipFuncAttributeMaxDynamicSharedMemorySize, LDS_BYTES);
        if (hipOccupancyMaxActiveBlocksPerMultiprocessor(&per_cu, (const void*)k_fwd, NTHREADS, LDS_BYTES) != hipSuccess || per_cu < 1) { fprintf(stderr, "kernel_launch: occupancy query failed (%d)\n", per_cu); per_cu = 1; }
        grid = cus * 1;
        if (grid <= 0) grid = 256;
    }
    if (hipMemsetAsync(d_ws, 0, 32768, stream) != hipSuccess) { fprintf(stderr, "kernel_launch: memset of control words failed\n"); return; }
    void* args[] = {(void*)&p};
    hipError_t e = hipLaunchCooperativeKernel((const void*)k_fwd, dim3(grid), dim3(NTHREADS), args, LDS_BYTES, stream);
    if (e != hipSuccess) fprintf(stderr, "cooperative launch failed: %s (grid %d)\n", hipGetErrorString(e), grid);
#else
    const int grid = 256;
    launch_phase<0>(p, grid, stream); launch_phase<1>(p, grid, stream); launch_phase<2>(p, grid, stream); launch_phase<3>(p, grid, stream);
    launch_phase<4>(p, grid, stream); launch_phase<5>(p, grid, stream); launch_phase<6>(p, grid, stream); launch_phase<7>(p, grid, stream);
    launch_phase<8>(p, grid, stream); launch_phase<9>(p, grid, stream); launch_phase<10>(p, grid, stream); launch_phase<11>(p, grid, stream);
#endif
}
```

```cpp
#include <hip/hip_runtime.h>
#include <hip/hip_cooperative_groups.h>
#include <cstdio>
#include <cstdint>
namespace cg = cooperative_groups;

#ifndef MK_ONE_LAUNCH
#define MK_ONE_LAUNCH 1
#endif

#ifndef MK_KROT
#define MK_KROT 0
#endif
#ifndef MK_DUP
#define MK_DUP -1
#endif
#define LAS __attribute__((address_space(3)))
typedef unsigned short bf16_t;
typedef short bf16x8 __attribute__((ext_vector_type(8)));
typedef float f32x4 __attribute__((ext_vector_type(4)));
typedef float f32x2 __attribute__((ext_vector_type(2)));
typedef unsigned u32x4 __attribute__((ext_vector_type(4)));
typedef unsigned u32x2 __attribute__((ext_vector_type(2)));

constexpr int D = 1024, NBP = 8, SEQ = 2048, NMETA = 16, LP = SEQ + NMETA, DECB = 128, DECS = 8;
constexpr int MP = NBP * LP, MS = DECB * DECS, MTOK = MP + MS, MPAD = 17664;
constexpr int NSEQ = NBP + DECB;
constexpr int NIN = 7176, NZ = 7168;
constexpr int ZC_U = 0, ZC_Q = 1024, ZC_K = 2048, ZC_V = 3072, ZC_O = 4096, ZC_GA = 5120, ZC_GB = 6144;
constexpr int DFF = 2816, NUP = 5632, NH = 4, DH = 256;
constexpr float EPS = 1e-6f;
constexpr size_t O_YP = 0;
constexpr size_t O_YS = O_YP + (size_t)NBP * SEQ * D;
constexpr size_t O_PLC = O_YS + (size_t)DECB * DECS * D;
constexpr size_t O_PLH = O_PLC + (size_t)NBP * 3 * D;
constexpr size_t O_PC = O_PLH + (size_t)NBP * D;
constexpr size_t O_PN = O_PC + (size_t)NBP * NH * DH * DH;
constexpr size_t O_PM = O_PN + (size_t)NBP * NH * DH;
constexpr size_t O_PF = O_PM + (size_t)NBP * NH;
constexpr size_t O_SLC = O_PF + (size_t)NBP * 2 * NUP;
constexpr size_t O_SLH = O_SLC + (size_t)DECB * 3 * D;
constexpr size_t O_SC = O_SLH + (size_t)DECB * D;
constexpr size_t O_SN = O_SC + (size_t)DECB * NH * DH * DH;
constexpr size_t O_SM = O_SN + (size_t)DECB * NH * DH;
constexpr size_t O_SF = O_SM + (size_t)DECB * NH;
constexpr size_t O_END = O_SF + (size_t)DECB * 2 * NUP;
constexpr size_t MiB = 1u << 20;
constexpr size_t WS_CTL = 0, WS_WIN = 1 * MiB, WS_WCAT = 15 * MiB, WS_WOUT = 19 * MiB, WS_WUP = 21 * MiB, WS_WDOWN = 32 * MiB;
constexpr size_t WS_SMALL = 38 * MiB;
constexpr size_t WS_XN = 40 * MiB;
constexpr size_t WS_Z = 75 * MiB;
constexpr size_t WS_ACAT = 317 * MiB;
constexpr size_t WS_MERGED = 386 * MiB;
constexpr size_t WS_X1 = 421 * MiB;
constexpr size_t WS_END = 490 * MiB;
constexpr int LSEG = 64, NSEGP = 33;
constexpr size_t WS_WLRU = 39 * MiB;
constexpr size_t WS_SSQ = 39 * MiB + 512 * 1024;
constexpr size_t WS_PCUM = WS_MERGED;
constexpr size_t WS_AGG = WS_X1;
constexpr size_t WS_CARRY = WS_X1 + 4 * MiB;

struct P {
    const float* in[29];
    float* out;
    unsigned char* ws;
};
enum { I_XP = 0, I_XS, I_SLC, I_SLH, I_SC, I_SN, I_SM, I_SF, I_META, I_G1, I_WIN, I_BIN, I_LCW, I_LCB, I_LWR, I_LBR, I_LWI, I_LBI, I_LAM, I_HG, I_WA, I_WB, I_WOUT, I_G2, I_WUP, I_FCW, I_FCB, I_WDOWN, I_GF };

__device__ __forceinline__ unsigned pk2(float lo, float hi) { unsigned r; asm("v_cvt_pk_bf16_f32 %0, %1, %2" : "=v"(r) : "v"(lo), "v"(hi)); return r; }
__device__ __forceinline__ unsigned f2bf(float f) { return pk2(f, 0.f) & 0xffffu; }
__device__ __forceinline__ float bf2f(unsigned short b) { return __builtin_bit_cast(float, ((unsigned)b) << 16); }
__device__ __forceinline__ float bflo(unsigned w) { return __builtin_bit_cast(float, w << 16); }
__device__ __forceinline__ float bfhi(unsigned w) { return __builtin_bit_cast(float, w & 0xffff0000u); }
__device__ __forceinline__ void unpack8(const u32x4 w, float (&o)[8]) { o[0] = bflo(w.x); o[1] = bfhi(w.x); o[2] = bflo(w.y); o[3] = bfhi(w.y); o[4] = bflo(w.z); o[5] = bfhi(w.z); o[6] = bflo(w.w); o[7] = bfhi(w.w); }
__device__ __forceinline__ float wave_sum(float v) {
#pragma unroll
    for (int o = 1; o < 64; o <<= 1) v += __shfl_xor(v, o);
    return v;
}
__device__ __forceinline__ int lane_id_volatile() { int l; asm volatile("v_mbcnt_lo_u32_b32 %0, -1, 0\n\tv_mbcnt_hi_u32_b32 %0, -1, %0" : "=v"(l)); return l; }
__device__ __forceinline__ int opaque_tid(int wv) { return wv * 64 + lane_id_volatile(); }
__device__ __forceinline__ float sigmoidf_(float x) { return __builtin_amdgcn_rcpf(1.0f + __expf(-x)); }
constexpr int ZG_OFF = 8192, ZG_PITCH = 14336;
__device__ __forceinline__ float ub0(unsigned w) { return (float)(w & 0xffu); }
__device__ __forceinline__ float ub1(unsigned w) { return (float)((w >> 8) & 0xffu); }
__device__ __forceinline__ float ub2(unsigned w) { return (float)((w >> 16) & 0xffu); }
__device__ __forceinline__ float ub3(unsigned w) { return (float)(w >> 24); }
__device__ __forceinline__ unsigned q8(float s, unsigned lo) { const unsigned q = (unsigned)(s * 255.0f + 0.5f); return q < lo ? lo : q; }
__device__ __forceinline__ float logsigmoidf_(float x) { return fminf(x, 0.f) - log1pf(__expf(-fabsf(x))); }
__device__ __forceinline__ void seq_info(int s, int& row0, int& L) { if (s < NBP) { row0 = s * LP; L = LP; } else { row0 = MP + (s - NBP) * DECS; L = DECS; } }
__device__ __forceinline__ const float* xrow3(const float* meta, const float* xp, const float* xs, int r) {
    if (r < MP) { const int b = r / LP, t = r - b * LP; return t < NMETA ? meta + (size_t)t * D : xp + ((size_t)b * SEQ + (t - NMETA)) * D; }
    return xs + (size_t)(r - MP) * D;
}
__device__ __forceinline__ const float* xrow_ptr(const P& p, int r) {
    if (r < MP) { const int b = r / LP, t = r - b * LP; return t < NMETA ? p.in[I_META] + (size_t)t * D : p.in[I_XP] + ((size_t)b * SEQ + (t - NMETA)) * D; }
    return p.in[I_XS] + (size_t)(r - MP) * D;
}

namespace pg8 {
constexpr int BM = 256, BK = 64, HALF = 128, HTB = HALF * BK * 2, STAGE_BYTES = 8 * HTB, NXCD = 8, WGM = 8;
__host__ __device__ __forceinline__ int lds_byte(int r, int c) { const int st = (r >> 4) * 2 + (c >> 5), rr = r & 15, cc = c & 31, ob = rr * 64 + cc * 2; return st * 1024 + (ob ^ (((ob >> 9) & 1) << 5)); }
__host__ __device__ __forceinline__ void stage_rc(int b, int& R, int& C) { const int st = b / 1024, sb = b % 1024, swz = sb ^ (((sb >> 9) & 1) << 5); R = (st >> 1) * 16 + swz / 64; C = (st & 1) * 32 + (swz % 64) / 2; }
__host__ __device__ __forceinline__ int perm32(int rho) { const int n = rho >> 4, i = rho & 15; return 8 * (i >> 2) + 4 * n + (i & 3); }
__host__ __device__ __forceinline__ int up_row0(int pm) { return pm < 65 ? 254 * pm : MP + 256 * (pm - 65); }
struct Unit { int pm, pn, kt0, nt, kind, slot; };
struct Gemm { const bf16_t* A; const bf16_t* Bt; int M, N, K; int a_mode; };
struct StaticOrder {
    int nM, nN, nwg, G, c, ntk;
    __host__ __device__ void init(int M, int N, int K, int G_, int c_) { nM = M / BM; nN = N / BM; nwg = nM * nN; G = G_; c = c_; ntk = K / BK; }
    __host__ __device__ bool next(int i, Unit& u) const {
        const long L = (long)i * G + c; if (L >= nwg) return false;
        int wgid = (int)L; { const int q = nwg / NXCD, r = nwg % NXCD, xcd = wgid % NXCD, off = wgid / NXCD; wgid = (xcd < r ? xcd * (q + 1) : r * (q + 1) + (xcd - r) * q) + off; }
        const int nig = WGM * nN, gid = wgid / nig, fm = gid * WGM, gsz = (nM - fm) < WGM ? (nM - fm) : WGM;
        u.pm = fm + ((wgid % nig) % gsz); u.pn = (wgid % nig) / gsz; u.kt0 = 0; u.nt = ntk; u.kind = 0; u.slot = 0; return true;
    }
    __device__ __forceinline__ void a_ready(const Unit&) const {}
    __device__ __forceinline__ void done(const Unit&) const {}
};
struct SplitTailOrder : StaticOrder {
    int S;
    __host__ __device__ bool next(int i, Unit& u) const {
        if (S <= 0 || i == 0) return StaticOrder::next(i, u);
        if (i > 1) return false;
        const int R = nwg - G; if (R <= 0 || c >= R * S) return false;
        StaticOrder t = *this; t.c = c / S; if (!t.StaticOrder::next(1, u)) return false;
        const int sl = c % S, per = ntk / S; u.kt0 = sl * per; u.nt = per; u.kind = 1; u.slot = c; return true;
    }
};
__device__ __forceinline__ unsigned cvt_pk_bf16(float lo, float hi) { unsigned r; asm volatile("v_cvt_pk_bf16_f32 %0, %1, %2" : "=v"(r) : "v"(lo), "v"(hi)); return r; }

struct EpiBf16 {
    static constexpr bool PERM = true, APERM = false, AFTER_DRAIN = false, HAS_MID = false, TAIL_REDUCE = false;
    bf16_t* O; int ldc; const float* bias; const float* ssq;
    __device__ __forceinline__ void mid(f32x4 (&acc)[2][2][4][2], const Unit& u, int wr, int wc, int fr, int fq) const {}
    __device__ __forceinline__ void operator()(const f32x4 (&acc)[2][2][4][2], const Unit& u, int wr, int wc, int fr, int fq) const {
        const int row0 = u.pm * BM + wr * 64 + fr; const int col0 = u.pn * BM + wc * 32 + 8 * fq;
        f32x4 bv[2][2];
#pragma unroll
        for (int bj = 0; bj < 2; ++bj)
#pragma unroll
            for (int n = 0; n < 2; ++n) bv[bj][n] = bias ? *(const f32x4*)(bias + col0 + bj * HALF + 4 * n) : (f32x4){0.f, 0.f, 0.f, 0.f};
        if (u.pn >= 16) {
            const unsigned lo = (u.pn >= 24) ? 1u : 0u; unsigned char* zb = (unsigned char*)O + ZG_OFF + (col0 - 4096);
#pragma unroll
            for (int ai = 0; ai < 2; ++ai)
#pragma unroll
                for (int m = 0; m < 4; ++m) { unsigned char* rowp = zb + (size_t)(row0 + ai * HALF + m * 16) * ZG_PITCH;
#pragma unroll
                    for (int bj = 0; bj < 2; ++bj) { u32x2 w;
#pragma unroll
                        for (int n = 0; n < 2; ++n) {
                            const f32x4 t = (acc[ai][bj][m][n] + bv[bj][n]) * (-1.4426950408889634f);
                            const f32x4 d = (f32x4){__builtin_amdgcn_exp2f(t[0]), __builtin_amdgcn_exp2f(t[1]), __builtin_amdgcn_exp2f(t[2]), __builtin_amdgcn_exp2f(t[3])} + 1.0f;
                            const f32x4 sq = (f32x4){__builtin_amdgcn_rcpf(d[0]), __builtin_amdgcn_rcpf(d[1]), __builtin_amdgcn_rcpf(d[2]), __builtin_amdgcn_rcpf(d[3])} * 255.0f + 0.5f;
                            unsigned q0 = (unsigned)sq[0], q1 = (unsigned)sq[1], q2 = (unsigned)sq[2], q3 = (unsigned)sq[3];
                            if (lo) { q0 = q0 < 1u ? 1u : q0; q1 = q1 < 1u ? 1u : q1; q2 = q2 < 1u ? 1u : q2; q3 = q3 < 1u ? 1u : q3; }
                            const unsigned pw = q0 | (q1 << 8) | (q2 << 16) | (q3 << 24); if (n == 0) w.x = pw; else w.y = pw; }
                        *(u32x2*)(rowp + bj * HALF) = w; } }
            return; }
#pragma unroll
        for (int ai = 0; ai < 2; ++ai)
#pragma unroll
            for (int m = 0; m < 4; ++m) { bf16_t* rowp = O + (size_t)(row0 + ai * HALF + m * 16) * ldc + col0;
                const float rs = ssq ? 1.0f / sqrtf(ssq[row0 + ai * HALF + m * 16] * (1.0f / D) + EPS) : 1.0f;
#pragma unroll
                for (int bj = 0; bj < 2; ++bj) { const f32x4 v0 = acc[ai][bj][m][0] * rs + bv[bj][0], v1 = acc[ai][bj][m][1] * rs + bv[bj][1];
                    u32x4 w; w.x = cvt_pk_bf16(v0[0], v0[1]); w.y = cvt_pk_bf16(v0[2], v0[3]); w.z = cvt_pk_bf16(v1[0], v1[1]); w.w = cvt_pk_bf16(v1[2], v1[3]);
                    __builtin_nontemporal_store(w, (u32x4*)(rowp + bj * HALF)); } }
    }
};
template <int CTRL> __device__ __forceinline__ float dppmovz(float src) { return __builtin_bit_cast(float, __builtin_amdgcn_update_dpp(0, __builtin_bit_cast(int, src), CTRL, 0xf, 0xf, true)); }
__device__ __forceinline__ float gelu_tanh_e(float x) { const float u2 = -1.5957691216057308f * (x + 0.044715f * x * x * x); return x * __builtin_amdgcn_rcpf(1.0f + __expf(u2)); }
struct EpiUp {
    static constexpr bool PERM = true, APERM = true, AFTER_DRAIN = false, HAS_MID = false, TAIL_REDUCE = false;
    bf16_t* HM; const float* ssq; const float* cw; const float* cb; const float* sf; float* out; LAS float* EX;
    __device__ __forceinline__ void mid(f32x4 (&acc)[2][2][4][2], const Unit& u, int wr, int wc, int fr, int fq) const {}
    __device__ __forceinline__ void operator()(f32x4 (&acc)[2][2][4][2], const Unit& u, int wr, int wc, int fr_, int fq_) const {
        int fr = fr_, fq = fq_; asm volatile("" : "+v"(fr), "+v"(fq));
        const int rbase = up_row0(u.pm) + wr * 64 + 4 * fr;
        const bool sample = u.pm >= 65;
#pragma unroll
        for (int ai = 0; ai < 2; ++ai) { const f32x4 sq = *(const f32x4*)(ssq + rbase + ai * HALF);
#pragma unroll
            for (int m = 0; m < 4; ++m) { const float rs = __builtin_amdgcn_rsqf(sq[m] * (1.0f / D) + EPS);
#pragma unroll
                for (int bj = 0; bj < 2; ++bj)
#pragma unroll
                    for (int n = 0; n < 2; ++n) acc[ai][bj][m][n] = acc[ai][bj][m][n] * rs; } }
        const int cl = wc * 32 + 8 * fq;
        if (fr == 15) {
#pragma unroll
            for (int ai = 0; ai < 2; ++ai)
#pragma unroll
                for (int bj = 0; bj < 2; ++bj)
#pragma unroll
                    for (int n = 0; n < 2; ++n) { *(LAS f32x4*)(EX + ((ai * 2 + wr) * 2 + 0) * 256 + bj * 128 + cl + 4 * n) = acc[ai][bj][2][n]; *(LAS f32x4*)(EX + ((ai * 2 + wr) * 2 + 1) * 256 + bj * 128 + cl + 4 * n) = acc[ai][bj][3][n]; } }
        asm volatile("s_waitcnt lgkmcnt(0)" ::: "memory"); __builtin_amdgcn_s_barrier(); asm volatile("" ::: "memory");
        const float mk0 = (fr == 0) ? 1.f : 0.f;
        const int hal = (u.pm >= 1 && u.pm < 65) ? 2 : 0;
        const int ch0 = u.pn * 128 + cl;
#pragma unroll
        for (int n = 0; n < 2; ++n) {
            const int ch = ch0 + 4 * n;
            const f32x4 wv0 = *(const f32x4*)(cw + ch), wv1 = *(const f32x4*)(cw + NUP + ch), wv2 = *(const f32x4*)(cw + 2 * NUP + ch), bv = *(const f32x4*)(cb + ch);
            const f32x4 wg0 = *(const f32x4*)(cw + DFF + ch), wg1 = *(const f32x4*)(cw + NUP + DFF + ch), wg2 = *(const f32x4*)(cw + 2 * NUP + DFF + ch), bg = *(const f32x4*)(cb + DFF + ch);
#pragma unroll
            for (int ai = 0; ai < 2; ++ai) {
                const int r0 = rbase + ai * HALF;
                const int t0 = sample ? ((r0 - MP) & 7) : (r0 - (r0 / LP) * LP);
                f32x4 p1v, p2v, p1g, p2g;
#pragma unroll
                for (int j = 0; j < 4; ++j) { p1v[j] = dppmovz<0x111>(acc[ai][0][3][n][j]); p2v[j] = dppmovz<0x111>(acc[ai][0][2][n][j]); p1g[j] = dppmovz<0x111>(acc[ai][1][3][n][j]); p2g[j] = dppmovz<0x111>(acc[ai][1][2][n][j]); }
                if (ai + wr > 0) { const int pb = (wr == 1) ? (ai * 2) : 1;
                    p2v += *(const LAS f32x4*)(EX + (pb * 2 + 0) * 256 + cl + 4 * n) * mk0; p1v += *(const LAS f32x4*)(EX + (pb * 2 + 1) * 256 + cl + 4 * n) * mk0;
                    p2g += *(const LAS f32x4*)(EX + (pb * 2 + 0) * 256 + 128 + cl + 4 * n) * mk0; p1g += *(const LAS f32x4*)(EX + (pb * 2 + 1) * 256 + 128 + cl + 4 * n) * mk0; }
                if (sample) {
                    if ((fr & 1) == 0) { const float* b0 = sf + (size_t)((r0 - MP) >> 3) * 2 * NUP; p2v = *(const f32x4*)(b0 + ch); p2g = *(const f32x4*)(b0 + DFF + ch); p1v = *(const f32x4*)(b0 + NUP + ch); p1g = *(const f32x4*)(b0 + NUP + DFF + ch); } }
                if (!sample && __builtin_amdgcn_ballot_w64(t0 == 0) != 0ull) { const float keep = (t0 == 0) ? 0.f : 1.f; p1v = p1v * keep; p2v = p2v * keep; p1g = p1g * keep; p2g = p2g * keep; }
                const bool zmid = !sample && __builtin_amdgcn_ballot_w64(t0 == LP - 2) != 0ull; const float z2 = (!sample && t0 == LP - 2) ? 1.f : 0.f;
#pragma unroll
                for (int m = 0; m < 4; ++m) {
                    const f32x4 xv = acc[ai][0][m][n], xg = acc[ai][1][m][n];
                    const f32x4 av = (m == 0) ? p1v : acc[ai][0][m > 0 ? m - 1 : 0][n], ag = (m == 0) ? p1g : acc[ai][1][m > 0 ? m - 1 : 0][n];
                    const f32x4 bv2 = (m == 0) ? p2v : (m == 1) ? p1v : acc[ai][0][m > 1 ? m - 2 : 0][n], bg2 = (m == 0) ? p2g : (m == 1) ? p1g : acc[ai][1][m > 1 ? m - 2 : 0][n];
                    f32x4 cv = bv + wv2 * xv + wv1 * av + wv0 * bv2, cg = bg + wg2 * xg + wg1 * ag + wg0 * bg2;
                    if (zmid && m == 2) { cv -= z2 * (wv1 * av + wv0 * bv2); cg -= z2 * (wg1 * ag + wg0 * bg2); }
                    if (zmid && m == 3) { cv -= z2 * (wv0 * bv2); cg -= z2 * (wg0 * bg2); }
                    if ((ai == 1 || m >= 2) ? true : (wr * 64 + 4 * fr + m >= hal)) {
                        const f32x4 tg = cg * ((cg * cg) * 0.044715f + 1.0f), ug = tg * (-1.5957691216057308f * 1.4426950408889634f);
                        const f32x4 dg = (f32x4){__builtin_amdgcn_exp2f(ug[0]), __builtin_amdgcn_exp2f(ug[1]), __builtin_amdgcn_exp2f(ug[2]), __builtin_amdgcn_exp2f(ug[3])} + 1.0f;
                        const f32x4 og = (cg * cv) * (f32x4){__builtin_amdgcn_rcpf(dg[0]), __builtin_amdgcn_rcpf(dg[1]), __builtin_amdgcn_rcpf(dg[2]), __builtin_amdgcn_rcpf(dg[3])};
                        u32x2 w; w.x = cvt_pk_bf16(og[0], og[1]); w.y = cvt_pk_bf16(og[2], og[3]);
                        *(u32x2*)((char*)HM + (((unsigned)(r0 + m) * (unsigned)DFF + (unsigned)ch) * 2u)) = w; }
                    __builtin_amdgcn_sched_barrier(0); }
            }
        }
#pragma unroll
        for (int ai = 0; ai < 2; ++ai) {
            int r0s = rbase + ai * HALF; asm volatile("" : "+v"(r0s));
            const int t0 = sample ? ((r0s - MP) & 7) : (r0s - (r0s / LP) * LP), Lq = sample ? DECS : LP;
            if (__builtin_amdgcn_ballot_w64(t0 + 3 >= Lq - 2) != 0ull) {
                float* ob = sample ? out + O_SF + (size_t)((r0s - MP) >> 3) * 2 * NUP : out + O_PF + (size_t)(r0s / LP) * 2 * NUP;
#pragma unroll
                for (int m = 0; m < 4; ++m) { const int t = t0 + m, i = ai * HALF + wr * 64 + 4 * fr + m;
                    if (t >= Lq - 2 && t < Lq && i >= hal) { float* of = ob + (size_t)(t - (Lq - 2)) * NUP + ch0;
                        *(f32x4*)(of) = acc[ai][0][m][0]; *(f32x4*)(of + 4) = acc[ai][0][m][1]; *(f32x4*)(of + DFF) = acc[ai][1][m][0]; *(f32x4*)(of + DFF + 4) = acc[ai][1][m][1]; } } }
        }
    }
};
struct EpiMerge {
    static constexpr bool PERM = true, APERM = false, AFTER_DRAIN = false, HAS_MID = true, TAIL_REDUCE = true;
    bf16_t* O; const bf16_t* Z; float* PART; unsigned* tcnt; int S;
    __device__ __forceinline__ void mid(f32x4 (&acc)[2][2][4][2], const Unit& u, int wr, int wc, int fr, int fq) const {
        int row0 = u.pm * BM + wr * 64 + fr; const int col0 = u.pn * BM + wc * 32 + 8 * fq;
        asm volatile("" : "+v"(row0));
#pragma unroll
        for (int ai = 0; ai < 2; ++ai)
#pragma unroll
            for (int m = 0; m < 4; ++m) { const unsigned char* zr = (const unsigned char*)Z + (size_t)(row0 + ai * HALF + m * 16) * ZG_PITCH + ZG_OFF + col0;
#pragma unroll
                for (int bj = 0; bj < 2; ++bj) {
                    const u32x2 qa = *(const u32x2*)(zr + 1024 + bj * HALF), qb = *(const u32x2*)(zr + 2048 + bj * HALF);
                    const unsigned qaw[2] = {qa.x, qa.y}, qbw[2] = {qb.x, qb.y};
#pragma unroll
                    for (int n = 0; n < 2; ++n) { const unsigned wa = qaw[n], wb = qbw[n];
                        acc[ai][bj][m][n][0] *= ub0(wa) * __builtin_amdgcn_rcpf(ub0(wb)); acc[ai][bj][m][n][1] *= ub1(wa) * __builtin_amdgcn_rcpf(ub1(wb));
                        acc[ai][bj][m][n][2] *= ub2(wa) * __builtin_amdgcn_rcpf(ub2(wb)); acc[ai][bj][m][n][3] *= ub3(wa) * __builtin_amdgcn_rcpf(ub3(wb)); } }
                asm volatile("" ::: "memory"); }
    }
    __device__ __forceinline__ void operator()(const f32x4 (&acc)[2][2][4][2], const Unit& u, int wr, int wc, int fr, int fq) const {
        const int row0 = u.pm * BM + wr * 64 + fr; const int col0 = u.pn * BM + wc * 32 + 8 * fq;
#pragma unroll
        for (int ai = 0; ai < 2; ++ai)
#pragma unroll
            for (int m = 0; m < 4; ++m) { const size_t r = (size_t)(row0 + ai * HALF + m * 16);
#pragma unroll
                for (int bj = 0; bj < 2; ++bj) {
                    const u32x2 qb = *(const u32x2*)((const unsigned char*)Z + r * ZG_PITCH + ZG_OFF + 2048 + col0 + bj * HALF); const unsigned qbw[2] = {qb.x, qb.y};
                    float v[8];
#pragma unroll
                    for (int n = 0; n < 2; ++n) { const unsigned wb = qbw[n]; const f32x4 a = acc[ai][bj][m][n] * (1.0f / 255.0f);
                        v[4 * n + 0] = a[0] * ub0(wb); v[4 * n + 1] = a[1] * ub1(wb); v[4 * n + 2] = a[2] * ub2(wb); v[4 * n + 3] = a[3] * ub3(wb); }
                    u32x4 w; w.x = cvt_pk_bf16(v[0], v[1]); w.y = cvt_pk_bf16(v[2], v[3]); w.z = cvt_pk_bf16(v[4], v[5]); w.w = cvt_pk_bf16(v[6], v[7]);
                    *(u32x4*)(O + r * D + col0 + bj * HALF) = w; }
                asm volatile("" ::: "memory"); }
    }
    __device__ __forceinline__ void strip(const f32x4 (&sA)[4][2], const f32x4 (&sB)[4][2], const Unit& u, int wr, int wc, int fr, int fq, int a, int b, int m0, int nm) const {
        const int row0 = u.pm * BM + a * HALF + wr * 64 + fr, col0 = u.pn * BM + b * HALF + wc * 32 + 8 * fq;
#pragma unroll
        for (int mi = 0; mi < 4; ++mi) if (mi < nm) { const size_t r = (size_t)(row0 + (m0 + mi) * 16);
            const unsigned char* zr = (const unsigned char*)Z + r * ZG_PITCH + ZG_OFF + col0; const u32x2 qa = *(const u32x2*)(zr + 1024), qb = *(const u32x2*)(zr + 2048); const unsigned qaw[2] = {qa.x, qa.y}, qbw[2] = {qb.x, qb.y};
            float v[8];
#pragma unroll
            for (int n = 0; n < 2; ++n) { const unsigned wa = qaw[n], wb = qbw[n]; const f32x4 xa = sA[mi][n] * (1.0f / 255.0f), xb = sB[mi][n] * (1.0f / 255.0f);
                v[4 * n + 0] = ub0(wa) * xa[0] + ub0(wb) * xb[0]; v[4 * n + 1] = ub1(wa) * xa[1] + ub1(wb) * xb[1]; v[4 * n + 2] = ub2(wa) * xa[2] + ub2(wb) * xb[2]; v[4 * n + 3] = ub3(wa) * xa[3] + ub3(wb) * xb[3]; }
            u32x4 w; w.x = cvt_pk_bf16(v[0], v[1]); w.y = cvt_pk_bf16(v[2], v[3]); w.z = cvt_pk_bf16(v[4], v[5]); w.w = cvt_pk_bf16(v[6], v[7]);
            *(u32x4*)(O + r * D + col0) = w; }
    }
};
struct EpiX1 {
    static constexpr bool PERM = true, APERM = false, AFTER_DRAIN = false, HAS_MID = false, TAIL_REDUCE = true;
    const float *meta, *xp, *xs; float* X1; bf16_t* XN; float* ssq; float* PART; unsigned* tcnt; int S;
    __device__ __forceinline__ void mid(f32x4 (&acc)[2][2][4][2], const Unit& u, int wr, int wc, int fr, int fq) const {}
    __device__ __forceinline__ void operator()(const f32x4 (&acc)[2][2][4][2], const Unit& u, int wr, int wc, int fr, int fq) const {
        const int row0 = u.pm * BM + wr * 64 + fr, col0 = u.pn * BM + wc * 32 + 8 * fq;
#pragma unroll
        for (int ai = 0; ai < 2; ++ai)
#pragma unroll
            for (int m = 0; m < 4; ++m) { const int r = row0 + ai * HALF + m * 16; float sq = 0.f;
                if (r < MTOK) { const float* xr = xrow3(meta, xp, xs, r) + col0; bf16_t* ob = XN + (size_t)r * D + col0;
#pragma unroll
                    for (int bj = 0; bj < 2; ++bj) { const f32x4 v0 = *(const f32x4*)(xr + bj * HALF) + acc[ai][bj][m][0], v1 = *(const f32x4*)(xr + bj * HALF + 4) + acc[ai][bj][m][1];
                        u32x4 w; w.x = cvt_pk_bf16(v0[0], v0[1]); w.y = cvt_pk_bf16(v0[2], v0[3]); w.z = cvt_pk_bf16(v1[0], v1[1]); w.w = cvt_pk_bf16(v1[2], v1[3]); *(u32x4*)(ob + bj * HALF) = w;
                        sq += ((v0[0] * v0[0] + v0[1] * v0[1]) + (v0[2] * v0[2] + v0[3] * v0[3])) + ((v1[0] * v1[0] + v1[1] * v1[1]) + (v1[2] * v1[2] + v1[3] * v1[3])); } }
                sq += __shfl_xor(sq, 16); sq += __shfl_xor(sq, 32);
                if (fq == 0 && r < MTOK) atomicAdd(ssq + r, sq); }
    }
    __device__ __forceinline__ void strip(const f32x4 (&sA)[4][2], const f32x4 (&sB)[4][2], const Unit& u, int wr, int wc, int fr, int fq, int a, int b, int m0, int nm) const {
        const int row0 = u.pm * BM + a * HALF + wr * 64 + fr, col0 = u.pn * BM + b * HALF + wc * 32 + 8 * fq;
#pragma unroll
        for (int mi = 0; mi < 4; ++mi) if (mi < nm) { const int r = row0 + (m0 + mi) * 16; float sq = 0.f;
            if (r < MTOK) { const float* xr = xrow3(meta, xp, xs, r) + col0; bf16_t* ob = XN + (size_t)r * D + col0;
                const f32x4 v0 = *(const f32x4*)(xr) + sA[mi][0], v1 = *(const f32x4*)(xr + 4) + sA[mi][1];
                u32x4 w; w.x = cvt_pk_bf16(v0[0], v0[1]); w.y = cvt_pk_bf16(v0[2], v0[3]); w.z = cvt_pk_bf16(v1[0], v1[1]); w.w = cvt_pk_bf16(v1[2], v1[3]); *(u32x4*)ob = w;
                sq += ((v0[0] * v0[0] + v0[1] * v0[1]) + (v0[2] * v0[2] + v0[3] * v0[3])) + ((v1[0] * v1[0] + v1[1] * v1[1]) + (v1[2] * v1[2] + v1[3] * v1[3])); }
            sq += __shfl_xor(sq, 16); sq += __shfl_xor(sq, 32);
            if (fq == 0 && r < MTOK) atomicAdd(ssq + r, sq); }
    }
};
struct EpiAcc {
    static constexpr bool PERM = true, APERM = false, AFTER_DRAIN = false, HAS_MID = false, TAIL_REDUCE = false;
    const bf16_t* X1B; bf16_t* X2B; float* PART;
    __device__ __forceinline__ void mid(f32x4 (&acc)[2][2][4][2], const Unit& u, int wr, int wc, int fr, int fq) const {}
    __device__ __forceinline__ void operator()(const f32x4 (&acc)[2][2][4][2], const Unit& u, int wr, int wc, int fr, int fq) const {
        const int rl0 = wr * 64 + fr, cl0 = wc * 32 + 8 * fq;
        if (u.kind == 0) {
#pragma unroll
            for (int ai = 0; ai < 2; ++ai)
#pragma unroll
                for (int m = 0; m < 4; ++m) { const int r = u.pm * BM + rl0 + ai * HALF + m * 16;
                    if (r < MTOK) { const size_t e = (size_t)r * D + u.pn * BM + cl0;
#pragma unroll
                        for (int bj = 0; bj < 2; ++bj) { const u32x4 xw = *(const u32x4*)(X1B + e + bj * HALF); const f32x4 a0 = acc[ai][bj][m][0], a1 = acc[ai][bj][m][1];
                            u32x4 w; w.x = cvt_pk_bf16(bflo(xw.x) + a0[0], bfhi(xw.x) + a0[1]); w.y = cvt_pk_bf16(bflo(xw.y) + a0[2], bfhi(xw.y) + a0[3]);
                            w.z = cvt_pk_bf16(bflo(xw.z) + a1[0], bfhi(xw.z) + a1[1]); w.w = cvt_pk_bf16(bflo(xw.w) + a1[2], bfhi(xw.w) + a1[3]);
                            *(u32x4*)(X2B + e + bj * HALF) = w; } } }
        } else {
            bf16_t* pt = (bf16_t*)PART + (size_t)u.slot * 65536;
#pragma unroll
            for (int ai = 0; ai < 2; ++ai)
#pragma unroll
                for (int m = 0; m < 4; ++m) { bf16_t* o = pt + (size_t)(rl0 + ai * HALF + m * 16) * 256 + cl0;
#pragma unroll
                    for (int bj = 0; bj < 2; ++bj) { const f32x4 a0 = acc[ai][bj][m][0], a1 = acc[ai][bj][m][1];
                        u32x4 w; w.x = cvt_pk_bf16(a0[0], a0[1]); w.y = cvt_pk_bf16(a0[2], a0[3]); w.z = cvt_pk_bf16(a1[0], a1[1]); w.w = cvt_pk_bf16(a1[2], a1[3]); *(u32x4*)(o + bj * HALF) = w; } }
        }
    }
};

template <class Epi, class Sched, bool ALIGN_EPI = false, bool SP2 = false>
__device__ __forceinline__ void gemm_phase(LAS unsigned char* lds, const Gemm g, const Sched& S, const Epi& E, int wv) {
    int tid_ = opaque_tid(wv);
    const int tid = tid_, wid = __builtin_amdgcn_readfirstlane(tid >> 6), lane = tid & 63, wr = wid >> 2, wc = wid & 3, fr = lane & 15, fq = lane >> 4;
    const int K = g.K;
    unsigned voffA[2], voffB[2];
#pragma unroll
    for (int i = 0; i < 2; ++i) { int R, C; stage_rc(tid * 16 + i * 8192, R, C); const int Rb = Epi::PERM ? ((R & ~31) + perm32(R & 31)) : R;
        const int Ra = Epi::APERM ? ((R & ~63) + 4 * (R & 15) + ((R >> 4) & 3)) : R;
        voffA[i] = (unsigned)(Ra * K + C) * 2u; voffB[i] = (unsigned)(Rb * K + C) * 2u; }
    const size_t kstep = (size_t)(BK * 2);
    const size_t hstep = (size_t)HALF * K * 2;
    const size_t tstep = 2 * hstep;
    const unsigned ldsw = (unsigned)wid * 1024u;
    const int aoff = lds_byte(wr * 64 + fr, fq * 8), boff = lds_byte(wc * 32 + fr, fq * 8);
#define PG8_SA(b, h) (((b) * 2 + (h)) * HTB)
#define PG8_SB(b, h) ((4 + (b) * 2 + (h)) * HTB)
#define PG8_STAGE(bufoff, gbase, voff) do { _Pragma("unroll") for (int _i = 0; _i < 2; ++_i) \
        __builtin_amdgcn_global_load_lds((const unsigned*)((const char*)(gbase) + (voff)[_i]), (LAS unsigned*)(lds + (bufoff) + ldsw + _i * 8192), 16, 0, 0); } while (0)
#define PG8_LDA(dst, b, h) do { _Pragma("unroll") for (int m = 0; m < 4; ++m) _Pragma("unroll") for (int k = 0; k < 2; ++k) dst[m][k] = *(const LAS bf16x8*)(lds + PG8_SA(b, h) + aoff + m * 2048 + k * 1024); } while (0)
#define PG8_LDB(dst, b, h) do { _Pragma("unroll") for (int n = 0; n < 2; ++n) _Pragma("unroll") for (int k = 0; k < 2; ++k) dst[n][k] = *(const LAS bf16x8*)(lds + PG8_SB(b, h) + boff + n * 2048 + k * 1024); } while (0)
#define PG8_MMA(ai, bj, At, Bt) do { __builtin_amdgcn_s_setprio(1); _Pragma("unroll") for (int m = 0; m < 4; ++m) _Pragma("unroll") for (int n = 0; n < 2; ++n) _Pragma("unroll") for (int k = 0; k < 2; ++k) \
        acc[ai][bj][m][n] = __builtin_amdgcn_mfma_f32_16x16x32_bf16(Bt[n][k], At[m][k], acc[ai][bj][m][n], 0, 0, 0); __builtin_amdgcn_s_setprio(0); } while (0)
#define PG8_WAIT_V(n) asm volatile("s_waitcnt vmcnt(" #n ")" ::: "memory")
#define PG8_WAIT_L(n) asm volatile("s_waitcnt lgkmcnt(" #n ")" ::: "memory")
#define PG8_BAR __builtin_amdgcn_s_barrier()
#define PG8_SCHED __builtin_amdgcn_sched_barrier(0)
    Unit cur, nxt; int ui = 0;
    if (!S.next(0, cur)) return;
    f32x4 acc[2][2][4][2];
#pragma unroll
    for (int a = 0; a < 2; ++a)
#pragma unroll
        for (int b = 0; b < 2; ++b)
#pragma unroll
            for (int m = 0; m < 4; ++m)
#pragma unroll
                for (int n = 0; n < 2; ++n) acc[a][b][m][n] = (f32x4){0.f, 0.f, 0.f, 0.f};
    bf16x8 At[4][2], B0[2][2], B1[2][2];
    const char* cA = (const char*)g.A + (size_t)(g.a_mode ? up_row0(cur.pm) : cur.pm * BM) * K * 2 + (size_t)cur.kt0 * kstep; const char* cB = (const char*)g.Bt + (size_t)cur.pn * tstep + (size_t)cur.kt0 * kstep;
    S.a_ready(cur);
    auto krot = [](const Unit& u) -> int { return (MK_KROT && !Epi::HAS_MID && u.kind == 0) ? (((((u.pm + 2 * u.pn) & 7) * u.nt) >> 3) & ~1) : 0; };
    int crot = krot(cur);
    { const char* fA = cA + (size_t)crot * kstep; const char* fB = cB + (size_t)crot * kstep;
    if constexpr (SP2) {
        PG8_STAGE(PG8_SB(0, 0), fB, voffB); PG8_STAGE(PG8_SB(0, 1), fB + hstep, voffB); PG8_STAGE(PG8_SA(0, 0), fA, voffA); PG8_STAGE(PG8_SA(0, 1), fA + hstep, voffA);
        if (wr == 1) PG8_BAR;
        PG8_WAIT_V(2); PG8_BAR;
        PG8_STAGE(PG8_SB(1, 0), fB + kstep, voffB); PG8_STAGE(PG8_SA(1, 0), fA + kstep, voffA); PG8_STAGE(PG8_SB(1, 1), fB + hstep + kstep, voffB);
        PG8_WAIT_V(6); PG8_BAR;
    } else {
        PG8_STAGE(PG8_SB(0, 0), fB, voffB); PG8_STAGE(PG8_SA(0, 0), fA, voffA); PG8_STAGE(PG8_SB(0, 1), fB + hstep, voffB); PG8_STAGE(PG8_SA(0, 1), fA + hstep, voffA);
        if (wr == 1) PG8_BAR;
        PG8_WAIT_V(4); PG8_BAR;
        PG8_STAGE(PG8_SB(1, 0), fB + kstep, voffB); PG8_STAGE(PG8_SA(1, 0), fA + kstep, voffA); PG8_STAGE(PG8_SB(1, 1), fB + hstep + kstep, voffB);
        PG8_WAIT_V(6); PG8_BAR;
    } }
    for (;;) {
        const bool has_next = S.next(ui + 1, nxt);
        const char* nA = has_next ? (const char*)g.A + (size_t)(g.a_mode ? up_row0(nxt.pm) : nxt.pm * BM) * K * 2 + (size_t)nxt.kt0 * kstep : cA; const char* nB = has_next ? (const char*)g.Bt + (size_t)nxt.pn * tstep + (size_t)nxt.kt0 * kstep : cB;
        const int nt = cur.nt; const int nrot = has_next ? krot(nxt) : 0;
        for (int t = 0; t < nt; t += 2) {
            const bool last = (t == nt - 2);
            int k1 = crot + t + 1, k2 = crot + t + 2; if (k1 >= nt) k1 -= nt; if (k2 >= nt) k2 -= nt;
            const char* a1 = cA + (size_t)k1 * kstep;
            const char* a2 = last ? nA + (size_t)nrot * kstep : cA + (size_t)k2 * kstep; const char* b2 = last ? nB + (size_t)nrot * kstep : cB + (size_t)k2 * kstep;
            const char* a3 = a2 + kstep; const char* b3 = b2 + kstep;
            if (last && has_next) S.a_ready(nxt);
            if constexpr (Epi::HAS_MID) { if (cur.kind == 0 && t == (nt >> 1)) E.mid(acc, cur, wr, wc, fr, fq); }
            if constexpr (SP2) {
            PG8_LDB(B0, 0, 0); PG8_LDB(B1, 0, 1); PG8_SCHED; PG8_LDA(At, 0, 0); PG8_STAGE(PG8_SA(1, 1), a1 + hstep, voffA);
            PG8_WAIT_V(8); PG8_WAIT_L(0); PG8_BAR; PG8_MMA(0, 0, At, B0); PG8_MMA(0, 1, At, B1); PG8_BAR; PG8_SCHED;
            PG8_LDA(At, 0, 1); PG8_STAGE(PG8_SB(0, 0), b2, voffB); PG8_STAGE(PG8_SB(0, 1), b2 + hstep, voffB); PG8_STAGE(PG8_SA(0, 0), a2, voffA);
            PG8_WAIT_V(8); PG8_WAIT_L(0); PG8_BAR; PG8_MMA(1, 0, At, B0); PG8_MMA(1, 1, At, B1); PG8_BAR; PG8_SCHED;
            PG8_LDB(B0, 1, 0); PG8_LDB(B1, 1, 1); PG8_SCHED; PG8_LDA(At, 1, 0); PG8_STAGE(PG8_SA(0, 1), a2 + hstep, voffA);
            PG8_WAIT_V(8); PG8_WAIT_L(0); PG8_BAR; PG8_MMA(0, 0, At, B0); PG8_MMA(0, 1, At, B1); PG8_BAR; PG8_SCHED;
            PG8_LDA(At, 1, 1); PG8_STAGE(PG8_SB(1, 0), b3, voffB); PG8_STAGE(PG8_SB(1, 1), b3 + hstep, voffB); PG8_STAGE(PG8_SA(1, 0), a3, voffA);
            PG8_WAIT_V(8); PG8_WAIT_L(0); PG8_BAR; PG8_MMA(1, 0, At, B0); PG8_MMA(1, 1, At, B1); PG8_BAR; PG8_SCHED;
            } else {
            PG8_LDB(B0, 0, 0); PG8_SCHED; PG8_LDA(At, 0, 0); PG8_STAGE(PG8_SA(1, 1), a1 + hstep, voffA);
            PG8_WAIT_L(8); PG8_BAR; PG8_WAIT_L(0); PG8_MMA(0, 0, At, B0); PG8_BAR; PG8_SCHED;
            PG8_LDB(B1, 0, 1); PG8_STAGE(PG8_SB(0, 0), b2, voffB);
            PG8_BAR; PG8_WAIT_L(0); PG8_MMA(0, 1, At, B1); PG8_BAR;
            PG8_LDA(At, 0, 1); PG8_STAGE(PG8_SA(0, 0), a2, voffA);
            PG8_BAR; PG8_WAIT_L(0); PG8_MMA(1, 0, At, B0); PG8_BAR; PG8_SCHED;
            PG8_STAGE(PG8_SB(0, 1), b2 + hstep, voffB);
            PG8_WAIT_V(6); PG8_BAR; PG8_MMA(1, 1, At, B1); PG8_BAR;
            PG8_LDB(B0, 1, 0); PG8_SCHED; PG8_LDA(At, 1, 0); PG8_STAGE(PG8_SA(0, 1), a2 + hstep, voffA);
            PG8_WAIT_L(8); PG8_BAR; PG8_WAIT_L(0); PG8_MMA(0, 0, At, B0); PG8_BAR; PG8_SCHED;
            PG8_LDB(B1, 1, 1); PG8_STAGE(PG8_SB(1, 0), b3, voffB);
            PG8_BAR; PG8_WAIT_L(0); PG8_MMA(0, 1, At, B1); PG8_BAR;
            PG8_LDA(At, 1, 1); PG8_STAGE(PG8_SA(1, 0), a3, voffA);
            PG8_BAR; PG8_WAIT_L(0); PG8_MMA(1, 0, At, B0); PG8_BAR; PG8_SCHED;
            PG8_STAGE(PG8_SB(1, 1), b3 + hstep, voffB);
            PG8_WAIT_V(6); PG8_BAR; PG8_MMA(1, 1, At, B1); PG8_BAR;
            }
        }
        if constexpr (ALIGN_EPI) { if (wr == 0) PG8_BAR; }
        if constexpr (Epi::TAIL_REDUCE) {
            if (cur.kind == 1) {
                const int tix = cur.slot / E.S, sl = cur.slot - tix * E.S; LAS unsigned* bw = (LAS unsigned*)(lds + STAGE_BYTES + 8192);
                { const __amdgpu_buffer_rsrc_t rs = __builtin_amdgcn_make_buffer_rsrc(E.PART, 0, 0x7fffffff, 0x00020000); const unsigned base = ((unsigned)cur.slot * 8192u + (unsigned)tid) * 16u;
#pragma unroll
                  for (int a = 0; a < 2; ++a)
#pragma unroll
                      for (int b = 0; b < 2; ++b)
#pragma unroll
                          for (int m = 0; m < 4; ++m) { const f32x4 a0 = acc[a][b][m][0], a1 = acc[a][b][m][1];
                              u32x4 w; w.x = cvt_pk_bf16(a0[0], a0[1]); w.y = cvt_pk_bf16(a0[2], a0[3]); w.z = cvt_pk_bf16(a1[0], a1[1]); w.w = cvt_pk_bf16(a1[2], a1[3]);
                              __builtin_amdgcn_raw_buffer_store_b128(w, rs, base + (unsigned)(((a * 2 + b) * 4 + m) * 512 * 16), 0, 16); } }
                asm volatile("s_waitcnt vmcnt(0)" ::: "memory"); PG8_BAR; asm volatile("" ::: "memory");
                if (tid == 0) { (void)__hip_atomic_fetch_add(E.tcnt + tix, 1u, __ATOMIC_RELAXED, __HIP_MEMORY_SCOPE_AGENT);
                    unsigned sp = 0; while (__hip_atomic_load(E.tcnt + tix, __ATOMIC_RELAXED, __HIP_MEMORY_SCOPE_AGENT) < (unsigned)E.S) { __builtin_amdgcn_s_sleep(2); if (++sp > (1u << 22)) break; }
                    __builtin_amdgcn_fence(__ATOMIC_ACQUIRE, "agent"); }
                asm volatile("s_waitcnt vmcnt(0) lgkmcnt(0)" ::: "memory"); PG8_BAR; asm volatile("" ::: "memory");
                __builtin_amdgcn_fence(__ATOMIC_ACQUIRE, "agent"); asm volatile("s_waitcnt vmcnt(0)" ::: "memory");
                const int per = 32 / E.S, i0 = sl * per, sa_ = i0 >> 4, sb_ = (i0 >> 3) & 1, m0 = (i0 >> 1) & 3, nm = per >> 1;
                f32x4 sA[4][2], sB[4][2];
#pragma unroll
                for (int mi = 0; mi < 4; ++mi)
#pragma unroll
                    for (int n = 0; n < 2; ++n) { sA[mi][n] = (f32x4){0.f, 0.f, 0.f, 0.f}; sB[mi][n] = (f32x4){0.f, 0.f, 0.f, 0.f}; }
#pragma unroll 1
                for (int s2 = 0; s2 < E.S; ++s2) {
                    const u32x4* pp = (const u32x4*)((const char*)E.PART + (size_t)(tix * E.S + s2) * 131072) + tid + (i0 >> 1) * 512; f32x4 tq[4][2];
#pragma unroll
                    for (int mi = 0; mi < 4; ++mi) { u32x4 pw = {0u, 0u, 0u, 0u}; if (mi < nm) pw = pp[mi * 512];
                        tq[mi][0] = (f32x4){__builtin_bit_cast(float, pw.x << 16), __builtin_bit_cast(float, pw.x & 0xffff0000u), __builtin_bit_cast(float, pw.y << 16), __builtin_bit_cast(float, pw.y & 0xffff0000u)};
                        tq[mi][1] = (f32x4){__builtin_bit_cast(float, pw.z << 16), __builtin_bit_cast(float, pw.z & 0xffff0000u), __builtin_bit_cast(float, pw.w << 16), __builtin_bit_cast(float, pw.w & 0xffff0000u)}; }
                    const bool second = Epi::HAS_MID && (s2 >= (E.S >> 1));
#pragma unroll
                    for (int mi = 0; mi < 4; ++mi)
#pragma unroll
                        for (int n = 0; n < 2; ++n) { if (second) sB[mi][n] += tq[mi][n]; else sA[mi][n] += tq[mi][n]; } }
                E.strip(sA, sB, cur, wr, wc, fr, fq, sa_, sb_, m0, nm);
            } else E(acc, cur, wr, wc, fr, fq);
        } else E(acc, cur, wr, wc, fr, fq);
        S.done(cur);
        if (!has_next) break;
#pragma unroll
        for (int a = 0; a < 2; ++a)
#pragma unroll
            for (int b = 0; b < 2; ++b)
#pragma unroll
                for (int m = 0; m < 4; ++m)
#pragma unroll
                    for (int n = 0; n < 2; ++n) acc[a][b][m][n] = (f32x4){0.f, 0.f, 0.f, 0.f};
        cur = nxt; cA = nA; cB = nB; crot = nrot; ++ui;
        if constexpr (ALIGN_EPI) { if (wr == 1) PG8_BAR; }
    }
    PG8_WAIT_V(0);
    if constexpr (!ALIGN_EPI) { if (wr == 0) PG8_BAR; }
    PG8_BAR;
#undef PG8_SA
#undef PG8_SB
#undef PG8_STAGE
#undef PG8_LDA
#undef PG8_LDB
#undef PG8_MMA
#undef PG8_WAIT_V
#undef PG8_WAIT_L
#undef PG8_BAR
#undef PG8_SCHED
}
}

constexpr int LDS_BYTES = 159744;
constexpr int NTHREADS = 512;

__device__ __forceinline__ void tr_item(const float* W, int ldw, int k0, int ns0, bf16_t* WT, int ldt, int nd0, int kd0, const float* kscale, float cs, LAS float* scr, int lane) {
    float wv_[32];
#pragma unroll
    for (int i = 0; i < 32; ++i) wv_[i] = W[(size_t)(k0 + 2 * i + (lane >> 5)) * ldw + ns0 + (lane & 31)];
#pragma unroll
    for (int i = 0; i < 32; ++i) { const int kk = 2 * i + (lane >> 5); const float s = kscale ? kscale[k0 + kk] * cs : cs; scr[kk * 33 + (lane & 31)] = wv_[i] * s; }
    asm volatile("s_waitcnt lgkmcnt(0)" ::: "memory");
    const int c = lane & 7;
#pragma unroll
    for (int j = 0; j < 4; ++j) { const int n = (lane >> 3) + 8 * j; const LAS float* s = scr + (8 * c) * 33 + n;
        u32x4 o; o.x = pk2(s[0 * 33], s[1 * 33]); o.y = pk2(s[2 * 33], s[3 * 33]); o.z = pk2(s[4 * 33], s[5 * 33]); o.w = pk2(s[6 * 33], s[7 * 33]);
        *(u32x4*)(WT + (size_t)(nd0 + n) * ldt + kd0 + k0 + 8 * c) = o; }
    asm volatile("s_waitcnt lgkmcnt(0)" ::: "memory");
}
__device__ __forceinline__ void phase_prep(const P& p, LAS unsigned char* lds, int bid, int nb, int wv) {
    const int tid = opaque_tid(wv), lane = tid & 63, wave = tid >> 6;
    unsigned char* ws = p.ws;
    LAS float* scr = (LAS float*)(lds + wave * 8448);
    LAS float* wg = (LAS float*)(lds + 8 * 8448);
    const float* w_in = p.in[I_WIN];
    for (int i = tid; i < 8192; i += NTHREADS) { const int k = i >> 3, j = i & 7; wg[j * 1024 + k] = w_in[(size_t)k * NIN + 5120 + j]; }
    __syncthreads();
    const int gw = wave * nb + bid, NGW = nb * 8;
    constexpr int I_IN = 16 * 224;
    for (int it = gw; it < I_IN; it += NGW) { const int kb = it / 224, nbk = it % 224, n0 = nbk * 32; const int ns0 = n0 + (n0 >= 5120 ? 8 : 0); const float cs = (n0 >= ZC_Q && n0 < ZC_K) ? 0.0625f : 1.0f;
        tr_item(w_in, NIN, kb * 64, ns0, (bf16_t*)(ws + WS_WIN), 1024, n0, 0, nullptr, cs, scr, lane); }
    { bf16_t* WL = (bf16_t*)(ws + WS_WLRU);
      for (int e = bid * NTHREADS + tid; e < 2 * 65536; e += nb * NTHREADS) { const int gate = e >> 16, n = (e >> 12) & 15, d = (e >> 6) & 63, c = e & 63;
          WL[e] = (bf16_t)f2bf((gate ? p.in[I_LWI] : p.in[I_LWR])[(size_t)(n * 64 + c) * 64 + d]); }
    }
    { float* ssq = (float*)(ws + WS_SSQ); for (int i = bid * NTHREADS + tid; i < MPAD; i += nb * NTHREADS) ssq[i] = 0.f; }
    { float* bias1 = (float*)(ws + WS_SMALL); const float* b_in = p.in[I_BIN];
      for (int n = bid * NTHREADS + tid; n < NZ; n += nb * NTHREADS) { const float cs = (n >= ZC_Q && n < ZC_K) ? 0.0625f : 1.0f; bias1[n] = b_in[n + (n >= 5120 ? 8 : 0)] * cs; } }
    { bf16_t* XN = (bf16_t*)(ws + WS_XN); float* gates = (float*)(ws + WS_SMALL + 65536); const float* g1 = p.in[I_G1]; const float* b_in = p.in[I_BIN];
      f32x4 vn[4];
      if (gw < MTOK) { const f32x4* xr = (const f32x4*)xrow_ptr(p, gw) + lane;
#pragma unroll
          for (int j = 0; j < 4; ++j) vn[j] = xr[64 * j]; }
      for (int m = gw; m < MTOK; m += NGW) {
          f32x4 v[4]; float s = 0.f;
#pragma unroll
          for (int j = 0; j < 4; ++j) v[j] = vn[j];
          if (m + NGW < MTOK) { const f32x4* xr = (const f32x4*)xrow_ptr(p, m + NGW) + lane;
#pragma unroll
              for (int j = 0; j < 4; ++j) vn[j] = xr[64 * j]; }
#pragma unroll
          for (int j = 0; j < 4; ++j) s += (v[j].x * v[j].x + v[j].y * v[j].y) + (v[j].z * v[j].z + v[j].w * v[j].w);
          const float rstd = 1.0f / sqrtf(wave_sum(s) * (1.0f / D) + EPS);
          unsigned long long* o8 = (unsigned long long*)(XN + (size_t)m * D) + lane;
          float ga[8];
#pragma unroll
          for (int q = 0; q < 8; ++q) ga[q] = 0.f;
#pragma unroll
          for (int j = 0; j < 4; ++j) { const f32x4 gg = ((const f32x4*)g1)[lane + 64 * j]; v[j] = v[j] * rstd * gg;
              o8[64 * j] = (unsigned long long)pk2(v[j].x, v[j].y) | ((unsigned long long)pk2(v[j].z, v[j].w) << 32);
#pragma unroll
              for (int q = 0; q < 8; ++q) { const f32x4 w = *(const LAS f32x4*)(wg + q * 1024 + 4 * (lane + 64 * j)); ga[q] += (v[j].x * w.x + v[j].y * w.y) + (v[j].z * w.z + v[j].w * w.w); } }
#pragma unroll
          for (int q = 0; q < 8; ++q) ga[q] = wave_sum(ga[q]);
          if (lane < 8) { float r = ga[0];
#pragma unroll
              for (int q = 1; q < 8; ++q) r = (lane == q) ? ga[q] : r;
              gates[(size_t)m * 8 + lane] = r + b_in[5120 + lane]; }
      } }
}

__device__ __forceinline__ void lru_load8(const bf16_t* Z, const float* st, int row0, int L, int tok, int ch, float (&o)[8]) {
    if (tok >= 0) { const int tc = tok < L ? tok : L - 1; const u32x4 w = *(const u32x4*)(Z + (size_t)(row0 + tc) * NZ + ZC_U + ch);
        o[0] = bflo(w.x); o[1] = bfhi(w.x); o[2] = bflo(w.y); o[3] = bfhi(w.y); o[4] = bflo(w.z); o[5] = bfhi(w.z); o[6] = bflo(w.w); o[7] = bfhi(w.w); }
    else if (st) { const f32x4 a = *(const f32x4*)(st + (size_t)(3 + tok) * D + ch), b = *(const f32x4*)(st + (size_t)(3 + tok) * D + ch + 4);
        o[0] = a.x; o[1] = a.y; o[2] = a.z; o[3] = a.w; o[4] = b.x; o[5] = b.y; o[6] = b.z; o[7] = b.w; }
    else {
#pragma unroll
        for (int q = 0; q < 8; ++q) o[q] = 0.f; }
}
__device__ __forceinline__ void phase_lru(const P& p, LAS unsigned char* lds, int bid, int nb, int wv, int it_lo, int it_hi) {
    const int tid = opaque_tid(wv), lane = tid & 63, w = __builtin_amdgcn_readfirstlane(tid >> 6), g = lane >> 4, li = lane & 15;
    const bf16_t* Z = (const bf16_t*)(p.ws + WS_Z); bf16_t* ACAT = (bf16_t*)(p.ws + WS_ACAT); bf16_t* PCUM = (bf16_t*)(p.ws + WS_PCUM);
    float* AGG = (float*)(p.ws + WS_AGG); float* CARRY = (float*)(p.ws + WS_CARRY); const bf16_t* WL = (const bf16_t*)(p.ws + WS_WLRU); unsigned* cnt = (unsigned*)(p.ws + WS_CTL);
    LAS float* cwL = (LAS float*)(lds + w * 6400);
    LAS float* ucL = cwL + 320;
    LAS float* gbL = cwL + 1408;
    const int n = bid & 15;
    LAS unsigned char* wls = lds + 8 * 6400;
    for (int i = tid; i < 1024; i += NTHREADS) { const int row = i >> 3, ch8 = i & 7; *(LAS u32x4*)(wls + row * 144 + ch8 * 16) = *(const u32x4*)(WL + (size_t)((row >> 6) * 16 + n) * 4096 + (row & 63) * 64 + ch8 * 8); }
    __syncthreads();
    constexpr int NPI = NBP * NSEGP, NIT = NPI + DECB;
    const int nwv = (nb >> 4) * 8;
    for (int it = it_lo + (bid >> 4) * 8 + w; it < (it_hi < NIT ? it_hi : NIT); it += nwv) {
        int s, seg;
        constexpr int NFULL = NBP * (NSEGP - 1);
        if (it < NFULL) { seg = it % (NSEGP - 1); s = it / (NSEGP - 1); } else if (it < NPI) { s = it - NFULL; seg = NSEGP - 1; } else { s = NBP + (it - NPI); seg = 0; }
        int row0, L; seq_info(s, row0, L);
        const int tb = seg * LSEG, te = (tb + LSEG < L) ? tb + LSEG : L, ntile = (te - tb + 15) >> 4;
        const float* st = (s >= NBP) ? p.in[I_SLC] + (size_t)(s - NBP) * 3 * D : nullptr;
        { const int ch = n * 64 + lane; cwL[lane] = p.in[I_LCW][ch]; cwL[64 + lane] = p.in[I_LCW][D + ch]; cwL[128 + lane] = p.in[I_LCW][2 * D + ch]; cwL[192 + lane] = p.in[I_LCW][3 * D + ch]; cwL[256 + lane] = p.in[I_LCB][ch]; }
        { const int ch = n * 64 + lane; const float lam = p.in[I_LAM][ch]; gbL[lane] = p.in[I_LBR][ch]; gbL[64 + lane] = p.in[I_LBI][ch]; gbL[128 + lane] = 8.0f * (fmaxf(-lam, 0.f) + log1pf(__expf(-fabsf(lam)))); }
        float hc[4], pc[4];
#pragma unroll
        for (int q = 0; q < 4; ++q) { const int ch = n * 64 + 16 * q + li; hc[q] = (s >= NBP) ? p.in[I_SLH][(size_t)(s - NBP) * D + ch] : 0.f; pc[q] = 1.f; }
        const int cA = n * 64 + 8 * g, cB = cA + 32;
        u32x4 rwa[4], rwb[4];
#define LRU_LOADRAW(tt0_) do { _Pragma("unroll") for (int d = 0; d < 4; ++d) { int tok = (tt0_) + li - 3 + d; tok = tok < 0 ? 0 : (tok < L ? tok : L - 1); \
            const bf16_t* zr = Z + (size_t)(row0 + tok) * NZ + ZC_U; rwa[d] = *(const u32x4*)(zr + cA); rwb[d] = *(const u32x4*)(zr + cB); } } while (0)
        LRU_LOADRAW(tb);
        for (int tile = 0; tile < ntile; ++tile) {
            const int tt0 = tb + tile * 16, t = tt0 + li;
            float ucA[8], ucB[8];
            { const f32x4 b0 = *(const LAS f32x4*)(cwL + 256 + 8 * g), b1 = *(const LAS f32x4*)(cwL + 256 + 8 * g + 4), b2 = *(const LAS f32x4*)(cwL + 256 + 32 + 8 * g), b3 = *(const LAS f32x4*)(cwL + 256 + 32 + 8 * g + 4);
              ucA[0] = b0.x; ucA[1] = b0.y; ucA[2] = b0.z; ucA[3] = b0.w; ucA[4] = b1.x; ucA[5] = b1.y; ucA[6] = b1.z; ucA[7] = b1.w;
              ucB[0] = b2.x; ucB[1] = b2.y; ucB[2] = b2.z; ucB[3] = b2.w; ucB[4] = b3.x; ucB[5] = b3.y; ucB[6] = b3.z; ucB[7] = b3.w; }
#pragma unroll
            for (int d = 0; d < 4; ++d) { float ua[8], ub[8]; unpack8(rwa[d], ua); unpack8(rwb[d], ub);
                if (tt0 == 0 && t - 3 + d < 0) { lru_load8(Z, st, row0, L, t - 3 + d, cA, ua); lru_load8(Z, st, row0, L, t - 3 + d, cB, ub); }
                const f32x4 w0 = *(const LAS f32x4*)(cwL + d * 64 + 8 * g), w1 = *(const LAS f32x4*)(cwL + d * 64 + 8 * g + 4), w2 = *(const LAS f32x4*)(cwL + d * 64 + 32 + 8 * g), w3 = *(const LAS f32x4*)(cwL + d * 64 + 32 + 8 * g + 4);
                ucA[0] += w0.x * ua[0]; ucA[1] += w0.y * ua[1]; ucA[2] += w0.z * ua[2]; ucA[3] += w0.w * ua[3]; ucA[4] += w1.x * ua[4]; ucA[5] += w1.y * ua[5]; ucA[6] += w1.z * ua[6]; ucA[7] += w1.w * ua[7];
                ucB[0] += w2.x * ub[0]; ucB[1] += w2.y * ub[1]; ucB[2] += w2.z * ub[2]; ucB[3] += w2.w * ub[3]; ucB[4] += w3.x * ub[4]; ucB[5] += w3.y * ub[5]; ucB[6] += w3.z * ub[6]; ucB[7] += w3.w * ub[7]; }
            if (tile + 1 < ntile) LRU_LOADRAW(tt0 + 16);
            *(LAS f32x4*)(ucL + li * 68 + 8 * g) = (f32x4){ucA[0], ucA[1], ucA[2], ucA[3]}; *(LAS f32x4*)(ucL + li * 68 + 8 * g + 4) = (f32x4){ucA[4], ucA[5], ucA[6], ucA[7]};
            *(LAS f32x4*)(ucL + li * 68 + 32 + 8 * g) = (f32x4){ucB[0], ucB[1], ucB[2], ucB[3]}; *(LAS f32x4*)(ucL + li * 68 + 32 + 8 * g + 4) = (f32x4){ucB[4], ucB[5], ucB[6], ucB[7]};
            bf16x8 af[2];
            { u32x4 a0, a1; a0.x = pk2(ucA[0], ucA[1]); a0.y = pk2(ucA[2], ucA[3]); a0.z = pk2(ucA[4], ucA[5]); a0.w = pk2(ucA[6], ucA[7]);
              a1.x = pk2(ucB[0], ucB[1]); a1.y = pk2(ucB[2], ucB[3]); a1.z = pk2(ucB[4], ucB[5]); a1.w = pk2(ucB[6], ucB[7]);
              af[0] = __builtin_bit_cast(bf16x8, a0); af[1] = __builtin_bit_cast(bf16x8, a1); }
            f32x4 ra[4], ia[4];
#pragma unroll
            for (int q = 0; q < 4; ++q) { ra[q] = (f32x4){0.f, 0.f, 0.f, 0.f}; ia[q] = (f32x4){0.f, 0.f, 0.f, 0.f};
#pragma unroll
                for (int k = 0; k < 2; ++k) { const bf16x8 wr0 = *(const LAS bf16x8*)(wls + (16 * q + li) * 144 + (32 * k + 8 * g) * 2), wi0 = *(const LAS bf16x8*)(wls + (64 + 16 * q + li) * 144 + (32 * k + 8 * g) * 2);
                    ra[q] = __builtin_amdgcn_mfma_f32_16x16x32_bf16(af[k], wr0, ra[q], 0, 0, 0); ia[q] = __builtin_amdgcn_mfma_f32_16x16x32_bf16(af[k], wi0, ia[q], 0, 0, 0); } }
            asm volatile("s_waitcnt lgkmcnt(0)" ::: "memory");
#pragma unroll
            for (int q = 0; q < 4; ++q) {
                const float brq = gbL[16 * q + li], biq = gbL[64 + 16 * q + li], sp8q = gbL[128 + 16 * q + li];
                float av[4], hv[4], pv[4];
                {
                    constexpr float L2E = 1.4426950408889634f;
                    const f32x4 uc4 = {ucL[(4 * g + 0) * 68 + 16 * q + li], ucL[(4 * g + 1) * 68 + 16 * q + li], ucL[(4 * g + 2) * 68 + 16 * q + li], ucL[(4 * g + 3) * 68 + 16 * q + li]};
                    const f32x4 xr = (ra[q] + brq) * (-L2E), xi = (ia[q] + biq) * (-L2E);
                    const f32x4 dr = (f32x4){__builtin_amdgcn_exp2f(xr[0]), __builtin_amdgcn_exp2f(xr[1]), __builtin_amdgcn_exp2f(xr[2]), __builtin_amdgcn_exp2f(xr[3])} + 1.0f;
                    const f32x4 di = (f32x4){__builtin_amdgcn_exp2f(xi[0]), __builtin_amdgcn_exp2f(xi[1]), __builtin_amdgcn_exp2f(xi[2]), __builtin_amdgcn_exp2f(xi[3])} + 1.0f;
                    const f32x4 rg = {__builtin_amdgcn_rcpf(dr[0]), __builtin_amdgcn_rcpf(dr[1]), __builtin_amdgcn_rcpf(dr[2]), __builtin_amdgcn_rcpf(dr[3])};
                    const f32x4 ig = {__builtin_amdgcn_rcpf(di[0]), __builtin_amdgcn_rcpf(di[1]), __builtin_amdgcn_rcpf(di[2]), __builtin_amdgcn_rcpf(di[3])};
                    const f32x4 la = rg * (-sp8q), y = la + la, le = la * L2E;
                    const f32x4 a4 = {__builtin_amdgcn_exp2f(le[0]), __builtin_amdgcn_exp2f(le[1]), __builtin_amdgcn_exp2f(le[2]), __builtin_amdgcn_exp2f(le[3])};
                    const f32x4 ser = (0.0f - y) * (1.0f + y * (0.5f + y * (0.16666667f + y * (0.041666668f + y * 0.0083333338f)))), dir = 1.0f - a4 * a4;
                    const f32x4 iu = ig * uc4;
#pragma unroll
                    for (int r = 0; r < 4; ++r) { const float om = (y[r] > -0.125f) ? ser[r] : dir[r]; float a = a4[r], inp = __builtin_amdgcn_sqrtf(om) * iu[r];
                        if (tt0 + 4 * g + r >= te) { a = 1.f; inp = 0.f; }
                        av[r] = a; hv[r] = inp; } }
                pv[0] = av[0];
#pragma unroll
                for (int r = 1; r < 4; ++r) { hv[r] = av[r] * hv[r - 1] + hv[r]; pv[r] = av[r] * pv[r - 1]; }
                float Pg[4], Hg[4];
#pragma unroll
                for (int x = 0; x < 4; ++x) { Pg[x] = __shfl(pv[3], li + 16 * x); Hg[x] = __shfl(hv[3], li + 16 * x); }
                float cin = hc[q], pin = pc[q], mycin = cin, mypin = pin;
#pragma unroll
                for (int x = 0; x < 4; ++x) { cin = Hg[x] + Pg[x] * cin; pin = Pg[x] * pin; if (g == x + 1) { mycin = cin; mypin = pin; } }
                hc[q] = cin; pc[q] = pin;
                { const unsigned ao = ((unsigned)(row0 + tt0 + 4 * g) * 2048u + (unsigned)(n * 64 + li)) * 2u, po = ((unsigned)(row0 + tt0 + 4 * g) * (unsigned)D + (unsigned)(n * 64 + li)) * 2u;
                  if (tt0 + 16 <= te) {
#pragma unroll
                      for (int r = 0; r < 4; ++r) { *(bf16_t*)((char*)ACAT + (ao + (unsigned)(r * 4096 + q * 32))) = (bf16_t)f2bf(hv[r] + pv[r] * mycin);
                          if (seg > 0) *((unsigned char*)PCUM + ((po >> 1) + (unsigned)(r * D + q * 16))) = (unsigned char)q8(pv[r] * mypin, 0u); }
                  } else {
#pragma unroll
                      for (int r = 0; r < 4; ++r) { if (tt0 + 4 * g + r < te) { *(bf16_t*)((char*)ACAT + (ao + (unsigned)(r * 4096 + q * 32))) = (bf16_t)f2bf(hv[r] + pv[r] * mycin);
                          if (seg > 0) *((unsigned char*)PCUM + ((po >> 1) + (unsigned)(r * D + q * 16))) = (unsigned char)q8(pv[r] * mypin, 0u); } } } }
            }
        }
        const int lane = lane_id_volatile(), g = lane >> 4, li = lane & 15;
        if (te == L) { float* oc = (s < NBP) ? p.out + O_PLC + (size_t)s * 3 * D : p.out + O_SLC + (size_t)(s - NBP) * 3 * D; const int ch = n * 64 + lane;
#pragma unroll
            for (int i = 0; i < 3; ++i) oc[(size_t)i * D + ch] = bf2f(Z[(size_t)(row0 + L - 3 + i) * NZ + ZC_U + ch]); }
        if (s >= NBP) { if (g == 0) {
#pragma unroll
            for (int q = 0; q < 4; ++q) p.out[O_SLH + (size_t)(s - NBP) * D + n * 64 + 16 * q + li] = hc[q]; } }
        else {
            if (g == 0) {
#pragma unroll
                for (int q = 0; q < 4; ++q) { float* ag = AGG + ((size_t)(s * NSEGP + seg) * D + n * 64 + 16 * q + li) * 2;
                    __hip_atomic_store(ag, pc[q], __ATOMIC_RELAXED, __HIP_MEMORY_SCOPE_AGENT); __hip_atomic_store(ag + 1, hc[q], __ATOMIC_RELAXED, __HIP_MEMORY_SCOPE_AGENT); } }
            asm volatile("s_waitcnt vmcnt(0)" ::: "memory");
            unsigned old = 0; if (lane == 0) old = __hip_atomic_fetch_add(cnt + s * 16 + n, 1u, __ATOMIC_RELAXED, __HIP_MEMORY_SCOPE_AGENT);
            old = (unsigned)__builtin_amdgcn_readfirstlane((int)old);
            if (old == NSEGP - 1) {
                __builtin_amdgcn_fence(__ATOMIC_ACQUIRE, "agent");
                const int ch = n * 64 + lane; const float* ag0 = AGG + ((size_t)(s * NSEGP) * D + ch) * 2;
                float Pv[NSEGP], Ev[NSEGP];
#pragma unroll
                for (int sg = 0; sg < NSEGP; ++sg) { Pv[sg] = __hip_atomic_load(ag0 + (size_t)sg * D * 2, __ATOMIC_RELAXED, __HIP_MEMORY_SCOPE_AGENT); Ev[sg] = __hip_atomic_load(ag0 + (size_t)sg * D * 2 + 1, __ATOMIC_RELAXED, __HIP_MEMORY_SCOPE_AGENT); }
                float c = 0.f;
#pragma unroll
                for (int sg = 0; sg < NSEGP; ++sg) { CARRY[(size_t)(s * NSEGP + sg) * D + ch] = c; c = Ev[sg] + Pv[sg] * c; }
                p.out[O_PLH + (size_t)s * D + ch] = c; }
        }
        asm volatile("s_waitcnt lgkmcnt(0)" ::: "memory");
    }
#undef LRU_LOADRAW
}

constexpr int ML_RS = 528, ML_VS = 144;
constexpr int ML_Q = 0, ML_K = 33792, ML_CT = 67584, ML_VT = 101376, ML_WV = 110592, ML_SW = 119808, ML_N = 129024, ML_GA = 130048, ML_QN = 131328, ML_DEN = 131584, ML_SC = 132096;
typedef short v4s __attribute__((ext_vector_type(4)));
__device__ __forceinline__ int vt_off(int R, int gi) { return R * ML_VS + ((gi ^ ((R >> 3) & 7)) << 4); }
__device__ __forceinline__ float scan_sum64(float x, int lane) {
#pragma unroll
    for (int o = 1; o < 64; o <<= 1) { const float t = __shfl_up(x, o); if (lane >= o) x += t; }
    return x;
}
__device__ __forceinline__ float scan_max64(float x, int lane) {
#pragma unroll
    for (int o = 1; o < 64; o <<= 1) { const float t = __shfl_up(x, o); if (lane >= o) x = fmaxf(x, t); }
    return x;
}
constexpr int ML_AL = 132160, ML_BL = ML_AL + 8448, ML_ML = ML_BL + 8448, ML_NT = ML_ML + 8448;
__device__ __forceinline__ void phase_mlstm(const P& p, LAS unsigned char* lds, int bid, int nb, int wv) {
    const int tid = opaque_tid(wv), lane = tid & 63, w = __builtin_amdgcn_readfirstlane(tid >> 6), g = lane >> 4, li = lane & 15;
    const bf16_t* Z = (const bf16_t*)(p.ws + WS_Z); bf16_t* ACAT = (bf16_t*)(p.ws + WS_ACAT); const float* gates = (const float*)(p.ws + WS_SMALL + 65536);
    LAS float* nL = (LAS float*)(lds + ML_N); LAS float* wkL = (LAS float*)(lds + ML_GA); LAS float* totL = wkL + 64; LAS float* cmxL = wkL + 128;
    LAS float* qnL = (LAS float*)(lds + ML_QN); LAS float* denL = (LAS float*)(lds + ML_DEN);
    LAS float* aL = (LAS float*)(lds + ML_AL); LAS float* BL = (LAS float*)(lds + ML_BL); LAS float* ML_ = (LAS float*)(lds + ML_ML);
    for (int it = bid; it < NBP * 16; it += nb) {
        const int lane = lane_id_volatile(), tid = w * 64 + lane, g = lane >> 4, li = lane & 15;
        const int sh = (it & 7) + 8 * (it >> 5), s = sh >> 2, hh = sh & 3, j = (it >> 3) & 3;
        int row0, L; seq_info(s, row0, L);
        const int nch = (L + 63) >> 6;
        const float m0 = 0.f;
        f32x4 cacc[2][4], nacc[2];
#pragma unroll
        for (int di = 0; di < 2; ++di) { nacc[di] = (f32x4){0.f, 0.f, 0.f, 0.f};
#pragma unroll
            for (int vi = 0; vi < 4; ++vi) cacc[di][vi] = (f32x4){0.f, 0.f, 0.f, 0.f}; }
        {
#pragma unroll 1
          for (int c = w; c < nch; c += 8) { const int t = c * 64 + lane; const bool valid = t < L; const float* gr = gates + (size_t)(row0 + t) * 8 + hh;
              const float lf = valid ? logsigmoidf_(gr[4]) : 0.f; const float sl = scan_sum64(lf, lane); aL[t] = valid ? gr[0] : -INFINITY; BL[t] = sl; if (lane == 63) totL[c] = sl; }
          __syncthreads();
          { const float x = (lane < nch) ? totL[lane] : 0.f; const float inc = scan_sum64(x, lane);
#pragma unroll 1
            for (int c = w; c < nch; c += 8) { const int t = c * 64 + lane; const float boff = (c > 0) ? __shfl(inc, c - 1) : 0.f; const float Bt = boff + BL[t]; const float a = aL[t] - Bt;
                const float ml = scan_max64(a, lane); aL[t] = a; BL[t] = Bt; ML_[t] = ml; if (lane == 63) cmxL[c] = ml; } }
          __syncthreads();
          { const float x = (lane < nch) ? cmxL[lane] : -INFINITY; const float pm = scan_max64(x, lane);
#pragma unroll 1
            for (int c = w; c < nch; c += 8) { const int t = c * 64 + lane; const float mp = (c > 0) ? fmaxf(m0, __shfl(pm, c - 1)) : m0; ML_[t] = fmaxf(mp, ML_[t]); } }
        }
        u32x4 pq[4], pk[4], pv;
#define ML_LOAD(t0_) do { const int t0__ = (t0_); \
            _Pragma("unroll") for (int i = 0; i < 4; ++i) { const int id = tid + 512 * i, rr = id >> 5, ch = id & 31; const bf16_t* zr = Z + (size_t)(row0 + t0__ + rr) * NZ + hh * DH + ch * 8; \
                pq[i] = *(const u32x4*)(zr + ZC_Q); pk[i] = *(const u32x4*)(zr + ZC_K); } \
            { const int rr = tid >> 3, ch = tid & 7; pv = *(const u32x4*)(Z + (size_t)(row0 + t0__ + rr) * NZ + ZC_V + hh * DH + j * 64 + ch * 8); } } while (0)
        ML_LOAD(0);
        for (int c = 0; c < nch; ++c) {
            const int t0 = c * 64;
            int tid_c = tid; asm volatile("" : "+v"(tid_c));
            const int tid = tid_c, lane = tid & 63, g = lane >> 4, li = lane & 15;
#pragma unroll
            for (int i = 0; i < 4; ++i) { const int id = tid + 512 * i, rr = id >> 5, ch = id & 31;
                *(LAS u32x4*)(lds + ML_Q + rr * ML_RS + ch * 16) = pq[i]; *(LAS u32x4*)(lds + ML_K + rr * ML_RS + ch * 16) = pk[i]; }
            { const int rr = tid >> 3, ch = tid & 7; const unsigned vw[4] = {pv.x, pv.y, pv.z, pv.w};
#pragma unroll
                for (int q = 0; q < 4; ++q) { *(LAS unsigned short*)(lds + ML_VT + vt_off(ch * 8 + 2 * q, rr >> 3) + (rr & 7) * 2) = (unsigned short)(vw[q] & 0xffffu);
                                              *(LAS unsigned short*)(lds + ML_VT + vt_off(ch * 8 + 2 * q + 1, rr >> 3) + (rr & 7) * 2) = (unsigned short)(vw[q] >> 16); } }
#pragma unroll
            for (int di = 0; di < 2; ++di) {
#pragma unroll
                for (int vi = 0; vi < 4; ++vi) { u32x2 cw; cw.x = pk2(cacc[di][vi][0], cacc[di][vi][1]); cw.y = pk2(cacc[di][vi][2], cacc[di][vi][3]);
                    *(LAS u32x2*)(lds + ML_CT + (16 * vi + li) * ML_RS + (32 * w + 16 * di + 4 * g) * 2) = cw; }
                if (li == 0) { u32x2 nw; nw.x = pk2(nacc[di][0], nacc[di][1]); nw.y = pk2(nacc[di][2], nacc[di][3]); *(LAS u32x2*)(lds + ML_NT + (32 * w + 16 * di + 4 * g) * 2) = nw; } }
            __syncthreads();
            if (c + 1 < nch) ML_LOAD(t0 + 64);
            const float Mprev = (c > 0) ? ML_[t0 - 1] : m0, MT = ML_[t0 + 63];
            bf16x8 qf[8];
            { const int ti = w >> 1, si0 = 2 * (w & 1); const bool need0 = si0 <= ti, need1 = si0 + 1 <= ti, needn = (w & 1) == 0;
              f32x4 a0 = {0.f, 0.f, 0.f, 0.f}, a1 = {0.f, 0.f, 0.f, 0.f}, aN = {0.f, 0.f, 0.f, 0.f};
              bf16x8 kf[8], nf[8];
#pragma unroll
              for (int k = 0; k < 8; ++k) qf[k] = *(const LAS bf16x8*)(lds + ML_Q + (16 * ti + li) * ML_RS + (32 * k + 8 * g) * 2);
              if (need0) {
#pragma unroll
                  for (int k = 0; k < 8; ++k) kf[k] = *(const LAS bf16x8*)(lds + ML_K + (16 * si0 + li) * ML_RS + (32 * k + 8 * g) * 2); }
              if (needn) {
#pragma unroll
                  for (int k = 0; k < 8; ++k) { const u32x4 t = *(const LAS u32x4*)(lds + ML_NT + (32 * k + 8 * g) * 2); nf[k] = __builtin_bit_cast(bf16x8, (li == 0) ? t : (u32x4){0u, 0u, 0u, 0u}); } }
              __builtin_amdgcn_sched_barrier(0);
              if (need0) {
#pragma unroll
                  for (int k = 0; k < 8; ++k) a0 = __builtin_amdgcn_mfma_f32_16x16x32_bf16(kf[k], qf[k], a0, 0, 0, 0); }
              __builtin_amdgcn_sched_barrier(0);
              if (need1) {
#pragma unroll
                  for (int k = 0; k < 8; ++k) kf[k] = *(const LAS bf16x8*)(lds + ML_K + (16 * si0 + 16 + li) * ML_RS + (32 * k + 8 * g) * 2); }
              if (needn) {
#pragma unroll
                  for (int k = 0; k < 8; ++k) aN = __builtin_amdgcn_mfma_f32_16x16x32_bf16(nf[k], qf[k], aN, 0, 0, 0);
                  if (g == 0) qnL[16 * ti + li] = aN[0]; }
              __builtin_amdgcn_sched_barrier(0);
              if (need1) {
#pragma unroll
                  for (int k = 0; k < 8; ++k) a1 = __builtin_amdgcn_mfma_f32_16x16x32_bf16(kf[k], qf[k], a1, 0, 0, 0); }
              const int tau = 16 * ti + li; const float Mt = ML_[t0 + tau]; float dsum = 0.f;
#pragma unroll
              for (int x = 0; x < 2; ++x) { const f32x4 acc = x ? a1 : a0; const int sb = 16 * (si0 + x) + 4 * g; const f32x4 as = *(const LAS f32x4*)(aL + t0 + sb); float v[4];
#pragma unroll
                  for (int r = 0; r < 4; ++r) { const float wgt = (sb + r <= tau) ? __expf(as[r] - Mt) : 0.f; v[r] = acc[r] * wgt; dsum += v[r]; }
                  u32x2 sw; sw.x = pk2(v[0], v[1]); sw.y = pk2(v[2], v[3]);
                  *(LAS u32x2*)(lds + ML_SW + tau * ML_VS + sb * 2) = sw; }
              dsum += __shfl_xor(dsum, 16); dsum += __shfl_xor(dsum, 32);
              if (g == 0) denL[tau * 2 + (w & 1)] = dsum; }
            { const int dv0 = tid >> 4, sp = tid & 15; const f32x4 as = *(const LAS f32x4*)(aL + t0 + 4 * sp);
              const f32x4 wk = {__expf(as.x - MT), __expf(as.y - MT), __expf(as.z - MT), __expf(as.w - MT)};
              if (dv0 == 0) *(LAS f32x4*)(wkL + 4 * sp) = wk;
#pragma unroll
              for (int x = 0; x < 2; ++x) { const int dv = dv0 + 32 * x; const u32x2 vv = *(const LAS u32x2*)(lds + ML_VT + vt_off(dv, sp >> 1) + (sp & 1) * 8);
                  u32x2 o; o.x = pk2(bflo(vv.x) * wk.x, bfhi(vv.x) * wk.y); o.y = pk2(bflo(vv.y) * wk.z, bfhi(vv.y) * wk.w);
                  *(LAS u32x2*)(lds + ML_WV + dv * ML_VS + sp * 8) = o; } }
            __syncthreads();
            { const int ti = w >> 1;
              bf16x8 sf[2];
#pragma unroll
              for (int k = 0; k < 2; ++k) sf[k] = *(const LAS bf16x8*)(lds + ML_SW + (16 * ti + li) * ML_VS + (32 * k + 8 * g) * 2);
#pragma unroll
              for (int x = 0; x < 2; ++x) { const int vi = (w & 1) + 2 * x; f32x4 acc = {0.f, 0.f, 0.f, 0.f}, acc2 = {0.f, 0.f, 0.f, 0.f};
              bf16x8 cf[8], vf[2];
#pragma unroll
              for (int k = 0; k < 8; ++k) cf[k] = *(const LAS bf16x8*)(lds + ML_CT + (16 * vi + li) * ML_RS + (32 * k + 8 * g) * 2);
#pragma unroll
              for (int k = 0; k < 2; ++k) vf[k] = *(const LAS bf16x8*)(lds + ML_VT + vt_off(16 * vi + li, 4 * k + g));
              const int tau = 16 * ti + li; const float Mt = ML_[t0 + tau], Bt = BL[t0 + tau], qn = qnL[tau]; const float d0 = denL[tau * 2], d1 = denL[tau * 2 + 1];
              __builtin_amdgcn_sched_barrier(0);
#pragma unroll
              for (int k = 0; k < 8; ++k) acc = __builtin_amdgcn_mfma_f32_16x16x32_bf16(cf[k], qf[k], acc, 0, 0, 0);
#pragma unroll
              for (int k = 0; k < 2; ++k) acc2 = __builtin_amdgcn_mfma_f32_16x16x32_bf16(vf[k], sf[k], acc2, 0, 0, 0);
              const float ei = __expf(Mprev - Mt);
              acc = acc * ei + acc2;
              const float den = d0 + d1 + ei * qn;
              const float inv = __builtin_amdgcn_rcpf(fmaxf(fabsf(den), __expf(-(Bt + Mt))));
              acc = acc * inv;
              if (t0 + tau < L) { u32x2 hw; hw.x = pk2(acc[0], acc[1]); hw.y = pk2(acc[2], acc[3]); *(u32x2*)(ACAT + (size_t)(row0 + t0 + tau) * 2048 + 1024 + hh * DH + j * 64 + 16 * vi + 4 * g) = hw; } } }
            { const float decay = __expf(Mprev - MT);
#pragma unroll
              for (int di = 0; di < 2; ++di) { nacc[di] = nacc[di] * decay;
#pragma unroll
                  for (int vi = 0; vi < 4; ++vi) cacc[di][vi] = cacc[di][vi] * decay; }
              const int q = li >> 2, pp = li & 3;
              bf16x8 ak[2][2], bw[2][4], bnf[2];
#pragma unroll
              for (int k = 0; k < 2; ++k) {
#pragma unroll
                  for (int di = 0; di < 2; ++di) {
                      const v4s lo = __builtin_amdgcn_ds_read_tr16_b64_v4i16((LAS v4s*)(lds + ML_K + (32 * k + 8 * g + q) * ML_RS + (32 * w + 16 * di + 4 * pp) * 2));
                      const v4s hi = __builtin_amdgcn_ds_read_tr16_b64_v4i16((LAS v4s*)(lds + ML_K + (32 * k + 8 * g + 4 + q) * ML_RS + (32 * w + 16 * di + 4 * pp) * 2));
                      ak[k][di] = (bf16x8){lo.x, lo.y, lo.z, lo.w, hi.x, hi.y, hi.z, hi.w}; }
#pragma unroll
                  for (int vi = 0; vi < 4; ++vi) bw[k][vi] = *(const LAS bf16x8*)(lds + ML_WV + (16 * vi + li) * ML_VS + (32 * k + 8 * g) * 2);
                  { const f32x4 w0 = *(const LAS f32x4*)(wkL + 32 * k + 8 * g), w1 = *(const LAS f32x4*)(wkL + 32 * k + 8 * g + 4);
                    u32x4 bn; bn.x = pk2(w0.x, w0.y); bn.y = pk2(w0.z, w0.w); bn.z = pk2(w1.x, w1.y); bn.w = pk2(w1.z, w1.w);
                    if (li != 0) bn = (u32x4){0u, 0u, 0u, 0u};
                    bnf[k] = __builtin_bit_cast(bf16x8, bn); } }
              __builtin_amdgcn_sched_barrier(0);
#pragma unroll
              for (int k = 0; k < 2; ++k) {
#pragma unroll
                  for (int vi = 0; vi < 4; ++vi)
#pragma unroll
                      for (int di = 0; di < 2; ++di) cacc[di][vi] = __builtin_amdgcn_mfma_f32_16x16x32_bf16(ak[k][di], bw[k][vi], cacc[di][vi], 0, 0, 0);
#pragma unroll
                  for (int di = 0; di < 2; ++di) nacc[di] = __builtin_amdgcn_mfma_f32_16x16x32_bf16(ak[k][di], bnf[k], nacc[di], 0, 0, 0); } }
            __syncthreads();
        }
#undef ML_LOAD
        { const int lane = lane_id_volatile(), g = lane >> 4, li = lane & 15;
          float* oC = p.out + O_PC + ((size_t)s * NH + hh) * DH * DH; float* oN = p.out + O_PN + ((size_t)s * NH + hh) * DH; float* oM = p.out + O_PM + (size_t)s * NH + hh;
#pragma unroll
          for (int di = 0; di < 2; ++di)
#pragma unroll
              for (int vi = 0; vi < 4; ++vi)
#pragma unroll
                  for (int r = 0; r < 4; ++r) oC[(size_t)(32 * w + 16 * di + 4 * g + r) * DH + j * 64 + 16 * vi + li] = cacc[di][vi][r];
          if (j == 0 && li == 0) {
#pragma unroll
              for (int di = 0; di < 2; ++di) *(f32x4*)(oN + 32 * w + 16 * di + 4 * g) = nacc[di]; }
          if (j == 0 && w == 0 && lane == 0) oM[0] = BL[L - 1] + ML_[L - 1]; }
        __syncthreads();
    }
}

constexpr int MS_NP = 0, MS_QF = 0, MS_KF = 8192, MS_QT = 32768, MS_WT = 40960, MS_SS = 49152, MS_HALF = 65536;
__device__ __forceinline__ void mlstm_sample(const P& p, LAS unsigned char* lds, int bid, int nb, int wv) {
    const int tid = opaque_tid(wv), half = tid >> 8, lt = tid & 255, lane = tid & 63, wq = (tid >> 6) & 3;
    const bf16_t* Z = (const bf16_t*)(p.ws + WS_Z); bf16_t* ACAT = (bf16_t*)(p.ws + WS_ACAT); const float* gates = (const float*)(p.ws + WS_SMALL + 65536);
    LAS unsigned char* hb = lds + half * MS_HALF;
    LAS float* NP = (LAS float*)(hb + MS_NP); LAS float* QF = (LAS float*)(hb + MS_QF); LAS float* KF = (LAS float*)(hb + MS_KF); LAS float* QT = (LAS float*)(hb + MS_QT); LAS float* WT = (LAS float*)(hb + MS_WT); LAS float* SS = (LAS float*)(hb + MS_SS);
    for (int pp = bid; pp < DECB * NH / 2; pp += nb) {
        const int pr = pp * 2 + half, b = pr >> 2, hh = pr & 3; const int rowb = MP + b * DECS;
        const float* C0 = p.in[I_SC] + (size_t)pr * DH * DH; float* OC = p.out + O_SC + (size_t)pr * DH * DH;
        float aG[8], MtG[8], BtG[8], wk[8]; const float m0 = p.in[I_SM][pr];
        { float Bc = 0.f, Mc = m0;
#pragma unroll
          for (int t = 0; t < 8; ++t) { const float* gr = gates + (size_t)(rowb + t) * 8 + hh; const float ig = gr[0], lf = logsigmoidf_(gr[4]); Bc += lf; BtG[t] = Bc; aG[t] = ig - Bc; Mc = fmaxf(Mc, aG[t]); MtG[t] = Mc; } }
        const float MT = MtG[7], decay = __expf(m0 - MT);
#pragma unroll
        for (int t = 0; t < 8; ++t) wk[t] = __expf(aG[t] - MT);
        { float kq[8], kk[8]; const bf16_t* zr = Z + (size_t)rowb * NZ + hh * DH + lt;
#pragma unroll
          for (int t = 0; t < 8; ++t) { kq[t] = bf2f(zr[(size_t)t * NZ + ZC_Q]); kk[t] = bf2f(zr[(size_t)t * NZ + ZC_K]); QF[t * 256 + lt] = kq[t]; KF[t * 256 + lt] = kk[t]; }
          const float n0 = p.in[I_SN][(size_t)pr * DH + lt]; KF[8 * 256 + lt] = n0;
          *(LAS f32x4*)(QT + lt * 8) = (f32x4){kq[0], kq[1], kq[2], kq[3]}; *(LAS f32x4*)(QT + lt * 8 + 4) = (f32x4){kq[4], kq[5], kq[6], kq[7]};
          float nn = decay * n0;
#pragma unroll
          for (int t = 0; t < 8; ++t) { kk[t] *= wk[t]; nn += kk[t]; }
          *(LAS f32x4*)(WT + lt * 8) = (f32x4){kk[0], kk[1], kk[2], kk[3]}; *(LAS f32x4*)(WT + lt * 8 + 4) = (f32x4){kk[4], kk[5], kk[6], kk[7]};
          p.out[O_SN + (size_t)pr * DH + lt] = nn;
          if (lt == 0) { p.out[O_SM + pr] = BtG[7] + MT;
#pragma unroll
              for (int t = 0; t < 8; ++t) { SS[80 + t] = aG[t]; SS[88 + t] = MtG[t]; SS[96 + t] = BtG[t]; } } }
        f32x4 vv[8];
#pragma unroll
        for (int t = 0; t < 8; ++t) { const u32x2 w = *(const u32x2*)(Z + (size_t)(rowb + t) * NZ + ZC_V + hh * DH + 4 * lane); vv[t] = (f32x4){bflo(w.x), bfhi(w.x), bflo(w.y), bfhi(w.y)}; }
        const f32x4* cp = (const f32x4*)(C0 + (size_t)(64 * wq) * DH) + lane; f32x4* op = (f32x4*)(OC + (size_t)(64 * wq) * DH) + lane;
        f32x4 cr[4];
#pragma unroll
        for (int i = 0; i < 4; ++i) cr[i] = __builtin_nontemporal_load(cp + i * 64);
        __syncthreads();
        if (lt < 144) { const int pair = lt >> 1, part = lt & 1, t = pair / 9, sp = pair - 9 * t; float acc = 0.f;
#pragma unroll 8
            for (int i = 0; i < 32; ++i) { const f32x4 a = *(const LAS f32x4*)(QF + t * 256 + part * 128 + 4 * i), bq = *(const LAS f32x4*)(KF + sp * 256 + part * 128 + 4 * i); acc += (a.x * bq.x + a.y * bq.y) + (a.z * bq.z + a.w * bq.w); }
            acc += __shfl_xor(acc, 1);
            if (part == 0) SS[pair] = acc; }
        __syncthreads();
        f32x4 num[8];
#pragma unroll
        for (int t = 0; t < 8; ++t) num[t] = (f32x4){0.f, 0.f, 0.f, 0.f};
        const LAS float* qtp = QT + 64 * wq * 8; const LAS float* wtp = WT + 64 * wq * 8;
#pragma unroll 1
        for (int rb = 0; rb < 64; rb += 4) {
            f32x4 cn[4];
            cp += 4 * 64;
            if (rb + 4 < 64) {
#pragma unroll
                for (int i = 0; i < 4; ++i) cn[i] = __builtin_nontemporal_load(cp + i * 64); }
#pragma unroll
            for (int i = 0; i < 4; ++i) {
                const f32x4 q0 = *(const LAS f32x4*)(qtp + i * 8), q1 = *(const LAS f32x4*)(qtp + i * 8 + 4), w0 = *(const LAS f32x4*)(wtp + i * 8), w1 = *(const LAS f32x4*)(wtp + i * 8 + 4);
                const f32x4 c = cr[i];
                num[0] += q0.x * c; num[1] += q0.y * c; num[2] += q0.z * c; num[3] += q0.w * c; num[4] += q1.x * c; num[5] += q1.y * c; num[6] += q1.z * c; num[7] += q1.w * c;
                f32x4 o = decay * c + w0.x * vv[0]; o += w0.y * vv[1]; o += w0.z * vv[2]; o += w0.w * vv[3]; o += w1.x * vv[4]; o += w1.y * vv[5]; o += w1.z * vv[6]; o += w1.w * vv[7];
                __builtin_nontemporal_store(o, op + i * 64); }
            op += 4 * 64; qtp += 32; wtp += 32;
            if (rb + 4 < 64) {
#pragma unroll
                for (int i = 0; i < 4; ++i) cr[i] = cn[i]; }
        }
#pragma unroll
        for (int t = 0; t < 8; ++t) *(LAS f32x4*)(NP + (wq * 8 + t) * 256 + 4 * lane) = num[t];
        __syncthreads();
        { const int t = lt >> 5, d8 = (lt & 31) * 8; float nc[8];
#pragma unroll
          for (int i = 0; i < 8; ++i) nc[i] = 0.f;
#pragma unroll
          for (int x = 0; x < 4; ++x) { const f32x4 a = *(const LAS f32x4*)(NP + (x * 8 + t) * 256 + d8), c2 = *(const LAS f32x4*)(NP + (x * 8 + t) * 256 + d8 + 4);
              nc[0] += a.x; nc[1] += a.y; nc[2] += a.z; nc[3] += a.w; nc[4] += c2.x; nc[5] += c2.y; nc[6] += c2.z; nc[7] += c2.w; }
          const float Mt = SS[88 + t], Bt = SS[96 + t]; const float eint = __expf(m0 - Mt);
          float den = eint * SS[t * 9 + 8];
#pragma unroll
          for (int i = 0; i < 8; ++i) nc[i] *= eint;
#pragma unroll
          for (int sI = 0; sI < 8; ++sI) { const float sw = (sI <= t) ? SS[t * 9 + sI] * __expf(SS[80 + sI] - Mt) : 0.f; den += sw;
              float v8[8]; unpack8(*(const u32x4*)(Z + (size_t)(rowb + sI) * NZ + ZC_V + hh * DH + d8), v8);
#pragma unroll
              for (int i = 0; i < 8; ++i) nc[i] += sw * v8[i]; }
          const float dinv = 1.0f / fmaxf(fabsf(den), __expf(-(Bt + Mt)));
          u32x4 w; w.x = pk2(nc[0] * dinv, nc[1] * dinv); w.y = pk2(nc[2] * dinv, nc[3] * dinv); w.z = pk2(nc[4] * dinv, nc[5] * dinv); w.w = pk2(nc[6] * dinv, nc[7] * dinv);
          *(u32x4*)(ACAT + (size_t)(rowb + t) * 2048 + 1024 + hh * DH + d8) = w; }
        __syncthreads();
    }
}

__device__ __forceinline__ void phase_headnorm(const P& p, int bid, int nb, int wv) {
    const int tid = opaque_tid(wv), lane = tid & 63, wave = tid >> 6;
    const bf16_t* Z = (const bf16_t*)(p.ws + WS_Z); bf16_t* ACAT = (bf16_t*)(p.ws + WS_ACAT); const float* hg = p.in[I_HG];
    const bf16_t* PCUM = (const bf16_t*)(p.ws + WS_PCUM); const float* CARRY = (const float*)(p.ws + WS_CARRY);
    f32x4 gg[4];
#pragma unroll
    for (int j = 0; j < 4; ++j) gg[j] = ((const f32x4*)hg)[lane + 64 * j];
    for (int m = wave * nb + bid; m < MTOK; m += nb * 8) {
        u32x2* ap = (u32x2*)(ACAT + (size_t)m * 2048) + lane; u32x2* hp = ap + 256; const unsigned* op = (const unsigned*)((const unsigned char*)Z + (size_t)m * ZG_PITCH + ZG_OFF) + lane;
        bool fix = false; int sq = 0, seg = 0;
        if (m < MP) { sq = m / LP; seg = (m - sq * LP) >> 6; fix = seg > 0; }
        u32x2 hv[4], av[4]; unsigned ov[4], pv[4]; f32x4 cv[4];
#pragma unroll
        for (int j = 0; j < 4; ++j) { hv[j] = hp[64 * j]; ov[j] = op[64 * j]; }
        if (fix) { const unsigned* pp = (const unsigned*)((const unsigned char*)PCUM + (size_t)m * D) + lane; const f32x4* cp = (const f32x4*)(CARRY + (size_t)(sq * NSEGP + seg) * D) + lane;
#pragma unroll
            for (int j = 0; j < 4; ++j) { av[j] = ap[64 * j]; pv[j] = pp[64 * j]; cv[j] = cp[64 * j]; } }
        if (fix) {
#pragma unroll
            for (int j = 0; j < 4; ++j) { const f32x4 c = cv[j] * (1.0f / 255.0f); u32x2 o; o.x = pk2(bflo(av[j].x) + ub0(pv[j]) * c.x, bfhi(av[j].x) + ub1(pv[j]) * c.y); o.y = pk2(bflo(av[j].y) + ub2(pv[j]) * c.z, bfhi(av[j].y) + ub3(pv[j]) * c.w); ap[64 * j] = o; } }
#pragma unroll
        for (int j = 0; j < 4; ++j) {
            float v0 = bflo(hv[j].x), v1 = bfhi(hv[j].x), v2 = bflo(hv[j].y), v3 = bfhi(hv[j].y);
            const float ssq = wave_sum((v0 * v0 + v1 * v1) + (v2 * v2 + v3 * v3));
            const float rstd = 1.0f / sqrtf(ssq * (1.0f / DH) + EPS);
            const float rq = rstd * (1.0f / 255.0f);
            v0 = v0 * rq * gg[j].x * ub0(ov[j]); v1 = v1 * rq * gg[j].y * ub1(ov[j]); v2 = v2 * rq * gg[j].z * ub2(ov[j]); v3 = v3 * rq * gg[j].w * ub3(ov[j]);
            u32x2 o; o.x = pk2(v0, v1); o.y = pk2(v2, v3); hp[64 * j] = o; }
    }
}

__device__ __forceinline__ void phase_norm2(const P& p, int bid, int nb, int wv) {
    const int tid = opaque_tid(wv), lane = tid & 63, wave = tid >> 6;
    const float* X1 = (const float*)(p.ws + WS_X1); bf16_t* XN = (bf16_t*)(p.ws + WS_XN);
    for (int m = wave * nb + bid; m < MTOK; m += nb * 8) {
        const f32x4* xr = (const f32x4*)(X1 + (size_t)m * D) + lane; f32x4 v[4]; float s = 0.f;
#pragma unroll
        for (int j = 0; j < 4; ++j) { v[j] = xr[64 * j]; s += (v[j].x * v[j].x + v[j].y * v[j].y) + (v[j].z * v[j].z + v[j].w * v[j].w); }
        const float rstd = 1.0f / sqrtf(wave_sum(s) * (1.0f / D) + EPS);
        unsigned long long* o8 = (unsigned long long*)(XN + (size_t)m * D) + lane;
#pragma unroll
        for (int j = 0; j < 4; ++j) { v[j] = v[j] * rstd; o8[64 * j] = (unsigned long long)pk2(v[j].x, v[j].y) | ((unsigned long long)pk2(v[j].z, v[j].w) << 32); }
    }
}

__device__ __forceinline__ float gelu_tanh(float x) { const float u2 = -1.5957691216057308f * (x + 0.044715f * x * x * x); return x * __builtin_amdgcn_rcpf(1.0f + __expf(u2)); }
__device__ __forceinline__ void phase_convffn(const P& p, int bid, int nb, int wv) {
    const int gid = bid * NTHREADS + opaque_tid(wv), nruns = (nb * NTHREADS) / (DFF / 8);
    const int run = gid / (DFF / 8), c0 = (gid - run * (DFF / 8)) * 8;
    if (run >= nruns) return;
    const int rpr = (MTOK + nruns - 1) / nruns, r0 = run * rpr, r1 = (r0 + rpr < MTOK) ? r0 + rpr : MTOK;
    if (r0 >= r1) return;
    const bf16_t* __restrict__ UP = (const bf16_t*)(p.ws + WS_Z); bf16_t* __restrict__ HMID = (bf16_t*)(p.ws + WS_ACAT);
    const float* __restrict__ cw = p.in[I_FCW]; const float* __restrict__ cbv = p.in[I_FCB]; const float* __restrict__ sf = p.in[I_SF]; float* __restrict__ out = p.out;
    float wvt[3][8], wg[3][8], bv[8], bg[8];
#pragma unroll
    for (int q = 0; q < 8; ++q) { bv[q] = cbv[c0 + q]; bg[q] = cbv[DFF + c0 + q];
#pragma unroll
        for (int jx = 0; jx < 3; ++jx) { wvt[jx][q] = cw[(size_t)jx * NUP + c0 + q]; wg[jx][q] = cw[(size_t)jx * NUP + DFF + c0 + q]; } }
    int s, t, L, row0;
    if (r0 < MP) s = r0 / LP; else s = NBP + (r0 - MP) / DECS;
    seq_info(s, row0, L); t = r0 - row0;
    float x0v[8], x1v[8], x0g[8], x1g[8];
#pragma unroll
    for (int q = 0; q < 8; ++q) { x0v[q] = 0.f; x1v[q] = 0.f; x0g[q] = 0.f; x1g[q] = 0.f; }
    if (t >= 1) { unpack8(*(const u32x4*)(UP + (size_t)(r0 - 1) * NUP + c0), x1v); unpack8(*(const u32x4*)(UP + (size_t)(r0 - 1) * NUP + DFF + c0), x1g); }
    if (t >= 2) { unpack8(*(const u32x4*)(UP + (size_t)(r0 - 2) * NUP + c0), x0v); unpack8(*(const u32x4*)(UP + (size_t)(r0 - 2) * NUP + DFF + c0), x0g); }
    else if (t == 1 && s >= NBP) { const float* b1 = sf + ((size_t)(s - NBP) * 2 + 1) * NUP;
#pragma unroll
        for (int q = 0; q < 8; ++q) { x0v[q] = b1[c0 + q]; x0g[q] = b1[DFF + c0 + q]; } }
    u32x4 nv[4], ng[4];
#pragma unroll
    for (int i = 0; i < 4; ++i) { const int rr = (r0 + i < r1) ? r0 + i : r1 - 1; nv[i] = *(const u32x4*)(UP + (size_t)rr * NUP + c0); ng[i] = *(const u32x4*)(UP + (size_t)rr * NUP + DFF + c0); }
    for (int rb = r0; rb < r1; rb += 4) {
        u32x4 lv[4], lg[4];
#pragma unroll
        for (int i = 0; i < 4; ++i) { lv[i] = nv[i]; lg[i] = ng[i]; }
        if (rb + 4 < r1) {
#pragma unroll
            for (int i = 0; i < 4; ++i) { const int rr = (rb + 4 + i < r1) ? rb + 4 + i : r1 - 1; nv[i] = *(const u32x4*)(UP + (size_t)rr * NUP + c0); ng[i] = *(const u32x4*)(UP + (size_t)rr * NUP + DFF + c0); } }
#pragma unroll
        for (int i = 0; i < 4; ++i) { const int r = rb + i;
            if (r < r1) {
                if (t == 0) {
                    if (s >= NBP) { const float* b0 = sf + (size_t)(s - NBP) * 2 * NUP; const float* b1 = b0 + NUP;
#pragma unroll
                        for (int q = 0; q < 8; ++q) { x0v[q] = b0[c0 + q]; x0g[q] = b0[DFF + c0 + q]; x1v[q] = b1[c0 + q]; x1g[q] = b1[DFF + c0 + q]; } }
                    else {
#pragma unroll
                        for (int q = 0; q < 8; ++q) { x0v[q] = 0.f; x0g[q] = 0.f; x1v[q] = 0.f; x1g[q] = 0.f; } } }
                float x2v[8], x2g[8], o[8]; unpack8(lv[i], x2v); unpack8(lg[i], x2g);
#pragma unroll
                for (int q = 0; q < 8; ++q) { const float val = bv[q] + wvt[0][q] * x0v[q] + wvt[1][q] * x1v[q] + wvt[2][q] * x2v[q]; const float gt = bg[q] + wg[0][q] * x0g[q] + wg[1][q] * x1g[q] + wg[2][q] * x2g[q];
                    o[q] = gelu_tanh(gt) * val; }
                u32x4 w; w.x = pk2(o[0], o[1]); w.y = pk2(o[2], o[3]); w.z = pk2(o[4], o[5]); w.w = pk2(o[6], o[7]);
                *(u32x4*)(HMID + (size_t)r * DFF + c0) = w;
                if (t >= L - 2) {
                    float* of = (s < NBP ? out + O_PF + (size_t)s * 2 * NUP : out + O_SF + (size_t)(s - NBP) * 2 * NUP) + (size_t)(t - (L - 2)) * NUP;
                    *(f32x4*)(of + c0) = (f32x4){x2v[0], x2v[1], x2v[2], x2v[3]}; *(f32x4*)(of + c0 + 4) = (f32x4){x2v[4], x2v[5], x2v[6], x2v[7]};
                    *(f32x4*)(of + DFF + c0) = (f32x4){x2g[0], x2g[1], x2g[2], x2g[3]}; *(f32x4*)(of + DFF + c0 + 4) = (f32x4){x2g[4], x2g[5], x2g[6], x2g[7]}; }
#pragma unroll
                for (int q = 0; q < 8; ++q) { x0v[q] = x1v[q]; x1v[q] = x2v[q]; x0g[q] = x1g[q]; x1g[q] = x2g[q]; }
                if (++t == L) { ++s; t = 0; seq_info(s, row0, L); }
            } }
    }
}

__device__ __forceinline__ void phase_final(const P& p, LAS unsigned char* lds, int bid, int nb, int wv) {
    const int tid = opaque_tid(wv), lane = tid & 63, wave = tid >> 6;
    const bf16_t* X2B = (const bf16_t*)(p.ws + WS_X1); const bf16_t* X1B = (const bf16_t*)(p.ws + WS_XN); const float* gf = p.in[I_GF]; const float* PART = (const float*)(p.ws + WS_Z);
    LAS int* tailmap = (LAS int*)lds;
    constexpr int DS = 11;
    for (int i = tid; i < (MPAD / 256) * 4; i += NTHREADS) tailmap[i] = -1;
    __syncthreads();
    { pg8::SplitTailOrder S; S.init(MPAD, D, DFF, nb, 0); const int R = (nb == 256) ? S.nwg - nb : 0;
      if (tid < R) { pg8::Unit u; pg8::StaticOrder t = S; t.c = tid; if (t.next(1, u)) tailmap[u.pm * 4 + u.pn] = tid; } }
    __syncthreads();
    constexpr int FU = 3;
    for (int m0 = wave * nb + bid; m0 < MTOK; m0 += nb * 8 * FU) {
        float* o[FU]; bool ok[FU]; f32x4 v[FU][4]; int tix[FU][4];
#pragma unroll
        for (int u = 0; u < FU; ++u) { const int m = m0 + u * nb * 8; ok[u] = m < MTOK; o[u] = p.out;
            if (ok[u]) { if (m < MP) { const int b = m / LP, t = m - b * LP; if (t < NMETA) ok[u] = false; else o[u] = p.out + O_YP + ((size_t)b * SEQ + (t - NMETA)) * D; }
                         else o[u] = p.out + O_YS + (size_t)(m - MP) * D; }
#pragma unroll
            for (int j = 0; j < 4; ++j) { tix[u][j] = ok[u] ? tailmap[(m >> 8) * 4 + j] : -1;
                u32x2 xw = {0u, 0u}; if (ok[u]) xw = *((const u32x2*)((tix[u][j] >= 0 ? X1B : X2B) + (size_t)m * D) + lane + 64 * j);
                v[u][j] = (f32x4){bflo(xw.x), bfhi(xw.x), bflo(xw.y), bfhi(xw.y)}; } }
#pragma unroll
        for (int u = 0; u < FU; ++u) { const int m = m0 + u * nb * 8; float s = 0.f;
            if (!ok[u]) continue;
#pragma unroll
            for (int j = 0; j < 4; ++j) {
                const int ti = tix[u][j];
                if (ti >= 0) { const u32x2* pp = (const u32x2*)((const bf16_t*)PART + (size_t)(ti * DS) * 65536 + (size_t)(m & 255) * 256) + lane;
#pragma unroll
                    for (int sl = 0; sl < DS; ++sl) { const u32x2 pw = pp[(size_t)sl * 16384]; v[u][j] += (f32x4){bflo(pw.x), bfhi(pw.x), bflo(pw.y), bfhi(pw.y)}; } }
                s += (v[u][j].x * v[u][j].x + v[u][j].y * v[u][j].y) + (v[u][j].z * v[u][j].z + v[u][j].w * v[u][j].w); }
            const float rstd = 1.0f / sqrtf(wave_sum(s) * (1.0f / D) + EPS);
#pragma unroll
            for (int j = 0; j < 4; ++j) __builtin_nontemporal_store(v[u][j] * rstd * ((const f32x4*)gf)[lane + 64 * j], (f32x4*)o[u] + lane + 64 * j); }
    }
}

__device__ __forceinline__ void late_transposes(const P& p, LAS unsigned char* lds, int gw, int NGW, int wv) {
    const int lane = lane_id_volatile(); unsigned char* ws = p.ws;
    LAS float* scr = (LAS float*)(lds + wv * 8448);
    constexpr int I_SQ = 16 * 32, I_UP = 16 * 176, I_DN = 44 * 32, NITEMS = 3 * I_SQ + I_UP + I_DN;
    for (int it = gw; it < NITEMS; it += NGW) {
        int r = it;
        if (r < I_SQ) { tr_item(p.in[I_WA], 1024, (r / 32) * 64, (r % 32) * 32, (bf16_t*)(ws + WS_WCAT), 2048, (r % 32) * 32, 0, nullptr, 1.f, scr, lane); continue; } r -= I_SQ;
        if (r < I_SQ) { tr_item(p.in[I_WB], 1024, (r / 32) * 64, (r % 32) * 32, (bf16_t*)(ws + WS_WCAT), 2048, (r % 32) * 32, 1024, nullptr, 1.f, scr, lane); continue; } r -= I_SQ;
        if (r < I_SQ) { tr_item(p.in[I_WOUT], 1024, (r / 32) * 64, (r % 32) * 32, (bf16_t*)(ws + WS_WOUT), 1024, (r % 32) * 32, 0, nullptr, 1.f, scr, lane); continue; } r -= I_SQ;
        if (r < I_UP) { const int n0 = (r % 176) * 32, ns0 = ((n0 >> 7) & 1) * DFF + (n0 >> 8) * 128 + (n0 & 127);
            tr_item(p.in[I_WUP], NUP, (r / 176) * 64, ns0, (bf16_t*)(ws + WS_WUP), 1024, n0, 0, p.in[I_G2], 1.f, scr, lane); continue; } r -= I_UP;
        tr_item(p.in[I_WDOWN], 1024, (r / 32) * 64, (r % 32) * 32, (bf16_t*)(ws + WS_WDOWN), DFF, (r % 32) * 32, 0, nullptr, 1.f, scr, lane);
    }
}
__device__ __forceinline__ void phase_gemm1(const P& p, LAS unsigned char* lds, int bid, int nb, int wv) {
    pg8::Gemm g{(const bf16_t*)(p.ws + WS_XN), (const bf16_t*)(p.ws + WS_WIN), MPAD, NZ, D, 0}; pg8::StaticOrder S; S.init(MPAD, NZ, D, nb, bid);
    pg8::EpiBf16 E{(bf16_t*)(p.ws + WS_Z), NZ, (const float*)(p.ws + WS_SMALL), nullptr};
    pg8::gemm_phase<pg8::EpiBf16, pg8::StaticOrder, true, true>(lds, g, S, E, wv);
    { const int rem = S.nwg % nb, idle0 = (rem == 0) ? 0 : rem, nidle = nb - idle0;
      if (bid >= idle0) { late_transposes(p, lds, wv * nidle + (bid - idle0), nidle * 8, wv); } }
}
__device__ __forceinline__ void phase_gemm_merge(const P& p, LAS unsigned char* lds, int bid, int nb, int wv) {
    pg8::Gemm g{(const bf16_t*)(p.ws + WS_ACAT), (const bf16_t*)(p.ws + WS_WCAT), MPAD, D, 2048, 0}; pg8::SplitTailOrder S; S.init(MPAD, D, 2048, nb, bid); S.S = (nb == 256) ? 8 : 0;
    pg8::EpiMerge E{(bf16_t*)(p.ws + WS_MERGED), (const bf16_t*)(p.ws + WS_Z), (float*)(p.ws + WS_X1), (unsigned*)(p.ws + WS_CTL) + 1024, 8};
    pg8::gemm_phase<pg8::EpiMerge, pg8::SplitTailOrder, true, true>(lds, g, S, E, wv);
}
__device__ __forceinline__ void phase_gemm_out(const P& p, LAS unsigned char* lds, int bid, int nb, int wv) {
    pg8::Gemm g{(const bf16_t*)(p.ws + WS_MERGED), (const bf16_t*)(p.ws + WS_WOUT), MPAD, D, D, 0}; pg8::SplitTailOrder S; S.init(MPAD, D, D, nb, bid); S.S = (nb == 256) ? 4 : 0;
    pg8::EpiX1 E{p.in[I_META], p.in[I_XP], p.in[I_XS], nullptr, (bf16_t*)(p.ws + WS_XN), (float*)(p.ws + WS_SSQ), (float*)(p.ws + WS_Z), (unsigned*)(p.ws + WS_CTL) + 1088, 4};
    pg8::gemm_phase<pg8::EpiX1, pg8::SplitTailOrder, true, true>(lds, g, S, E, wv);
}
__device__ __forceinline__ void phase_gemm_up(const P& p, LAS unsigned char* lds, int bid, int nb, int wv) {
    pg8::Gemm g{(const bf16_t*)(p.ws + WS_XN), (const bf16_t*)(p.ws + WS_WUP), MPAD, NUP, D, 1}; pg8::StaticOrder S; S.init(MPAD, NUP, D, nb, bid);
    pg8::EpiUp E{(bf16_t*)(p.ws + WS_ACAT), (const float*)(p.ws + WS_SSQ), p.in[I_FCW], p.in[I_FCB], p.in[I_SF], p.out, (LAS float*)(lds + 131072)};
    pg8::gemm_phase<pg8::EpiUp, pg8::StaticOrder, true, true>(lds, g, S, E, wv);
}
__device__ __forceinline__ void phase_gemm_down(const P& p, LAS unsigned char* lds, int bid, int nb, int wv) {
    pg8::Gemm g{(const bf16_t*)(p.ws + WS_ACAT), (const bf16_t*)(p.ws + WS_WDOWN), MPAD, D, DFF, 0}; pg8::SplitTailOrder S; S.init(MPAD, D, DFF, nb, bid); S.S = (nb == 256) ? 11 : 0;
    pg8::EpiAcc E{(const bf16_t*)(p.ws + WS_XN), (bf16_t*)(p.ws + WS_X1), (float*)(p.ws + WS_Z)};
    pg8::gemm_phase<pg8::EpiAcc, pg8::SplitTailOrder, true, true>(lds, g, S, E, wv);
}


#define XB_TMO      128
#define XB_XCNT(j)  (256  + 64 * (j))
#define XB_XSUB(j)  (1280 + 64 * (j))
#define XB_XGEN(j)  (2304 + 64 * (j))
#define XB_TOP      3328
#define XB_TOPGEN   3392
#define XCD_BAR_WORDS 3456
#define XB_SPIN_CAP (1u << 22)
constexpr int CW_BAR = 4096;
__device__ __forceinline__ unsigned xb_ld(unsigned* p)              { return __hip_atomic_load(p, __ATOMIC_RELAXED, __HIP_MEMORY_SCOPE_AGENT); }
__device__ __forceinline__ unsigned xb_add(unsigned* p, unsigned v) { return __hip_atomic_fetch_add(p, v, __ATOMIC_RELAXED, __HIP_MEMORY_SCOPE_AGENT); }
__device__ __forceinline__ unsigned xb_xcc_id() { return (unsigned)__builtin_amdgcn_s_getreg((3 << 11) | 20) & 0xFu; }
#define XB_SPIN(cond, bar) do { unsigned _sp = 0; while (cond) { __builtin_amdgcn_s_sleep(1); \
    if ((++_sp & 255u) == 0u) { if (xb_ld(&(bar)[XB_TMO])) break; if (_sp > XB_SPIN_CAP) { atomicAdd(&(bar)[XB_TMO], 1u); break; } } } } while (0)
struct XcdBarrier { unsigned* bar; unsigned x; volatile LAS unsigned* st; };
__device__ __forceinline__ XcdBarrier xcd_barrier_post(unsigned* bar, volatile LAS unsigned* st) {
    XcdBarrier b; b.bar = bar; b.x = xb_xcc_id(); b.st = st;
    if (threadIdx.x == 0) (void)xb_add(&bar[XB_XCNT(b.x)], 1u);
    return b;
}
__device__ __forceinline__ void xcd_barrier_complete(unsigned* bar, unsigned x, unsigned& nloc, unsigned& nx) {
    const unsigned G = gridDim.x * gridDim.y * gridDim.z;
    unsigned sum, cnt, mine, sp = 0u;
    for (;;) {
        sum = 0u; cnt = 0u; mine = 0u;
#pragma unroll
        for (unsigned j = 0; j < 16; ++j) { const unsigned c = xb_ld(&bar[XB_XCNT(j)]); sum += c; cnt += (c > 0u) ? 1u : 0u; mine = (j == x) ? c : mine; }
        if (sum == G) break;
        __builtin_amdgcn_s_sleep(1);
        if ((++sp & 255u) == 0u) { if (xb_ld(&bar[XB_TMO])) break; if (sp > XB_SPIN_CAP) { atomicAdd(&bar[XB_TMO], 1u); break; } }
    }
    nloc = mine > 0u ? mine : 1u; nx = cnt > 0u ? cnt : 1u;
}
__device__ __forceinline__ void xcd_barrier(const XcdBarrier& b, int wv);
__device__ __forceinline__ void xcd_barrier_at(unsigned* bar, volatile LAS unsigned* st, int wv) { XcdBarrier b; b.bar = bar; b.x = xb_xcc_id(); b.st = st; xcd_barrier(b, wv); }
__device__ __forceinline__ void xcd_barrier(const XcdBarrier& b, int wv) {
    asm volatile("s_waitcnt vmcnt(0)" ::: "memory");
    __syncthreads();
    if (wv == 0 && lane_id_volatile() == 0) {
        unsigned* bar = b.bar;
        __builtin_amdgcn_s_waitcnt(0);
        unsigned nloc = b.st[0], nx = b.st[1];
        if (nloc == 0u) { xcd_barrier_complete(bar, b.x, nloc, nx); b.st[0] = nloc; b.st[1] = nx; }
        const unsigned old = xb_add(&bar[XB_XSUB(b.x)], 1u);
        const unsigned gen = old / nloc;
        if (old + 1u == (gen + 1u) * nloc) {
            __builtin_amdgcn_fence(__ATOMIC_RELEASE, "agent");
            asm volatile("s_waitcnt vmcnt(0)" ::: "memory");
            const unsigned og = xb_add(&bar[XB_TOP], 1u);
            const unsigned tg = og / nx;
            if (og + 1u == (tg + 1u) * nx) xb_add(&bar[XB_TOPGEN], 1u);
            else XB_SPIN(xb_ld(&bar[XB_TOPGEN]) == tg, bar);
            __builtin_amdgcn_fence(__ATOMIC_ACQUIRE, "agent");
            xb_add(&bar[XB_XGEN(b.x)], 1u);
            asm volatile("s_waitcnt vmcnt(0)" ::: "memory");
        } else {
            XB_SPIN(xb_ld(&bar[XB_XGEN(b.x)]) == gen, bar);
            __builtin_amdgcn_fence(__ATOMIC_ACQUIRE, "agent");
            asm volatile("s_waitcnt vmcnt(0)" ::: "memory");
        }
    }
    __syncthreads();
}

constexpr int NPHASES = 12;
template <int PH> __device__ __forceinline__ void run_phase(const P& p, LAS unsigned char* lds, int bid, int nb, int wv) {
    if constexpr (PH == 0) phase_prep(p, lds, bid, nb, wv);
    if constexpr (PH == 1) phase_gemm1(p, lds, bid, nb, wv);
    constexpr int LRU_SPLIT = NBP * NSEGP + DECB / 2;
    if constexpr (PH == 2) { if (bid >= (nb >> 1)) phase_lru(p, lds, bid - (nb >> 1), nb >> 1, wv, 0, LRU_SPLIT); __syncthreads(); }
    if constexpr (PH == 3) {
        if (bid < (nb >> 1)) { phase_mlstm(p, lds, bid, nb >> 1, wv); if (MK_DUP == 30) phase_mlstm(p, lds, bid, nb >> 1, wv); __syncthreads(); phase_lru(p, lds, bid, nb >> 1, wv, LRU_SPLIT, 1 << 30); __syncthreads(); }
        else { mlstm_sample(p, lds, bid - (nb >> 1), nb >> 1, wv); if (MK_DUP == 31) mlstm_sample(p, lds, bid - (nb >> 1), nb >> 1, wv); } }
    if constexpr (PH == 4) phase_headnorm(p, bid, nb, wv);
    if constexpr (PH == 5) phase_gemm_merge(p, lds, bid, nb, wv);
    if constexpr (PH == 6) phase_gemm_out(p, lds, bid, nb, wv);
    if constexpr (PH == 7) phase_norm2(p, bid, nb, wv);
    if constexpr (PH == 8) phase_gemm_up(p, lds, bid, nb, wv);
    if constexpr (PH == 9) phase_convffn(p, bid, nb, wv);
    if constexpr (PH == 10) phase_gemm_down(p, lds, bid, nb, wv);
    if constexpr (PH == 11) phase_final(p, lds, bid, nb, wv);
}
#if MK_ONE_LAUNCH
__global__ void __launch_bounds__(NTHREADS, 2) k_fwd(P p) {
    extern __shared__ __attribute__((aligned(16))) unsigned char lds_raw[];
    LAS unsigned char* lds = (LAS unsigned char*)lds_raw;
    cg::grid_group grid = cg::this_grid();
    const int bid = (int)blockIdx.x, nb = (int)gridDim.x;
    const int wv = __builtin_amdgcn_readfirstlane((int)(threadIdx.x >> 6));
#define RUNP(X) do { run_phase<X>(p, lds, bid, nb, wv); if (MK_DUP == X) { xcd_barrier_at((unsigned*)(p.ws + WS_CTL) + CW_BAR, (volatile LAS unsigned*)(lds + LDS_BYTES - 64), wv); run_phase<X>(p, lds, bid, nb, wv); } } while (0)
    volatile LAS unsigned* bst = (volatile LAS unsigned*)(lds + LDS_BYTES - 64);
    if (threadIdx.x < 16) bst[threadIdx.x] = 0u;
    (void)xcd_barrier_post((unsigned*)(p.ws + WS_CTL) + CW_BAR, bst);
    if (nb == 0x7fffffff) grid.sync();
    run_phase<0>(p, lds, bid, nb, wv); xcd_barrier_at((unsigned*)(p.ws + WS_CTL) + CW_BAR, (volatile LAS unsigned*)(lds + LDS_BYTES - 64), wv);
    RUNP(1); xcd_barrier_at((unsigned*)(p.ws + WS_CTL) + CW_BAR, (volatile LAS unsigned*)(lds + LDS_BYTES - 64), wv);
    RUNP(2);
    RUNP(3); xcd_barrier_at((unsigned*)(p.ws + WS_CTL) + CW_BAR, (volatile LAS unsigned*)(lds + LDS_BYTES - 64), wv);
    run_phase<4>(p, lds, bid, nb, wv); xcd_barrier_at((unsigned*)(p.ws + WS_CTL) + CW_BAR, (volatile LAS unsigned*)(lds + LDS_BYTES - 64), wv);
    RUNP(5); xcd_barrier_at((unsigned*)(p.ws + WS_CTL) + CW_BAR, (volatile LAS unsigned*)(lds + LDS_BYTES - 64), wv);
    RUNP(6); xcd_barrier_at((unsigned*)(p.ws + WS_CTL) + CW_BAR, (volatile LAS unsigned*)(lds + LDS_BYTES - 64), wv);
    RUNP(8); xcd_barrier_at((unsigned*)(p.ws + WS_CTL) + CW_BAR, (volatile LAS unsigned*)(lds + LDS_BYTES - 64), wv);
    run_phase<10>(p, lds, bid, nb, wv); xcd_barrier_at((unsigned*)(p.ws + WS_CTL) + CW_BAR, (volatile LAS unsigned*)(lds + LDS_BYTES - 64), wv);
    RUNP(11);
}
#endif

#if !MK_ONE_LAUNCH
template <int PH> __global__ void __launch_bounds__(NTHREADS, 2) k_phase(P p) {
    extern __shared__ __attribute__((aligned(16))) unsigned char lds_raw[];
    run_phase<PH>(p, (LAS unsigned char*)lds_raw, (int)blockIdx.x, (int)gridDim.x, __builtin_amdgcn_readfirstlane((int)(threadIdx.x >> 6)));
}
template <int PH> static void launch_phase(const P& p, int grid, hipStream_t stream) {
    static bool attr = false;
    if (!attr) { (void)hipFuncSetAttribute((const void*)k_phase<PH>, hipFuncAttributeMaxDynamicSharedMemorySize, LDS_BYTES); attr = true; }
    hipLaunchKernelGGL(k_phase<PH>, dim3(grid), dim3(NTHREADS), LDS_BYTES, stream, p);
}
#endif

extern "C" void kernel_launch(void* const* d_in, const int* in_sizes, int n_in, void* d_out, int out_size, void* d_ws, size_t ws_size, hipStream_t stream) {
    if (n_in != 29 || (size_t)out_size != O_END || ws_size < WS_END) { fprintf(stderr, "kernel_launch: unexpected shapes (n_in %d, out %d, ws %zu)\n", n_in, out_size, ws_size); return; }
    P p{};
    for (int i = 0; i < 29; ++i) p.in[i] = (const float*)d_in[i];
    p.out = (float*)d_out; p.ws = (unsigned char*)d_ws;
#if MK_ONE_LAUNCH
    static int grid = 0;
    if (grid == 0) {
        int dev = 0, cus = 0, per_cu = 0;
        (void)hipGetDevice(&dev); (void)hipDeviceGetAttribute(&cus, hipDeviceAttributeMultiprocessorCount, dev);
        (void)hipFuncSetAttribute((const void*)k_fwd, hipFuncAttributeMaxDynamicSharedMemorySize, LDS_BYTES);
        if (hipOccupancyMaxActiveBlocksPerMultiprocessor(&per_cu, (const void*)k_fwd, NTHREADS, LDS_BYTES) != hipSuccess || per_cu < 1) { fprintf(stderr, "kernel_launch: occupancy query failed (%d)\n", per_cu); per_cu = 1; }
        grid = cus * 1;
        if (grid <= 0) grid = 256;
    }
    if (hipMemsetAsync(d_ws, 0, 32768, stream) != hipSuccess) { fprintf(stderr, "kernel_launch: memset of control words failed\n"); return; }
    void* args[] = {(void*)&p};
    hipError_t e = hipLaunchCooperativeKernel((const void*)k_fwd, dim3(grid), dim3(NTHREADS), args, LDS_BYTES, stream);
    if (e != hipSuccess) fprintf(stderr, "cooperative launch failed: %s (grid %d)\n", hipGetErrorString(e), grid);
#else
    const int grid = 256;
    launch_phase<0>(p, grid, stream); launch_phase<1>(p, grid, stream); launch_phase<2>(p, grid, stream); launch_phase<3>(p, grid, stream);
    launch_phase<4>(p, grid, stream); launch_phase<5>(p, grid, stream); launch_phase<6>(p, grid, stream); launch_phase<7>(p, grid, stream);
    launch_phase<8>(p, grid, stream); launch_phase<9>(p, grid, stream); launch_phase<10>(p, grid, stream); launch_phase<11>(p, grid, stream);
#endif
}
```

```cpp
#include <hip/hip_runtime.h>
#include <hip/hip_cooperative_groups.h>
#include <cstdio>
#include <cstdint>
namespace cg = cooperative_groups;

#ifndef MK_ONE_LAUNCH
#define MK_ONE_LAUNCH 1
#endif

#ifndef MK_KROT
#define MK_KROT 0
#endif
#ifndef MK_DUP
#define MK_DUP -1
#endif
#define LAS __attribute__((address_space(3)))
typedef unsigned short bf16_t;
typedef short bf16x8 __attribute__((ext_vector_type(8)));
typedef float f32x4 __attribute__((ext_vector_type(4)));
typedef float f32x2 __attribute__((ext_vector_type(2)));
typedef unsigned u32x4 __attribute__((ext_vector_type(4)));
typedef unsigned u32x2 __attribute__((ext_vector_type(2)));

constexpr int D = 1024, NBP = 8, SEQ = 2048, NMETA = 16, LP = SEQ + NMETA, DECB = 128, DECS = 8;
constexpr int MP = NBP * LP, MS = DECB * DECS, MTOK = MP + MS, MPAD = 17664;
constexpr int NSEQ = NBP + DECB;
constexpr int NIN = 7176, NZ = 7168;
constexpr int ZC_U = 0, ZC_Q = 1024, ZC_K = 2048, ZC_V = 3072, ZC_O = 4096, ZC_GA = 5120, ZC_GB = 6144;
constexpr int DFF = 2816, NUP = 5632, NH = 4, DH = 256;
constexpr float EPS = 1e-6f;
constexpr size_t O_YP = 0;
constexpr size_t O_YS = O_YP + (size_t)NBP * SEQ * D;
constexpr size_t O_PLC = O_YS + (size_t)DECB * DECS * D;
constexpr size_t O_PLH = O_PLC + (size_t)NBP * 3 * D;
constexpr size_t O_PC = O_PLH + (size_t)NBP * D;
constexpr size_t O_PN = O_PC + (size_t)NBP * NH * DH * DH;
constexpr size_t O_PM = O_PN + (size_t)NBP * NH * DH;
constexpr size_t O_PF = O_PM + (size_t)NBP * NH;
constexpr size_t O_SLC = O_PF + (size_t)NBP * 2 * NUP;
constexpr size_t O_SLH = O_SLC + (size_t)DECB * 3 * D;
constexpr size_t O_SC = O_SLH + (size_t)DECB * D;
constexpr size_t O_SN = O_SC + (size_t)DECB * NH * DH * DH;
constexpr size_t O_SM = O_SN + (size_t)DECB * NH * DH;
constexpr size_t O_SF = O_SM + (size_t)DECB * NH;
constexpr size_t O_END = O_SF + (size_t)DECB * 2 * NUP;
constexpr size_t MiB = 1u << 20;
constexpr size_t WS_CTL = 0, WS_WIN = 1 * MiB, WS_WCAT = 15 * MiB, WS_WOUT = 19 * MiB, WS_WUP = 21 * MiB, WS_WDOWN = 32 * MiB;
constexpr size_t WS_SMALL = 38 * MiB;
constexpr size_t WS_XN = 40 * MiB;
constexpr size_t WS_Z = 75 * MiB;
constexpr size_t WS_ACAT = 317 * MiB;
constexpr size_t WS_MERGED = 386 * MiB;
constexpr size_t WS_X1 = 421 * MiB;
constexpr size_t WS_END = 490 * MiB;
constexpr int LSEG = 64, NSEGP = 33;
constexpr size_t WS_WLRU = 39 * MiB;
constexpr size_t WS_SSQ = 39 * MiB + 512 * 1024;
constexpr size_t WS_PCUM = WS_MERGED;
constexpr size_t WS_AGG = WS_X1;
constexpr size_t WS_CARRY = WS_X1 + 4 * MiB;

struct P {
    const float* in[29];
    float* out;
    unsigned char* ws;
};
enum { I_XP = 0, I_XS, I_SLC, I_SLH, I_SC, I_SN, I_SM, I_SF, I_META, I_G1, I_WIN, I_BIN, I_LCW, I_LCB, I_LWR, I_LBR, I_LWI, I_LBI, I_LAM, I_HG, I_WA, I_WB, I_WOUT, I_G2, I_WUP, I_FCW, I_FCB, I_WDOWN, I_GF };

__device__ __forceinline__ unsigned pk2(float lo, float hi) { unsigned r; asm("v_cvt_pk_bf16_f32 %0, %1, %2" : "=v"(r) : "v"(lo), "v"(hi)); return r; }
__device__ __forceinline__ unsigned f2bf(float f) { return pk2(f, 0.f) & 0xffffu; }
__device__ __forceinline__ float bf2f(unsigned short b) { return __builtin_bit_cast(float, ((unsigned)b) << 16); }
__device__ __forceinline__ float bflo(unsigned w) { return __builtin_bit_cast(float, w << 16); }
__device__ __forceinline__ float bfhi(unsigned w) { return __builtin_bit_cast(float, w & 0xffff0000u); }
__device__ __forceinline__ void unpack8(const u32x4 w, float (&o)[8]) { o[0] = bflo(w.x); o[1] = bfhi(w.x); o[2] = bflo(w.y); o[3] = bfhi(w.y); o[4] = bflo(w.z); o[5] = bfhi(w.z); o[6] = bflo(w.w); o[7] = bfhi(w.w); }
__device__ __forceinline__ float wave_sum(float v) {
#pragma unroll
    for (int o = 1; o < 64; o <<= 1) v += __shfl_xor(v, o);
    return v;
}
__device__ __forceinline__ int lane_id_volatile() { int l; asm volatile("v_mbcnt_lo_u32_b32 %0, -1, 0\n\tv_mbcnt_hi_u32_b32 %0, -1, %0" : "=v"(l)); return l; }
__device__ __forceinline__ int opaque_tid(int wv) { return wv * 64 + lane_id_volatile(); }
__device__ __forceinline__ float sigmoidf_(float x) { return __builtin_amdgcn_rcpf(1.0f + __expf(-x)); }
constexpr int ZG_OFF = 8192, ZG_PITCH = 14336;
__device__ __forceinline__ float ub0(unsigned w) { return (float)(w & 0xffu); }
__device__ __forceinline__ float ub1(unsigned w) { return (float)((w >> 8) & 0xffu); }
__device__ __forceinline__ float ub2(unsigned w) { return (float)((w >> 16) & 0xffu); }
__device__ __forceinline__ float ub3(unsigned w) { return (float)(w >> 24); }
__device__ __forceinline__ unsigned q8(float s, unsigned lo) { const unsigned q = (unsigned)(s * 255.0f + 0.5f); return q < lo ? lo : q; }
__device__ __forceinline__ float logsigmoidf_(float x) { return fminf(x, 0.f) - log1pf(__expf(-fabsf(x))); }
__device__ __forceinline__ void seq_info(int s, int& row0, int& L) { if (s < NBP) { row0 = s * LP; L = LP; } else { row0 = MP + (s - NBP) * DECS; L = DECS; } }
__device__ __forceinline__ const float* xrow3(const float* meta, const float* xp, const float* xs, int r) {
    if (r < MP) { const int b = r / LP, t = r - b * LP; return t < NMETA ? meta + (size_t)t * D : xp + ((size_t)b * SEQ + (t - NMETA)) * D; }
    return xs + (size_t)(r - MP) * D;
}
__device__ __forceinline__ const float* xrow_ptr(const P& p, int r) {
    if (r < MP) { const int b = r / LP, t = r - b * LP; return t < NMETA ? p.in[I_META] + (size_t)t * D : p.in[I_XP] + ((size_t)b * SEQ + (t - NMETA)) * D; }
    return p.in[I_XS] + (size_t)(r - MP) * D;
}

namespace pg8 {
constexpr int BM = 256, BK = 64, HALF = 128, HTB = HALF * BK * 2, STAGE_BYTES = 8 * HTB, NXCD = 8, WGM = 8;
__host__ __device__ __forceinline__ int lds_byte(int r, int c) { const int st = (r >> 4) * 2 + (c >> 5), rr = r & 15, cc = c & 31, ob = rr * 64 + cc * 2; return st * 1024 + (ob ^ (((ob >> 9) & 1) << 5)); }
__host__ __device__ __forceinline__ void stage_rc(int b, int& R, int& C) { const int st = b / 1024, sb = b % 1024, swz = sb ^ (((sb >> 9) & 1) << 5); R = (st >> 1) * 16 + swz / 64; C = (st & 1) * 32 + (swz % 64) / 2; }
__host__ __device__ __forceinline__ int perm32(int rho) { const int n = rho >> 4, i = rho & 15; return 8 * (i >> 2) + 4 * n + (i & 3); }
__host__ __device__ __forceinline__ int up_row0(int pm) { return pm < 65 ? 254 * pm : MP + 256 * (pm - 65); }
struct Unit { int pm, pn, kt0, nt, kind, slot; };
struct Gemm { const bf16_t* A; const bf16_t* Bt; int M, N, K; int a_mode; };
struct StaticOrder {
    int nM, nN, nwg, G, c, ntk;
    __host__ __device__ void init(int M, int N, int K, int G_, int c_) { nM = M / BM; nN = N / BM; nwg = nM * nN; G = G_; c = c_; ntk = K / BK; }
    __host__ __device__ bool next(int i, Unit& u) const {
        const long L = (long)i * G + c; if (L >= nwg) return false;
        int wgid = (int)L; { const int q = nwg / NXCD, r = nwg % NXCD, xcd = wgid % NXCD, off = wgid / NXCD; wgid = (xcd < r ? xcd * (q + 1) : r * (q + 1) + (xcd - r) * q) + off; }
        const int nig = WGM * nN, gid = wgid / nig, fm = gid * WGM, gsz = (nM - fm) < WGM ? (nM - fm) : WGM;
        u.pm = fm + ((wgid % nig) % gsz); u.pn = (wgid % nig) / gsz; u.kt0 = 0; u.nt = ntk; u.kind = 0; u.slot = 0; return true;
    }
    __device__ __forceinline__ void a_ready(const Unit&) const {}
    __device__ __forceinline__ void done(const Unit&) const {}
};
struct SplitTailOrder : StaticOrder {
    int S;
    __host__ __device__ bool next(int i, Unit& u) const {
        if (S <= 0 || i == 0) return StaticOrder::next(i, u);
        if (i > 1) return false;
        const int R = nwg - G; if (R <= 0 || c >= R * S) return false;
        StaticOrder t = *this; t.c = c / S; if (!t.StaticOrder::next(1, u)) return false;
        const int sl = c % S, per = ntk / S; u.kt0 = sl * per; u.nt = per; u.kind = 1; u.slot = c; return true;
    }
};
__device__ __forceinline__ unsigned cvt_pk_bf16(float lo, float hi) { unsigned r; asm volatile("v_cvt_pk_bf16_f32 %0, %1, %2" : "=v"(r) : "v"(lo), "v"(hi)); return r; }

struct EpiBf16 {
    static constexpr bool PERM = true, APERM = false, AFTER_DRAIN = false, HAS_MID = false, TAIL_REDUCE = false;
    bf16_t* O; int ldc; const float* bias; const float* ssq;
    __device__ __forceinline__ void mid(f32x4 (&acc)[2][2][4][2], const Unit& u, int wr, int wc, int fr, int fq) const {}
    __device__ __forceinline__ void operator()(const f32x4 (&acc)[2][2][4][2], const Unit& u, int wr, int wc, int fr, int fq) const {
        const int row0 = u.pm * BM + wr * 64 + fr; const int col0 = u.pn * BM + wc * 32 + 8 * fq;
        f32x4 bv[2][2];
#pragma unroll
        for (int bj = 0; bj < 2; ++bj)
#pragma unroll
            for (int n = 0; n < 2; ++n) bv[bj][n] = bias ? *(const f32x4*)(bias + col0 + bj * HALF + 4 * n) : (f32x4){0.f, 0.f, 0.f, 0.f};
        if (u.pn >= 16) {
            const unsigned lo = (u.pn >= 24) ? 1u : 0u; unsigned char* zb = (unsigned char*)O + ZG_OFF + (col0 - 4096);
#pragma unroll
            for (int ai = 0; ai < 2; ++ai)
#pragma unroll
                for (int m = 0; m < 4; ++m) { unsigned char* rowp = zb + (size_t)(row0 + ai * HALF + m * 16) * ZG_PITCH;
#pragma unroll
                    for (int bj = 0; bj < 2; ++bj) { u32x2 w;
#pragma unroll
                        for (int n = 0; n < 2; ++n) {
                            const f32x4 t = (acc[ai][bj][m][n] + bv[bj][n]) * (-1.4426950408889634f);
                            const f32x4 d = (f32x4){__builtin_amdgcn_exp2f(t[0]), __builtin_amdgcn_exp2f(t[1]), __builtin_amdgcn_exp2f(t[2]), __builtin_amdgcn_exp2f(t[3])} + 1.0f;
                            const f32x4 sq = (f32x4){__builtin_amdgcn_rcpf(d[0]), __builtin_amdgcn_rcpf(d[1]), __builtin_amdgcn_rcpf(d[2]), __builtin_amdgcn_rcpf(d[3])} * 255.0f + 0.5f;
                            unsigned q0 = (unsigned)sq[0], q1 = (unsigned)sq[1], q2 = (unsigned)sq[2], q3 = (unsigned)sq[3];
                            if (lo) { q0 = q0 < 1u ? 1u : q0; q1 = q1 < 1u ? 1u : q1; q2 = q2 < 1u ? 1u : q2; q3 = q3 < 1u ? 1u : q3; }
                            const unsigned pw = q0 | (q1 << 8) | (q2 << 16) | (q3 << 24); if (n == 0) w.x = pw; else w.y = pw; }
                        *(u32x2*)(rowp + bj * HALF) = w; } }
            return; }
#pragma unroll
        for (int ai = 0; ai < 2; ++ai)
#pragma unroll
            for (int m = 0; m < 4; ++m) { bf16_t* rowp = O + (size_t)(row0 + ai * HALF + m * 16) * ldc + col0;
                const float rs = ssq ? 1.0f / sqrtf(ssq[row0 + ai * HALF + m * 16] * (1.0f / D) + EPS) : 1.0f;
#pragma unroll
                for (int bj = 0; bj < 2; ++bj) { const f32x4 v0 = acc[ai][bj][m][0] * rs + bv[bj][0], v1 = acc[ai][bj][m][1] * rs + bv[bj][1];
                    u32x4 w; w.x = cvt_pk_bf16(v0[0], v0[1]); w.y = cvt_pk_bf16(v0[2], v0[3]); w.z = cvt_pk_bf16(v1[0], v1[1]); w.w = cvt_pk_bf16(v1[2], v1[3]);
                    __builtin_nontemporal_store(w, (u32x4*)(rowp + bj * HALF)); } }
    }
};
template <int CTRL> __device__ __forceinline__ float dppmovz(float src) { return __builtin_bit_cast(float, __builtin_amdgcn_update_dpp(0, __builtin_bit_cast(int, src), CTRL, 0xf, 0xf, true)); }
__device__ __forceinline__ float gelu_tanh_e(float x) { const float u2 = -1.5957691216057308f * (x + 0.044715f * x * x * x); return x * __builtin_amdgcn_rcpf(1.0f + __expf(u2)); }
struct EpiUp {
    static constexpr bool PERM = true, APERM = true, AFTER_DRAIN = false, HAS_MID = false, TAIL_REDUCE = false;
    bf16_t* HM; const float* ssq; const float* cw; const float* cb; const float* sf; float* out; LAS float* EX;
    __device__ __forceinline__ void mid(f32x4 (&acc)[2][2][4][2], const Unit& u, int wr, int wc, int fr, int fq) const {}
    __device__ __forceinline__ void operator()(f32x4 (&acc)[2][2][4][2], const Unit& u, int wr, int wc, int fr_, int fq_) const {
        int fr = fr_, fq = fq_; asm volatile("" : "+v"(fr), "+v"(fq));
        const int rbase = up_row0(u.pm) + wr * 64 + 4 * fr;
        const bool sample = u.pm >= 65;
#pragma unroll
        for (int ai = 0; ai < 2; ++ai) { const f32x4 sq = *(const f32x4*)(ssq + rbase + ai * HALF);
#pragma unroll
            for (int m = 0; m < 4; ++m) { const float rs = __builtin_amdgcn_rsqf(sq[m] * (1.0f / D) + EPS);
#pragma unroll
                for (int bj = 0; bj < 2; ++bj)
#pragma unroll
                    for (int n = 0; n < 2; ++n) acc[ai][bj][m][n] = acc[ai][bj][m][n] * rs; } }
        const int cl = wc * 32 + 8 * fq;
        if (fr == 15) {
#pragma unroll
            for (int ai = 0; ai < 2; ++ai)
#pragma unroll
                for (int bj = 0; bj < 2; ++bj)
#pragma unroll
                    for (int n = 0; n < 2; ++n) { *(LAS f32x4*)(EX + ((ai * 2 + wr) * 2 + 0) * 256 + bj * 128 + cl + 4 * n) = acc[ai][bj][2][n]; *(LAS f32x4*)(EX + ((ai * 2 + wr) * 2 + 1) * 256 + bj * 128 + cl + 4 * n) = acc[ai][bj][3][n]; } }
        asm volatile("s_waitcnt lgkmcnt(0)" ::: "memory"); __builtin_amdgcn_s_barrier(); asm volatile("" ::: "memory");
        const float mk0 = (fr == 0) ? 1.f : 0.f;
        const int hal = (u.pm >= 1 && u.pm < 65) ? 2 : 0;
        const int ch0 = u.pn * 128 + cl;
#pragma unroll
        for (int n = 0; n < 2; ++n) {
            const int ch = ch0 + 4 * n;
            const f32x4 wv0 = *(const f32x4*)(cw + ch), wv1 = *(const f32x4*)(cw + NUP + ch), wv2 = *(const f32x4*)(cw + 2 * NUP + ch), bv = *(const f32x4*)(cb + ch);
            const f32x4 wg0 = *(const f32x4*)(cw + DFF + ch), wg1 = *(const f32x4*)(cw + NUP + DFF + ch), wg2 = *(const f32x4*)(cw + 2 * NUP + DFF + ch), bg = *(const f32x4*)(cb + DFF + ch);
#pragma unroll
            for (int ai = 0; ai < 2; ++ai) {
                const int r0 = rbase + ai * HALF;
                const int t0 = sample ? ((r0 - MP) & 7) : (r0 - (r0 / LP) * LP);
                f32x4 p1v, p2v, p1g, p2g;
#pragma unroll
                for (int j = 0; j < 4; ++j) { p1v[j] = dppmovz<0x111>(acc[ai][0][3][n][j]); p2v[j] = dppmovz<0x111>(acc[ai][0][2][n][j]); p1g[j] = dppmovz<0x111>(acc[ai][1][3][n][j]); p2g[j] = dppmovz<0x111>(acc[ai][1][2][n][j]); }
                if (ai + wr > 0) { const int pb = (wr == 1) ? (ai * 2) : 1;
                    p2v += *(const LAS f32x4*)(EX + (pb * 2 + 0) * 256 + cl + 4 * n) * mk0; p1v += *(const LAS f32x4*)(EX + (pb * 2 + 1) * 256 + cl + 4 * n) * mk0;
                    p2g += *(const LAS f32x4*)(EX + (pb * 2 + 0) * 256 + 128 + cl + 4 * n) * mk0; p1g += *(const LAS f32x4*)(EX + (pb * 2 + 1) * 256 + 128 + cl + 4 * n) * mk0; }
                if (sample) {
                    if ((fr & 1) == 0) { const float* b0 = sf + (size_t)((r0 - MP) >> 3) * 2 * NUP; p2v = *(const f32x4*)(b0 + ch); p2g = *(const f32x4*)(b0 + DFF + ch); p1v = *(const f32x4*)(b0 + NUP + ch); p1g = *(const f32x4*)(b0 + NUP + DFF + ch); } }
                if (!sample && __builtin_amdgcn_ballot_w64(t0 == 0) != 0ull) { const float keep = (t0 == 0) ? 0.f : 1.f; p1v = p1v * keep; p2v = p2v * keep; p1g = p1g * keep; p2g = p2g * keep; }
                const bool zmid = !sample && __builtin_amdgcn_ballot_w64(t0 == LP - 2) != 0ull; const float z2 = (!sample && t0 == LP - 2) ? 1.f : 0.f;
#pragma unroll
                for (int m = 0; m < 4; ++m) {
                    const f32x4 xv = acc[ai][0][m][n], xg = acc[ai][1][m][n];
                    const f32x4 av = (m == 0) ? p1v : acc[ai][0][m > 0 ? m - 1 : 0][n], ag = (m == 0) ? p1g : acc[ai][1][m > 0 ? m - 1 : 0][n];
                    const f32x4 bv2 = (m == 0) ? p2v : (m == 1) ? p1v : acc[ai][0][m > 1 ? m - 2 : 0][n], bg2 = (m == 0) ? p2g : (m == 1) ? p1g : acc[ai][1][m > 1 ? m - 2 : 0][n];
                    f32x4 cv = bv + wv2 * xv + wv1 * av + wv0 * bv2, cg = bg + wg2 * xg + wg1 * ag + wg0 * bg2;
                    if (zmid && m == 2) { cv -= z2 * (wv1 * av + wv0 * bv2); cg -= z2 * (wg1 * ag + wg0 * bg2); }
                    if (zmid && m == 3) { cv -= z2 * (wv0 * bv2); cg -= z2 * (wg0 * bg2); }
                    if ((ai == 1 || m >= 2) ? true : (wr * 64 + 4 * fr + m >= hal)) {
                        constexpr float GC = -1.5957691216057308f * 1.4426950408889634f; const f32x4 ug = cg * ((cg * cg) * (0.044715f * GC) + GC);
                        const f32x4 dg = (f32x4){__builtin_amdgcn_exp2f(ug[0]), __builtin_amdgcn_exp2f(ug[1]), __builtin_amdgcn_exp2f(ug[2]), __builtin_amdgcn_exp2f(ug[3])} + 1.0f;
                        const f32x4 og = (cg * cv) * (f32x4){__builtin_amdgcn_rcpf(dg[0]), __builtin_amdgcn_rcpf(dg[1]), __builtin_amdgcn_rcpf(dg[2]), __builtin_amdgcn_rcpf(dg[3])};
                        u32x2 w; w.x = cvt_pk_bf16(og[0], og[1]); w.y = cvt_pk_bf16(og[2], og[3]);
                        *(u32x2*)((char*)HM + (((unsigned)(r0 + m) * (unsigned)DFF + (unsigned)ch) * 2u)) = w; }
                    __builtin_amdgcn_sched_barrier(0); }
            }
        }
#pragma unroll
        for (int ai = 0; ai < 2; ++ai) {
            int r0s = rbase + ai * HALF; asm volatile("" : "+v"(r0s));
            const int t0 = sample ? ((r0s - MP) & 7) : (r0s - (r0s / LP) * LP), Lq = sample ? DECS : LP;
            if (__builtin_amdgcn_ballot_w64(t0 + 3 >= Lq - 2) != 0ull) {
                float* ob = sample ? out + O_SF + (size_t)((r0s - MP) >> 3) * 2 * NUP : out + O_PF + (size_t)(r0s / LP) * 2 * NUP;
#pragma unroll
                for (int m = 0; m < 4; ++m) { const int t = t0 + m, i = ai * HALF + wr * 64 + 4 * fr + m;
                    if (t >= Lq - 2 && t < Lq && i >= hal) { float* of = ob + (size_t)(t - (Lq - 2)) * NUP + ch0;
                        *(f32x4*)(of) = acc[ai][0][m][0]; *(f32x4*)(of + 4) = acc[ai][0][m][1]; *(f32x4*)(of + DFF) = acc[ai][1][m][0]; *(f32x4*)(of + DFF + 4) = acc[ai][1][m][1]; } } }
        }
    }
};
struct EpiMerge {
    static constexpr bool PERM = true, APERM = false, AFTER_DRAIN = false, HAS_MID = true, TAIL_REDUCE = true;
    bf16_t* O; const bf16_t* Z; float* PART; unsigned* tcnt; int S;
    __device__ __forceinline__ void mid(f32x4 (&acc)[2][2][4][2], const Unit& u, int wr, int wc, int fr, int fq) const {
        int row0 = u.pm * BM + wr * 64 + fr; const int col0 = u.pn * BM + wc * 32 + 8 * fq;
        asm volatile("" : "+v"(row0));
#pragma unroll
        for (int ai = 0; ai < 2; ++ai)
#pragma unroll
            for (int m = 0; m < 4; ++m) { const unsigned char* zr = (const unsigned char*)Z + (size_t)(row0 + ai * HALF + m * 16) * ZG_PITCH + ZG_OFF + col0;
#pragma unroll
                for (int bj = 0; bj < 2; ++bj) {
                    const u32x2 qa = *(const u32x2*)(zr + 1024 + bj * HALF), qb = *(const u32x2*)(zr + 2048 + bj * HALF);
                    const unsigned qaw[2] = {qa.x, qa.y}, qbw[2] = {qb.x, qb.y};
#pragma unroll
                    for (int n = 0; n < 2; ++n) { const unsigned wa = qaw[n], wb = qbw[n];
                        acc[ai][bj][m][n][0] *= ub0(wa) * __builtin_amdgcn_rcpf(ub0(wb)); acc[ai][bj][m][n][1] *= ub1(wa) * __builtin_amdgcn_rcpf(ub1(wb));
                        acc[ai][bj][m][n][2] *= ub2(wa) * __builtin_amdgcn_rcpf(ub2(wb)); acc[ai][bj][m][n][3] *= ub3(wa) * __builtin_amdgcn_rcpf(ub3(wb)); } }
                asm volatile("" ::: "memory"); }
    }
    __device__ __forceinline__ void operator()(const f32x4 (&acc)[2][2][4][2], const Unit& u, int wr, int wc, int fr, int fq) const {
        const int row0 = u.pm * BM + wr * 64 + fr; const int col0 = u.pn * BM + wc * 32 + 8 * fq;
#pragma unroll
        for (int ai = 0; ai < 2; ++ai)
#pragma unroll
            for (int m = 0; m < 4; ++m) { const size_t r = (size_t)(row0 + ai * HALF + m * 16);
#pragma unroll
                for (int bj = 0; bj < 2; ++bj) {
                    const u32x2 qb = *(const u32x2*)((const unsigned char*)Z + r * ZG_PITCH + ZG_OFF + 2048 + col0 + bj * HALF); const unsigned qbw[2] = {qb.x, qb.y};
                    float v[8];
#pragma unroll
                    for (int n = 0; n < 2; ++n) { const unsigned wb = qbw[n]; const f32x4 a = acc[ai][bj][m][n] * (1.0f / 255.0f);
                        v[4 * n + 0] = a[0] * ub0(wb); v[4 * n + 1] = a[1] * ub1(wb); v[4 * n + 2] = a[2] * ub2(wb); v[4 * n + 3] = a[3] * ub3(wb); }
                    u32x4 w; w.x = cvt_pk_bf16(v[0], v[1]); w.y = cvt_pk_bf16(v[2], v[3]); w.z = cvt_pk_bf16(v[4], v[5]); w.w = cvt_pk_bf16(v[6], v[7]);
                    *(u32x4*)(O + r * D + col0 + bj * HALF) = w; }
                asm volatile("" ::: "memory"); }
    }
    __device__ __forceinline__ void strip(const f32x4 (&sA)[4][2], const f32x4 (&sB)[4][2], const Unit& u, int wr, int wc, int fr, int fq, int a, int b, int m0, int nm) const {
        const int row0 = u.pm * BM + a * HALF + wr * 64 + fr, col0 = u.pn * BM + b * HALF + wc * 32 + 8 * fq;
#pragma unroll
        for (int mi = 0; mi < 4; ++mi) if (mi < nm) { const size_t r = (size_t)(row0 + (m0 + mi) * 16);
            const unsigned char* zr = (const unsigned char*)Z + r * ZG_PITCH + ZG_OFF + col0; const u32x2 qa = *(const u32x2*)(zr + 1024), qb = *(const u32x2*)(zr + 2048); const unsigned qaw[2] = {qa.x, qa.y}, qbw[2] = {qb.x, qb.y};
            float v[8];
#pragma unroll
            for (int n = 0; n < 2; ++n) { const unsigned wa = qaw[n], wb = qbw[n]; const f32x4 xa = sA[mi][n] * (1.0f / 255.0f), xb = sB[mi][n] * (1.0f / 255.0f);
                v[4 * n + 0] = ub0(wa) * xa[0] + ub0(wb) * xb[0]; v[4 * n + 1] = ub1(wa) * xa[1] + ub1(wb) * xb[1]; v[4 * n + 2] = ub2(wa) * xa[2] + ub2(wb) * xb[2]; v[4 * n + 3] = ub3(wa) * xa[3] + ub3(wb) * xb[3]; }
            u32x4 w; w.x = cvt_pk_bf16(v[0], v[1]); w.y = cvt_pk_bf16(v[2], v[3]); w.z = cvt_pk_bf16(v[4], v[5]); w.w = cvt_pk_bf16(v[6], v[7]);
            *(u32x4*)(O + r * D + col0) = w; }
    }
};
struct EpiX1 {
    static constexpr bool PERM = true, APERM = false, AFTER_DRAIN = false, HAS_MID = false, TAIL_REDUCE = true;
    const float *meta, *xp, *xs; float* X1; bf16_t* XN; float* ssq; float* PART; unsigned* tcnt; int S;
    __device__ __forceinline__ void mid(f32x4 (&acc)[2][2][4][2], const Unit& u, int wr, int wc, int fr, int fq) const {}
    __device__ __forceinline__ void operator()(const f32x4 (&acc)[2][2][4][2], const Unit& u, int wr, int wc, int fr, int fq) const {
        const int row0 = u.pm * BM + wr * 64 + fr, col0 = u.pn * BM + wc * 32 + 8 * fq;
#pragma unroll
        for (int ai = 0; ai < 2; ++ai)
#pragma unroll
            for (int m = 0; m < 4; ++m) { const int r = row0 + ai * HALF + m * 16; float sq = 0.f;
                if (r < MTOK) { const float* xr = xrow3(meta, xp, xs, r) + col0; bf16_t* ob = XN + (size_t)r * D + col0;
#pragma unroll
                    for (int bj = 0; bj < 2; ++bj) { const f32x4 v0 = *(const f32x4*)(xr + bj * HALF) + acc[ai][bj][m][0], v1 = *(const f32x4*)(xr + bj * HALF + 4) + acc[ai][bj][m][1];
                        u32x4 w; w.x = cvt_pk_bf16(v0[0], v0[1]); w.y = cvt_pk_bf16(v0[2], v0[3]); w.z = cvt_pk_bf16(v1[0], v1[1]); w.w = cvt_pk_bf16(v1[2], v1[3]); *(u32x4*)(ob + bj * HALF) = w;
                        sq += ((v0[0] * v0[0] + v0[1] * v0[1]) + (v0[2] * v0[2] + v0[3] * v0[3])) + ((v1[0] * v1[0] + v1[1] * v1[1]) + (v1[2] * v1[2] + v1[3] * v1[3])); } }
                sq += __shfl_xor(sq, 16); sq += __shfl_xor(sq, 32);
                if (fq == 0 && r < MTOK) atomicAdd(ssq + r, sq); }
    }
    __device__ __forceinline__ void strip(const f32x4 (&sA)[4][2], const f32x4 (&sB)[4][2], const Unit& u, int wr, int wc, int fr, int fq, int a, int b, int m0, int nm) const {
        const int row0 = u.pm * BM + a * HALF + wr * 64 + fr, col0 = u.pn * BM + b * HALF + wc * 32 + 8 * fq;
#pragma unroll
        for (int mi = 0; mi < 4; ++mi) if (mi < nm) { const int r = row0 + (m0 + mi) * 16; float sq = 0.f;
            if (r < MTOK) { const float* xr = xrow3(meta, xp, xs, r) + col0; bf16_t* ob = XN + (size_t)r * D + col0;
                const f32x4 v0 = *(const f32x4*)(xr) + sA[mi][0], v1 = *(const f32x4*)(xr + 4) + sA[mi][1];
                u32x4 w; w.x = cvt_pk_bf16(v0[0], v0[1]); w.y = cvt_pk_bf16(v0[2], v0[3]); w.z = cvt_pk_bf16(v1[0], v1[1]); w.w = cvt_pk_bf16(v1[2], v1[3]); *(u32x4*)ob = w;
                sq += ((v0[0] * v0[0] + v0[1] * v0[1]) + (v0[2] * v0[2] + v0[3] * v0[3])) + ((v1[0] * v1[0] + v1[1] * v1[1]) + (v1[2] * v1[2] + v1[3] * v1[3])); }
            sq += __shfl_xor(sq, 16); sq += __shfl_xor(sq, 32);
            if (fq == 0 && r < MTOK) atomicAdd(ssq + r, sq); }
    }
};
struct EpiAcc {
    static constexpr bool PERM = true, APERM = false, AFTER_DRAIN = false, HAS_MID = false, TAIL_REDUCE = false;
    const bf16_t* X1B; bf16_t* X2B; float* PART;
    __device__ __forceinline__ void mid(f32x4 (&acc)[2][2][4][2], const Unit& u, int wr, int wc, int fr, int fq) const {}
    __device__ __forceinline__ void operator()(const f32x4 (&acc)[2][2][4][2], const Unit& u, int wr, int wc, int fr, int fq) const {
        const int rl0 = wr * 64 + fr, cl0 = wc * 32 + 8 * fq;
        if (u.kind == 0) {
#pragma unroll
            for (int ai = 0; ai < 2; ++ai)
#pragma unroll
                for (int m = 0; m < 4; ++m) { const int r = u.pm * BM + rl0 + ai * HALF + m * 16;
                    if (r < MTOK) { const size_t e = (size_t)r * D + u.pn * BM + cl0;
#pragma unroll
                        for (int bj = 0; bj < 2; ++bj) { const u32x4 xw = *(const u32x4*)(X1B + e + bj * HALF); const f32x4 a0 = acc[ai][bj][m][0], a1 = acc[ai][bj][m][1];
                            u32x4 w; w.x = cvt_pk_bf16(bflo(xw.x) + a0[0], bfhi(xw.x) + a0[1]); w.y = cvt_pk_bf16(bflo(xw.y) + a0[2], bfhi(xw.y) + a0[3]);
                            w.z = cvt_pk_bf16(bflo(xw.z) + a1[0], bfhi(xw.z) + a1[1]); w.w = cvt_pk_bf16(bflo(xw.w) + a1[2], bfhi(xw.w) + a1[3]);
                            *(u32x4*)(X2B + e + bj * HALF) = w; } } }
        } else {
            bf16_t* pt = (bf16_t*)PART + (size_t)u.slot * 65536;
#pragma unroll
            for (int ai = 0; ai < 2; ++ai)
#pragma unroll
                for (int m = 0; m < 4; ++m) { bf16_t* o = pt + (size_t)(rl0 + ai * HALF + m * 16) * 256 + cl0;
#pragma unroll
                    for (int bj = 0; bj < 2; ++bj) { const f32x4 a0 = acc[ai][bj][m][0], a1 = acc[ai][bj][m][1];
                        u32x4 w; w.x = cvt_pk_bf16(a0[0], a0[1]); w.y = cvt_pk_bf16(a0[2], a0[3]); w.z = cvt_pk_bf16(a1[0], a1[1]); w.w = cvt_pk_bf16(a1[2], a1[3]); *(u32x4*)(o + bj * HALF) = w; } }
        }
    }
};

template <class Epi, class Sched, bool ALIGN_EPI = false, bool SP2 = false>
__device__ __forceinline__ void gemm_phase(LAS unsigned char* lds, const Gemm g, const Sched& S, const Epi& E, int wv) {
    int tid_ = opaque_tid(wv);
    const int tid = tid_, wid = __builtin_amdgcn_readfirstlane(tid >> 6), lane = tid & 63, wr = wid >> 2, wc = wid & 3, fr = lane & 15, fq = lane >> 4;
    const int K = g.K;
    unsigned voffA[2], voffB[2];
#pragma unroll
    for (int i = 0; i < 2; ++i) { int R, C; stage_rc(tid * 16 + i * 8192, R, C); const int Rb = Epi::PERM ? ((R & ~31) + perm32(R & 31)) : R;
        const int Ra = Epi::APERM ? ((R & ~63) + 4 * (R & 15) + ((R >> 4) & 3)) : R;
        voffA[i] = (unsigned)(Ra * K + C) * 2u; voffB[i] = (unsigned)(Rb * K + C) * 2u; }
    const size_t kstep = (size_t)(BK * 2);
    const size_t hstep = (size_t)HALF * K * 2;
    const size_t tstep = 2 * hstep;
    const unsigned ldsw = (unsigned)wid * 1024u;
    const int aoff = lds_byte(wr * 64 + fr, fq * 8), boff = lds_byte(wc * 32 + fr, fq * 8);
#define PG8_SA(b, h) (((b) * 2 + (h)) * HTB)
#define PG8_SB(b, h) ((4 + (b) * 2 + (h)) * HTB)
#define PG8_STAGE(bufoff, gbase, voff) do { _Pragma("unroll") for (int _i = 0; _i < 2; ++_i) \
        __builtin_amdgcn_global_load_lds((const unsigned*)((const char*)(gbase) + (voff)[_i]), (LAS unsigned*)(lds + (bufoff) + ldsw + _i * 8192), 16, 0, 0); } while (0)
#define PG8_LDA(dst, b, h) do { _Pragma("unroll") for (int m = 0; m < 4; ++m) _Pragma("unroll") for (int k = 0; k < 2; ++k) dst[m][k] = *(const LAS bf16x8*)(lds + PG8_SA(b, h) + aoff + m * 2048 + k * 1024); } while (0)
#define PG8_LDB(dst, b, h) do { _Pragma("unroll") for (int n = 0; n < 2; ++n) _Pragma("unroll") for (int k = 0; k < 2; ++k) dst[n][k] = *(const LAS bf16x8*)(lds + PG8_SB(b, h) + boff + n * 2048 + k * 1024); } while (0)
#define PG8_MMA(ai, bj, At, Bt) do { __builtin_amdgcn_s_setprio(1); _Pragma("unroll") for (int m = 0; m < 4; ++m) _Pragma("unroll") for (int n = 0; n < 2; ++n) _Pragma("unroll") for (int k = 0; k < 2; ++k) \
        acc[ai][bj][m][n] = __builtin_amdgcn_mfma_f32_16x16x32_bf16(Bt[n][k], At[m][k], acc[ai][bj][m][n], 0, 0, 0); __builtin_amdgcn_s_setprio(0); } while (0)
#define PG8_WAIT_V(n) asm volatile("s_waitcnt vmcnt(" #n ")" ::: "memory")
#define PG8_WAIT_L(n) asm volatile("s_waitcnt lgkmcnt(" #n ")" ::: "memory")
#define PG8_BAR __builtin_amdgcn_s_barrier()
#define PG8_SCHED __builtin_amdgcn_sched_barrier(0)
    Unit cur, nxt; int ui = 0;
    if (!S.next(0, cur)) return;
    f32x4 acc[2][2][4][2];
#pragma unroll
    for (int a = 0; a < 2; ++a)
#pragma unroll
        for (int b = 0; b < 2; ++b)
#pragma unroll
            for (int m = 0; m < 4; ++m)
#pragma unroll
                for (int n = 0; n < 2; ++n) acc[a][b][m][n] = (f32x4){0.f, 0.f, 0.f, 0.f};
    bf16x8 At[4][2], B0[2][2], B1[2][2];
    const char* cA = (const char*)g.A + (size_t)(g.a_mode ? up_row0(cur.pm) : cur.pm * BM) * K * 2 + (size_t)cur.kt0 * kstep; const char* cB = (const char*)g.Bt + (size_t)cur.pn * tstep + (size_t)cur.kt0 * kstep;
    S.a_ready(cur);
    auto krot = [](const Unit& u) -> int { return (MK_KROT && !Epi::HAS_MID && u.kind == 0) ? (((((u.pm + 2 * u.pn) & 7) * u.nt) >> 3) & ~1) : 0; };
    int crot = krot(cur);
    { const char* fA = cA + (size_t)crot * kstep; const char* fB = cB + (size_t)crot * kstep;
    if constexpr (SP2) {
        PG8_STAGE(PG8_SB(0, 0), fB, voffB); PG8_STAGE(PG8_SB(0, 1), fB + hstep, voffB); PG8_STAGE(PG8_SA(0, 0), fA, voffA); PG8_STAGE(PG8_SA(0, 1), fA + hstep, voffA);
        if (wr == 1) PG8_BAR;
        PG8_WAIT_V(2); PG8_BAR;
        PG8_STAGE(PG8_SB(1, 0), fB + kstep, voffB); PG8_STAGE(PG8_SA(1, 0), fA + kstep, voffA); PG8_STAGE(PG8_SB(1, 1), fB + hstep + kstep, voffB);
        PG8_WAIT_V(6); PG8_BAR;
    } else {
        PG8_STAGE(PG8_SB(0, 0), fB, voffB); PG8_STAGE(PG8_SA(0, 0), fA, voffA); PG8_STAGE(PG8_SB(0, 1), fB + hstep, voffB); PG8_STAGE(PG8_SA(0, 1), fA + hstep, voffA);
        if (wr == 1) PG8_BAR;
        PG8_WAIT_V(4); PG8_BAR;
        PG8_STAGE(PG8_SB(1, 0), fB + kstep, voffB); PG8_STAGE(PG8_SA(1, 0), fA + kstep, voffA); PG8_STAGE(PG8_SB(1, 1), fB + hstep + kstep, voffB);
        PG8_WAIT_V(6); PG8_BAR;
    } }
    for (;;) {
        const bool has_next = S.next(ui + 1, nxt);
        const char* nA = has_next ? (const char*)g.A + (size_t)(g.a_mode ? up_row0(nxt.pm) : nxt.pm * BM) * K * 2 + (size_t)nxt.kt0 * kstep : cA; const char* nB = has_next ? (const char*)g.Bt + (size_t)nxt.pn * tstep + (size_t)nxt.kt0 * kstep : cB;
        const int nt = cur.nt; const int nrot = has_next ? krot(nxt) : 0;
        for (int t = 0; t < nt; t += 2) {
            const bool last = (t == nt - 2);
            int k1 = crot + t + 1, k2 = crot + t + 2; if (k1 >= nt) k1 -= nt; if (k2 >= nt) k2 -= nt;
            const char* a1 = cA + (size_t)k1 * kstep;
            const char* a2 = last ? nA + (size_t)nrot * kstep : cA + (size_t)k2 * kstep; const char* b2 = last ? nB + (size_t)nrot * kstep : cB + (size_t)k2 * kstep;
            const char* a3 = a2 + kstep; const char* b3 = b2 + kstep;
            if (last && has_next) S.a_ready(nxt);
            if constexpr (Epi::HAS_MID) { if (cur.kind == 0 && t == (nt >> 1)) E.mid(acc, cur, wr, wc, fr, fq); }
            if constexpr (SP2) {
            PG8_LDB(B0, 0, 0); PG8_LDB(B1, 0, 1); PG8_SCHED; PG8_LDA(At, 0, 0); PG8_STAGE(PG8_SA(1, 1), a1 + hstep, voffA);
            PG8_WAIT_V(8); PG8_WAIT_L(0); PG8_BAR; PG8_MMA(0, 0, At, B0); PG8_MMA(0, 1, At, B1); PG8_BAR; PG8_SCHED;
            PG8_LDA(At, 0, 1); PG8_STAGE(PG8_SB(0, 0), b2, voffB); PG8_STAGE(PG8_SB(0, 1), b2 + hstep, voffB); PG8_STAGE(PG8_SA(0, 0), a2, voffA);
            PG8_WAIT_V(8); PG8_WAIT_L(0); PG8_BAR; PG8_MMA(1, 0, At, B0); PG8_MMA(1, 1, At, B1); PG8_BAR; PG8_SCHED;
            PG8_LDB(B0, 1, 0); PG8_LDB(B1, 1, 1); PG8_SCHED; PG8_LDA(At, 1, 0); PG8_STAGE(PG8_SA(0, 1), a2 + hstep, voffA);
            PG8_WAIT_V(8); PG8_WAIT_L(0); PG8_BAR; PG8_MMA(0, 0, At, B0); PG8_MMA(0, 1, At, B1); PG8_BAR; PG8_SCHED;
            PG8_LDA(At, 1, 1); PG8_STAGE(PG8_SB(1, 0), b3, voffB); PG8_STAGE(PG8_SB(1, 1), b3 + hstep, voffB); PG8_STAGE(PG8_SA(1, 0), a3, voffA);
            PG8_WAIT_V(8); PG8_WAIT_L(0); PG8_BAR; PG8_MMA(1, 0, At, B0); PG8_MMA(1, 1, At, B1); PG8_BAR; PG8_SCHED;
            } else {
            PG8_LDB(B0, 0, 0); PG8_SCHED; PG8_LDA(At, 0, 0); PG8_STAGE(PG8_SA(1, 1), a1 + hstep, voffA);
            PG8_WAIT_L(8); PG8_BAR; PG8_WAIT_L(0); PG8_MMA(0, 0, At, B0); PG8_BAR; PG8_SCHED;
            PG8_LDB(B1, 0, 1); PG8_STAGE(PG8_SB(0, 0), b2, voffB);
            PG8_BAR; PG8_WAIT_L(0); PG8_MMA(0, 1, At, B1); PG8_BAR;
            PG8_LDA(At, 0, 1); PG8_STAGE(PG8_SA(0, 0), a2, voffA);
            PG8_BAR; PG8_WAIT_L(0); PG8_MMA(1, 0, At, B0); PG8_BAR; PG8_SCHED;
            PG8_STAGE(PG8_SB(0, 1), b2 + hstep, voffB);
            PG8_WAIT_V(6); PG8_BAR; PG8_MMA(1, 1, At, B1); PG8_BAR;
            PG8_LDB(B0, 1, 0); PG8_SCHED; PG8_LDA(At, 1, 0); PG8_STAGE(PG8_SA(0, 1), a2 + hstep, voffA);
            PG8_WAIT_L(8); PG8_BAR; PG8_WAIT_L(0); PG8_MMA(0, 0, At, B0); PG8_BAR; PG8_SCHED;
            PG8_LDB(B1, 1, 1); PG8_STAGE(PG8_SB(1, 0), b3, voffB);
            PG8_BAR; PG8_WAIT_L(0); PG8_MMA(0, 1, At, B1); PG8_BAR;
            PG8_LDA(At, 1, 1); PG8_STAGE(PG8_SA(1, 0), a3, voffA);
            PG8_BAR; PG8_WAIT_L(0); PG8_MMA(1, 0, At, B0); PG8_BAR; PG8_SCHED;
            PG8_STAGE(PG8_SB(1, 1), b3 + hstep, voffB);
            PG8_WAIT_V(6); PG8_BAR; PG8_MMA(1, 1, At, B1); PG8_BAR;
            }
        }
        if constexpr (ALIGN_EPI) { if (wr == 0) PG8_BAR; }
        if constexpr (Epi::TAIL_REDUCE) {
            if (cur.kind == 1) {
                const int tix = cur.slot / E.S, sl = cur.slot - tix * E.S; LAS unsigned* bw = (LAS unsigned*)(lds + STAGE_BYTES + 8192);
                { const __amdgpu_buffer_rsrc_t rs = __builtin_amdgcn_make_buffer_rsrc(E.PART, 0, 0x7fffffff, 0x00020000); const unsigned base = ((unsigned)cur.slot * 8192u + (unsigned)tid) * 16u;
#pragma unroll
                  for (int a = 0; a < 2; ++a)
#pragma unroll
                      for (int b = 0; b < 2; ++b)
#pragma unroll
                          for (int m = 0; m < 4; ++m) { const f32x4 a0 = acc[a][b][m][0], a1 = acc[a][b][m][1];
                              u32x4 w; w.x = cvt_pk_bf16(a0[0], a0[1]); w.y = cvt_pk_bf16(a0[2], a0[3]); w.z = cvt_pk_bf16(a1[0], a1[1]); w.w = cvt_pk_bf16(a1[2], a1[3]);
                              __builtin_amdgcn_raw_buffer_store_b128(w, rs, base + (unsigned)(((a * 2 + b) * 4 + m) * 512 * 16), 0, 16); } }
                asm volatile("s_waitcnt vmcnt(0)" ::: "memory"); PG8_BAR; asm volatile("" ::: "memory");
                if (tid == 0) { (void)__hip_atomic_fetch_add(E.tcnt + tix, 1u, __ATOMIC_RELAXED, __HIP_MEMORY_SCOPE_AGENT);
                    unsigned sp = 0; while (__hip_atomic_load(E.tcnt + tix, __ATOMIC_RELAXED, __HIP_MEMORY_SCOPE_AGENT) < (unsigned)E.S) { __builtin_amdgcn_s_sleep(2); if (++sp > (1u << 22)) break; }
                    __builtin_amdgcn_fence(__ATOMIC_ACQUIRE, "agent"); }
                asm volatile("s_waitcnt vmcnt(0) lgkmcnt(0)" ::: "memory"); PG8_BAR; asm volatile("" ::: "memory");
                __builtin_amdgcn_fence(__ATOMIC_ACQUIRE, "agent"); asm volatile("s_waitcnt vmcnt(0)" ::: "memory");
                const int per = 32 / E.S, i0 = sl * per, sa_ = i0 >> 4, sb_ = (i0 >> 3) & 1, m0 = (i0 >> 1) & 3, nm = per >> 1;
                f32x4 sA[4][2], sB[4][2];
#pragma unroll
                for (int mi = 0; mi < 4; ++mi)
#pragma unroll
                    for (int n = 0; n < 2; ++n) { sA[mi][n] = (f32x4){0.f, 0.f, 0.f, 0.f}; sB[mi][n] = (f32x4){0.f, 0.f, 0.f, 0.f}; }
#pragma unroll 1
                for (int s2 = 0; s2 < E.S; ++s2) {
                    const u32x4* pp = (const u32x4*)((const char*)E.PART + (size_t)(tix * E.S + s2) * 131072) + tid + (i0 >> 1) * 512; f32x4 tq[4][2];
#pragma unroll
                    for (int mi = 0; mi < 4; ++mi) { u32x4 pw = {0u, 0u, 0u, 0u}; if (mi < nm) pw = pp[mi * 512];
                        tq[mi][0] = (f32x4){__builtin_bit_cast(float, pw.x << 16), __builtin_bit_cast(float, pw.x & 0xffff0000u), __builtin_bit_cast(float, pw.y << 16), __builtin_bit_cast(float, pw.y & 0xffff0000u)};
                        tq[mi][1] = (f32x4){__builtin_bit_cast(float, pw.z << 16), __builtin_bit_cast(float, pw.z & 0xffff0000u), __builtin_bit_cast(float, pw.w << 16), __builtin_bit_cast(float, pw.w & 0xffff0000u)}; }
                    const bool second = Epi::HAS_MID && (s2 >= (E.S >> 1));
#pragma unroll
                    for (int mi = 0; mi < 4; ++mi)
#pragma unroll
                        for (int n = 0; n < 2; ++n) { if (second) sB[mi][n] += tq[mi][n]; else sA[mi][n] += tq[mi][n]; } }
                E.strip(sA, sB, cur, wr, wc, fr, fq, sa_, sb_, m0, nm);
            } else E(acc, cur, wr, wc, fr, fq);
        } else E(acc, cur, wr, wc, fr, fq);
        S.done(cur);
        if (!has_next) break;
#pragma unroll
        for (int a = 0; a < 2; ++a)
#pragma unroll
            for (int b = 0; b < 2; ++b)
#pragma unroll
                for (int m = 0; m < 4; ++m)
#pragma unroll
                    for (int n = 0; n < 2; ++n) acc[a][b][m][n] = (f32x4){0.f, 0.f, 0.f, 0.f};
        cur = nxt; cA = nA; cB = nB; crot = nrot; ++ui;
        if constexpr (ALIGN_EPI) { if (wr == 1) PG8_BAR; }
    }
    PG8_WAIT_V(0);
    if constexpr (!ALIGN_EPI) { if (wr == 0) PG8_BAR; }
    PG8_BAR;
#undef PG8_SA
#undef PG8_SB
#undef PG8_STAGE
#undef PG8_LDA
#undef PG8_LDB
#undef PG8_MMA
#undef PG8_WAIT_V
#undef PG8_WAIT_L
#undef PG8_BAR
#undef PG8_SCHED
}
}

constexpr int LDS_BYTES = 159744;
constexpr int NTHREADS = 512;

__device__ __forceinline__ void tr_item(const float* W, int ldw, int k0, int ns0, bf16_t* WT, int ldt, int nd0, int kd0, const float* kscale, float cs, LAS float* scr, int lane) {
    float wv_[32];
#pragma unroll
    for (int i = 0; i < 32; ++i) wv_[i] = W[(size_t)(k0 + 2 * i + (lane >> 5)) * ldw + ns0 + (lane & 31)];
#pragma unroll
    for (int i = 0; i < 32; ++i) { const int kk = 2 * i + (lane >> 5); const float s = kscale ? kscale[k0 + kk] * cs : cs; scr[kk * 33 + (lane & 31)] = wv_[i] * s; }
    asm volatile("s_waitcnt lgkmcnt(0)" ::: "memory");
    const int c = lane & 7;
#pragma unroll
    for (int j = 0; j < 4; ++j) { const int n = (lane >> 3) + 8 * j; const LAS float* s = scr + (8 * c) * 33 + n;
        u32x4 o; o.x = pk2(s[0 * 33], s[1 * 33]); o.y = pk2(s[2 * 33], s[3 * 33]); o.z = pk2(s[4 * 33], s[5 * 33]); o.w = pk2(s[6 * 33], s[7 * 33]);
        *(u32x4*)(WT + (size_t)(nd0 + n) * ldt + kd0 + k0 + 8 * c) = o; }
    asm volatile("s_waitcnt lgkmcnt(0)" ::: "memory");
}
__device__ __forceinline__ void phase_prep(const P& p, LAS unsigned char* lds, int bid, int nb, int wv) {
    const int tid = opaque_tid(wv), lane = tid & 63, wave = tid >> 6;
    unsigned char* ws = p.ws;
    LAS float* scr = (LAS float*)(lds + wave * 8448);
    LAS float* wg = (LAS float*)(lds + 8 * 8448);
    const float* w_in = p.in[I_WIN];
    for (int i = tid; i < 8192; i += NTHREADS) { const int k = i >> 3, j = i & 7; wg[j * 1024 + k] = w_in[(size_t)k * NIN + 5120 + j]; }
    __syncthreads();
    const int gw = wave * nb + bid, NGW = nb * 8;
    constexpr int I_IN = 16 * 224;
    for (int it = gw; it < I_IN; it += NGW) { const int kb = it / 224, nbk = it % 224, n0 = nbk * 32; const int ns0 = n0 + (n0 >= 5120 ? 8 : 0); const float cs = (n0 >= ZC_Q && n0 < ZC_K) ? 0.0625f : 1.0f;
        tr_item(w_in, NIN, kb * 64, ns0, (bf16_t*)(ws + WS_WIN), 1024, n0, 0, nullptr, cs, scr, lane); }
    { bf16_t* WL = (bf16_t*)(ws + WS_WLRU);
      for (int e = bid * NTHREADS + tid; e < 2 * 65536; e += nb * NTHREADS) { const int gate = e >> 16, n = (e >> 12) & 15, d = (e >> 6) & 63, c = e & 63;
          WL[e] = (bf16_t)f2bf((gate ? p.in[I_LWI] : p.in[I_LWR])[(size_t)(n * 64 + c) * 64 + d]); }
    }
    { float* ssq = (float*)(ws + WS_SSQ); for (int i = bid * NTHREADS + tid; i < MPAD; i += nb * NTHREADS) ssq[i] = 0.f; }
    { float* bias1 = (float*)(ws + WS_SMALL); const float* b_in = p.in[I_BIN];
      for (int n = bid * NTHREADS + tid; n < NZ; n += nb * NTHREADS) { const float cs = (n >= ZC_Q && n < ZC_K) ? 0.0625f : 1.0f; bias1[n] = b_in[n + (n >= 5120 ? 8 : 0)] * cs; } }
    { bf16_t* XN = (bf16_t*)(ws + WS_XN); float* gates = (float*)(ws + WS_SMALL + 65536); const float* g1 = p.in[I_G1]; const float* b_in = p.in[I_BIN];
      f32x4 vn[4];
      if (gw < MTOK) { const f32x4* xr = (const f32x4*)xrow_ptr(p, gw) + lane;
#pragma unroll
          for (int j = 0; j < 4; ++j) vn[j] = xr[64 * j]; }
      for (int m = gw; m < MTOK; m += NGW) {
          f32x4 v[4]; float s = 0.f;
#pragma unroll
          for (int j = 0; j < 4; ++j) v[j] = vn[j];
          if (m + NGW < MTOK) { const f32x4* xr = (const f32x4*)xrow_ptr(p, m + NGW) + lane;
#pragma unroll
              for (int j = 0; j < 4; ++j) vn[j] = xr[64 * j]; }
#pragma unroll
          for (int j = 0; j < 4; ++j) s += (v[j].x * v[j].x + v[j].y * v[j].y) + (v[j].z * v[j].z + v[j].w * v[j].w);
          const float rstd = 1.0f / sqrtf(wave_sum(s) * (1.0f / D) + EPS);
          unsigned long long* o8 = (unsigned long long*)(XN + (size_t)m * D) + lane;
          float ga[8];
#pragma unroll
          for (int q = 0; q < 8; ++q) ga[q] = 0.f;
#pragma unroll
          for (int j = 0; j < 4; ++j) { const f32x4 gg = ((const f32x4*)g1)[lane + 64 * j]; v[j] = v[j] * rstd * gg;
              o8[64 * j] = (unsigned long long)pk2(v[j].x, v[j].y) | ((unsigned long long)pk2(v[j].z, v[j].w) << 32);
#pragma unroll
              for (int q = 0; q < 8; ++q) { const f32x4 w = *(const LAS f32x4*)(wg + q * 1024 + 4 * (lane + 64 * j)); ga[q] += (v[j].x * w.x + v[j].y * w.y) + (v[j].z * w.z + v[j].w * w.w); } }
#pragma unroll
          for (int q = 0; q < 8; ++q) ga[q] = wave_sum(ga[q]);
          if (lane < 8) { float r = ga[0];
#pragma unroll
              for (int q = 1; q < 8; ++q) r = (lane == q) ? ga[q] : r;
              gates[(size_t)m * 8 + lane] = r + b_in[5120 + lane]; }
      } }
}

__device__ __forceinline__ void lru_load8(const bf16_t* Z, const float* st, int row0, int L, int tok, int ch, float (&o)[8]) {
    if (tok >= 0) { const int tc = tok < L ? tok : L - 1; const u32x4 w = *(const u32x4*)(Z + (size_t)(row0 + tc) * NZ + ZC_U + ch);
        o[0] = bflo(w.x); o[1] = bfhi(w.x); o[2] = bflo(w.y); o[3] = bfhi(w.y); o[4] = bflo(w.z); o[5] = bfhi(w.z); o[6] = bflo(w.w); o[7] = bfhi(w.w); }
    else if (st) { const f32x4 a = *(const f32x4*)(st + (size_t)(3 + tok) * D + ch), b = *(const f32x4*)(st + (size_t)(3 + tok) * D + ch + 4);
        o[0] = a.x; o[1] = a.y; o[2] = a.z; o[3] = a.w; o[4] = b.x; o[5] = b.y; o[6] = b.z; o[7] = b.w; }
    else {
#pragma unroll
        for (int q = 0; q < 8; ++q) o[q] = 0.f; }
}
__device__ __forceinline__ void phase_lru(const P& p, LAS unsigned char* lds, int bid, int nb, int wv, int it_lo, int it_hi) {
    const int tid = opaque_tid(wv), lane = tid & 63, w = __builtin_amdgcn_readfirstlane(tid >> 6), g = lane >> 4, li = lane & 15;
    const bf16_t* Z = (const bf16_t*)(p.ws + WS_Z); bf16_t* ACAT = (bf16_t*)(p.ws + WS_ACAT); bf16_t* PCUM = (bf16_t*)(p.ws + WS_PCUM);
    float* AGG = (float*)(p.ws + WS_AGG); float* CARRY = (float*)(p.ws + WS_CARRY); const bf16_t* WL = (const bf16_t*)(p.ws + WS_WLRU); unsigned* cnt = (unsigned*)(p.ws + WS_CTL);
    LAS float* cwL = (LAS float*)(lds + w * 6400);
    LAS float* ucL = cwL + 320;
    LAS float* gbL = cwL + 1408;
    const int n = bid & 15;
    LAS unsigned char* wls = lds + 8 * 6400;
    for (int i = tid; i < 1024; i += NTHREADS) { const int row = i >> 3, ch8 = i & 7; *(LAS u32x4*)(wls + row * 144 + ch8 * 16) = *(const u32x4*)(WL + (size_t)((row >> 6) * 16 + n) * 4096 + (row & 63) * 64 + ch8 * 8); }
    __syncthreads();
    constexpr int NPI = NBP * NSEGP, NIT = NPI + DECB;
    const int nwv = (nb >> 4) * 8;
    for (int it = it_lo + (bid >> 4) * 8 + w; it < (it_hi < NIT ? it_hi : NIT); it += nwv) {
        int s, seg;
        constexpr int NFULL = NBP * (NSEGP - 1);
        if (it < NFULL) { seg = it % (NSEGP - 1); s = it / (NSEGP - 1); } else if (it < NPI) { s = it - NFULL; seg = NSEGP - 1; } else { s = NBP + (it - NPI); seg = 0; }
        int row0, L; seq_info(s, row0, L);
        const int tb = seg * LSEG, te = (tb + LSEG < L) ? tb + LSEG : L, ntile = (te - tb + 15) >> 4;
        const float* st = (s >= NBP) ? p.in[I_SLC] + (size_t)(s - NBP) * 3 * D : nullptr;
        { const int ch = n * 64 + lane; cwL[lane] = p.in[I_LCW][ch]; cwL[64 + lane] = p.in[I_LCW][D + ch]; cwL[128 + lane] = p.in[I_LCW][2 * D + ch]; cwL[192 + lane] = p.in[I_LCW][3 * D + ch]; cwL[256 + lane] = p.in[I_LCB][ch]; }
        { const int ch = n * 64 + lane; const float lam = p.in[I_LAM][ch]; gbL[lane] = p.in[I_LBR][ch]; gbL[64 + lane] = p.in[I_LBI][ch]; gbL[128 + lane] = 8.0f * (fmaxf(-lam, 0.f) + log1pf(__expf(-fabsf(lam)))); }
        float hc[4], pc[4];
#pragma unroll
        for (int q = 0; q < 4; ++q) { const int ch = n * 64 + 16 * q + li; hc[q] = (s >= NBP) ? p.in[I_SLH][(size_t)(s - NBP) * D + ch] : 0.f; pc[q] = 1.f; }
        const int cA = n * 64 + 8 * g, cB = cA + 32;
        u32x4 rwa[4], rwb[4];
#define LRU_LOADRAW(tt0_) do { _Pragma("unroll") for (int d = 0; d < 4; ++d) { int tok = (tt0_) + li - 3 + d; tok = tok < 0 ? 0 : (tok < L ? tok : L - 1); \
            const bf16_t* zr = Z + (size_t)(row0 + tok) * NZ + ZC_U; rwa[d] = *(const u32x4*)(zr + cA); rwb[d] = *(const u32x4*)(zr + cB); } } while (0)
        LRU_LOADRAW(tb);
        for (int tile = 0; tile < ntile; ++tile) {
            const int tt0 = tb + tile * 16, t = tt0 + li;
            float ucA[8], ucB[8];
            { const f32x4 b0 = *(const LAS f32x4*)(cwL + 256 + 8 * g), b1 = *(const LAS f32x4*)(cwL + 256 + 8 * g + 4), b2 = *(const LAS f32x4*)(cwL + 256 + 32 + 8 * g), b3 = *(const LAS f32x4*)(cwL + 256 + 32 + 8 * g + 4);
              ucA[0] = b0.x; ucA[1] = b0.y; ucA[2] = b0.z; ucA[3] = b0.w; ucA[4] = b1.x; ucA[5] = b1.y; ucA[6] = b1.z; ucA[7] = b1.w;
              ucB[0] = b2.x; ucB[1] = b2.y; ucB[2] = b2.z; ucB[3] = b2.w; ucB[4] = b3.x; ucB[5] = b3.y; ucB[6] = b3.z; ucB[7] = b3.w; }
#pragma unroll
            for (int d = 0; d < 4; ++d) { float ua[8], ub[8]; unpack8(rwa[d], ua); unpack8(rwb[d], ub);
                if (tt0 == 0 && t - 3 + d < 0) { lru_load8(Z, st, row0, L, t - 3 + d, cA, ua); lru_load8(Z, st, row0, L, t - 3 + d, cB, ub); }
                const f32x4 w0 = *(const LAS f32x4*)(cwL + d * 64 + 8 * g), w1 = *(const LAS f32x4*)(cwL + d * 64 + 8 * g + 4), w2 = *(const LAS f32x4*)(cwL + d * 64 + 32 + 8 * g), w3 = *(const LAS f32x4*)(cwL + d * 64 + 32 + 8 * g + 4);
                ucA[0] += w0.x * ua[0]; ucA[1] += w0.y * ua[1]; ucA[2] += w0.z * ua[2]; ucA[3] += w0.w * ua[3]; ucA[4] += w1.x * ua[4]; ucA[5] += w1.y * ua[5]; ucA[6] += w1.z * ua[6]; ucA[7] += w1.w * ua[7];
                ucB[0] += w2.x * ub[0]; ucB[1] += w2.y * ub[1]; ucB[2] += w2.z * ub[2]; ucB[3] += w2.w * ub[3]; ucB[4] += w3.x * ub[4]; ucB[5] += w3.y * ub[5]; ucB[6] += w3.z * ub[6]; ucB[7] += w3.w * ub[7]; }
            if (tile + 1 < ntile) LRU_LOADRAW(tt0 + 16);
            *(LAS f32x4*)(ucL + li * 68 + 8 * g) = (f32x4){ucA[0], ucA[1], ucA[2], ucA[3]}; *(LAS f32x4*)(ucL + li * 68 + 8 * g + 4) = (f32x4){ucA[4], ucA[5], ucA[6], ucA[7]};
            *(LAS f32x4*)(ucL + li * 68 + 32 + 8 * g) = (f32x4){ucB[0], ucB[1], ucB[2], ucB[3]}; *(LAS f32x4*)(ucL + li * 68 + 32 + 8 * g + 4) = (f32x4){ucB[4], ucB[5], ucB[6], ucB[7]};
            bf16x8 af[2];
            { u32x4 a0, a1; a0.x = pk2(ucA[0], ucA[1]); a0.y = pk2(ucA[2], ucA[3]); a0.z = pk2(ucA[4], ucA[5]); a0.w = pk2(ucA[6], ucA[7]);
              a1.x = pk2(ucB[0], ucB[1]); a1.y = pk2(ucB[2], ucB[3]); a1.z = pk2(ucB[4], ucB[5]); a1.w = pk2(ucB[6], ucB[7]);
              af[0] = __builtin_bit_cast(bf16x8, a0); af[1] = __builtin_bit_cast(bf16x8, a1); }
            f32x4 ra[4], ia[4];
#pragma unroll
            for (int q = 0; q < 4; ++q) { ra[q] = (f32x4){0.f, 0.f, 0.f, 0.f}; ia[q] = (f32x4){0.f, 0.f, 0.f, 0.f};
#pragma unroll
                for (int k = 0; k < 2; ++k) { const bf16x8 wr0 = *(const LAS bf16x8*)(wls + (16 * q + li) * 144 + (32 * k + 8 * g) * 2), wi0 = *(const LAS bf16x8*)(wls + (64 + 16 * q + li) * 144 + (32 * k + 8 * g) * 2);
                    ra[q] = __builtin_amdgcn_mfma_f32_16x16x32_bf16(af[k], wr0, ra[q], 0, 0, 0); ia[q] = __builtin_amdgcn_mfma_f32_16x16x32_bf16(af[k], wi0, ia[q], 0, 0, 0); } }
            asm volatile("s_waitcnt lgkmcnt(0)" ::: "memory");
#pragma unroll
            for (int q = 0; q < 4; ++q) {
                const float brq = gbL[16 * q + li], biq = gbL[64 + 16 * q + li], sp8q = gbL[128 + 16 * q + li];
                float av[4], hv[4], pv[4];
                {
                    constexpr float L2E = 1.4426950408889634f;
                    const f32x4 uc4 = {ucL[(4 * g + 0) * 68 + 16 * q + li], ucL[(4 * g + 1) * 68 + 16 * q + li], ucL[(4 * g + 2) * 68 + 16 * q + li], ucL[(4 * g + 3) * 68 + 16 * q + li]};
                    const f32x4 xr = (ra[q] + brq) * (-L2E), xi = (ia[q] + biq) * (-L2E);
                    const f32x4 dr = (f32x4){__builtin_amdgcn_exp2f(xr[0]), __builtin_amdgcn_exp2f(xr[1]), __builtin_amdgcn_exp2f(xr[2]), __builtin_amdgcn_exp2f(xr[3])} + 1.0f;
                    const f32x4 di = (f32x4){__builtin_amdgcn_exp2f(xi[0]), __builtin_amdgcn_exp2f(xi[1]), __builtin_amdgcn_exp2f(xi[2]), __builtin_amdgcn_exp2f(xi[3])} + 1.0f;
                    const f32x4 rg = {__builtin_amdgcn_rcpf(dr[0]), __builtin_amdgcn_rcpf(dr[1]), __builtin_amdgcn_rcpf(dr[2]), __builtin_amdgcn_rcpf(dr[3])};
                    const f32x4 ig = {__builtin_amdgcn_rcpf(di[0]), __builtin_amdgcn_rcpf(di[1]), __builtin_amdgcn_rcpf(di[2]), __builtin_amdgcn_rcpf(di[3])};
                    const f32x4 la = rg * (-sp8q), y = la + la, le = la * L2E;
                    const f32x4 a4 = {__builtin_amdgcn_exp2f(le[0]), __builtin_amdgcn_exp2f(le[1]), __builtin_amdgcn_exp2f(le[2]), __builtin_amdgcn_exp2f(le[3])};
                    const f32x4 ser = (0.0f - y) * (1.0f + y * (0.5f + y * (0.16666667f + y * (0.041666668f + y * 0.0083333338f)))), dir = 1.0f - a4 * a4;
                    const f32x4 iu = ig * uc4;
#pragma unroll
                    for (int r = 0; r < 4; ++r) { const float om = (y[r] > -0.125f) ? ser[r] : dir[r]; float a = a4[r], inp = __builtin_amdgcn_sqrtf(om) * iu[r];
                        if (tt0 + 4 * g + r >= te) { a = 1.f; inp = 0.f; }
                        av[r] = a; hv[r] = inp; } }
                pv[0] = av[0];
#pragma unroll
                for (int r = 1; r < 4; ++r) { hv[r] = av[r] * hv[r - 1] + hv[r]; pv[r] = av[r] * pv[r - 1]; }
                float Pg[4], Hg[4];
#pragma unroll
                for (int x = 0; x < 4; ++x) { Pg[x] = __shfl(pv[3], li + 16 * x); Hg[x] = __shfl(hv[3], li + 16 * x); }
                float cin = hc[q], pin = pc[q], mycin = cin, mypin = pin;
#pragma unroll
                for (int x = 0; x < 4; ++x) { cin = Hg[x] + Pg[x] * cin; pin = Pg[x] * pin; if (g == x + 1) { mycin = cin; mypin = pin; } }
                hc[q] = cin; pc[q] = pin;
                { const unsigned ao = ((unsigned)(row0 + tt0 + 4 * g) * 2048u + (unsigned)(n * 64 + li)) * 2u, po = ((unsigned)(row0 + tt0 + 4 * g) * (unsigned)D + (unsigned)(n * 64 + li)) * 2u;
                  if (tt0 + 16 <= te) {
#pragma unroll
                      for (int r = 0; r < 4; ++r) { *(bf16_t*)((char*)ACAT + (ao + (unsigned)(r * 4096 + q * 32))) = (bf16_t)f2bf(hv[r] + pv[r] * mycin);
                          if (seg > 0) *((unsigned char*)PCUM + ((po >> 1) + (unsigned)(r * D + q * 16))) = (unsigned char)q8(pv[r] * mypin, 0u); }
                  } else {
#pragma unroll
                      for (int r = 0; r < 4; ++r) { if (tt0 + 4 * g + r < te) { *(bf16_t*)((char*)ACAT + (ao + (unsigned)(r * 4096 + q * 32))) = (bf16_t)f2bf(hv[r] + pv[r] * mycin);
                          if (seg > 0) *((unsigned char*)PCUM + ((po >> 1) + (unsigned)(r * D + q * 16))) = (unsigned char)q8(pv[r] * mypin, 0u); } } } }
            }
        }
        const int lane = lane_id_volatile(), g = lane >> 4, li = lane & 15;
        if (te == L) { float* oc = (s < NBP) ? p.out + O_PLC + (size_t)s * 3 * D : p.out + O_SLC + (size_t)(s - NBP) * 3 * D; const int ch = n * 64 + lane;
#pragma unroll
            for (int i = 0; i < 3; ++i) oc[(size_t)i * D + ch] = bf2f(Z[(size_t)(row0 + L - 3 + i) * NZ + ZC_U + ch]); }
        if (s >= NBP) { if (g == 0) {
#pragma unroll
            for (int q = 0; q < 4; ++q) p.out[O_SLH + (size_t)(s - NBP) * D + n * 64 + 16 * q + li] = hc[q]; } }
        else {
            if (g == 0) {
#pragma unroll
                for (int q = 0; q < 4; ++q) { float* ag = AGG + ((size_t)(s * NSEGP + seg) * D + n * 64 + 16 * q + li) * 2;
                    __hip_atomic_store(ag, pc[q], __ATOMIC_RELAXED, __HIP_MEMORY_SCOPE_AGENT); __hip_atomic_store(ag + 1, hc[q], __ATOMIC_RELAXED, __HIP_MEMORY_SCOPE_AGENT); } }
            asm volatile("s_waitcnt vmcnt(0)" ::: "memory");
            unsigned old = 0; if (lane == 0) old = __hip_atomic_fetch_add(cnt + s * 16 + n, 1u, __ATOMIC_RELAXED, __HIP_MEMORY_SCOPE_AGENT);
            old = (unsigned)__builtin_amdgcn_readfirstlane((int)old);
            if (old == NSEGP - 1) {
                __builtin_amdgcn_fence(__ATOMIC_ACQUIRE, "agent");
                const int ch = n * 64 + lane; const float* ag0 = AGG + ((size_t)(s * NSEGP) * D + ch) * 2;
                float Pv[NSEGP], Ev[NSEGP];
#pragma unroll
                for (int sg = 0; sg < NSEGP; ++sg) { Pv[sg] = __hip_atomic_load(ag0 + (size_t)sg * D * 2, __ATOMIC_RELAXED, __HIP_MEMORY_SCOPE_AGENT); Ev[sg] = __hip_atomic_load(ag0 + (size_t)sg * D * 2 + 1, __ATOMIC_RELAXED, __HIP_MEMORY_SCOPE_AGENT); }
                float c = 0.f;
#pragma unroll
                for (int sg = 0; sg < NSEGP; ++sg) { CARRY[(size_t)(s * NSEGP + sg) * D + ch] = c; c = Ev[sg] + Pv[sg] * c; }
                p.out[O_PLH + (size_t)s * D + ch] = c; }
        }
        asm volatile("s_waitcnt lgkmcnt(0)" ::: "memory");
    }
#undef LRU_LOADRAW
}

constexpr int ML_RS = 528, ML_VS = 144;
constexpr int ML_Q = 0, ML_K = 33792, ML_CT = 67584, ML_VT = 101376, ML_WV = 110592, ML_SW = 119808, ML_N = 129024, ML_GA = 130048, ML_QN = 131328, ML_DEN = 131584, ML_SC = 132096;
typedef short v4s __attribute__((ext_vector_type(4)));
__device__ __forceinline__ int vt_off(int R, int gi) { return R * ML_VS + ((gi ^ ((R >> 3) & 7)) << 4); }
__device__ __forceinline__ float scan_sum64(float x, int lane) {
#pragma unroll
    for (int o = 1; o < 64; o <<= 1) { const float t = __shfl_up(x, o); if (lane >= o) x += t; }
    return x;
}
__device__ __forceinline__ float scan_max64(float x, int lane) {
#pragma unroll
    for (int o = 1; o < 64; o <<= 1) { const float t = __shfl_up(x, o); if (lane >= o) x = fmaxf(x, t); }
    return x;
}
constexpr int ML_AL = 132160, ML_BL = ML_AL + 8448, ML_ML = ML_BL + 8448, ML_NT = ML_ML + 8448;
__device__ __forceinline__ void phase_mlstm(const P& p, LAS unsigned char* lds, int bid, int nb, int wv) {
    const int tid = opaque_tid(wv), lane = tid & 63, w = __builtin_amdgcn_readfirstlane(tid >> 6), g = lane >> 4, li = lane & 15;
    const bf16_t* Z = (const bf16_t*)(p.ws + WS_Z); bf16_t* ACAT = (bf16_t*)(p.ws + WS_ACAT); const float* gates = (const float*)(p.ws + WS_SMALL + 65536);
    LAS float* nL = (LAS float*)(lds + ML_N); LAS float* wkL = (LAS float*)(lds + ML_GA); LAS float* totL = wkL + 64; LAS float* cmxL = wkL + 128;
    LAS float* qnL = (LAS float*)(lds + ML_QN); LAS float* denL = (LAS float*)(lds + ML_DEN);
    LAS float* aL = (LAS float*)(lds + ML_AL); LAS float* BL = (LAS float*)(lds + ML_BL); LAS float* ML_ = (LAS float*)(lds + ML_ML);
    for (int it = bid; it < NBP * 16; it += nb) {
        const int lane = lane_id_volatile(), tid = w * 64 + lane, g = lane >> 4, li = lane & 15;
        const int sh = (it & 7) + 8 * (it >> 5), s = sh >> 2, hh = sh & 3, j = (it >> 3) & 3;
        int row0, L; seq_info(s, row0, L);
        const int nch = (L + 63) >> 6;
        const float m0 = 0.f;
        f32x4 cacc[2][4], nacc[2];
#pragma unroll
        for (int di = 0; di < 2; ++di) { nacc[di] = (f32x4){0.f, 0.f, 0.f, 0.f};
#pragma unroll
            for (int vi = 0; vi < 4; ++vi) cacc[di][vi] = (f32x4){0.f, 0.f, 0.f, 0.f}; }
        {
#pragma unroll 1
          for (int c = w; c < nch; c += 8) { const int t = c * 64 + lane; const bool valid = t < L; const float* gr = gates + (size_t)(row0 + t) * 8 + hh;
              const float lf = valid ? logsigmoidf_(gr[4]) : 0.f; const float sl = scan_sum64(lf, lane); aL[t] = valid ? gr[0] : -INFINITY; BL[t] = sl; if (lane == 63) totL[c] = sl; }
          __syncthreads();
          { const float x = (lane < nch) ? totL[lane] : 0.f; const float inc = scan_sum64(x, lane);
#pragma unroll 1
            for (int c = w; c < nch; c += 8) { const int t = c * 64 + lane; const float boff = (c > 0) ? __shfl(inc, c - 1) : 0.f; const float Bt = boff + BL[t]; const float a = aL[t] - Bt;
                const float ml = scan_max64(a, lane); aL[t] = a; BL[t] = Bt; ML_[t] = ml; if (lane == 63) cmxL[c] = ml; } }
          __syncthreads();
          { const float x = (lane < nch) ? cmxL[lane] : -INFINITY; const float pm = scan_max64(x, lane);
#pragma unroll 1
            for (int c = w; c < nch; c += 8) { const int t = c * 64 + lane; const float mp = (c > 0) ? fmaxf(m0, __shfl(pm, c - 1)) : m0; ML_[t] = fmaxf(mp, ML_[t]); } }
        }
        u32x4 pq[4], pk[4], pv;
#define ML_LOAD(t0_) do { const int t0__ = (t0_); \
            _Pragma("unroll") for (int i = 0; i < 4; ++i) { const int id = tid + 512 * i, rr = id >> 5, ch = id & 31; const bf16_t* zr = Z + (size_t)(row0 + t0__ + rr) * NZ + hh * DH + ch * 8; \
                pq[i] = *(const u32x4*)(zr + ZC_Q); pk[i] = *(const u32x4*)(zr + ZC_K); } \
            { const int rr = tid >> 3, ch = tid & 7; pv = *(const u32x4*)(Z + (size_t)(row0 + t0__ + rr) * NZ + ZC_V + hh * DH + j * 64 + ch * 8); } } while (0)
        ML_LOAD(0);
        for (int c = 0; c < nch; ++c) {
            const int t0 = c * 64;
            int tid_c = tid; asm volatile("" : "+v"(tid_c));
            const int tid = tid_c, lane = tid & 63, g = lane >> 4, li = lane & 15;
#pragma unroll
            for (int i = 0; i < 4; ++i) { const int id = tid + 512 * i, rr = id >> 5, ch = id & 31;
                *(LAS u32x4*)(lds + ML_Q + rr * ML_RS + ch * 16) = pq[i]; *(LAS u32x4*)(lds + ML_K + rr * ML_RS + ch * 16) = pk[i]; }
            { const int rr = tid >> 3, ch = tid & 7; const unsigned vw[4] = {pv.x, pv.y, pv.z, pv.w};
#pragma unroll
                for (int q = 0; q < 4; ++q) { *(LAS unsigned short*)(lds + ML_VT + vt_off(ch * 8 + 2 * q, rr >> 3) + (rr & 7) * 2) = (unsigned short)(vw[q] & 0xffffu);
                                              *(LAS unsigned short*)(lds + ML_VT + vt_off(ch * 8 + 2 * q + 1, rr >> 3) + (rr & 7) * 2) = (unsigned short)(vw[q] >> 16); } }
#pragma unroll
            for (int di = 0; di < 2; ++di) {
#pragma unroll
                for (int vi = 0; vi < 4; ++vi) { u32x2 cw; cw.x = pk2(cacc[di][vi][0], cacc[di][vi][1]); cw.y = pk2(cacc[di][vi][2], cacc[di][vi][3]);
                    *(LAS u32x2*)(lds + ML_CT + (16 * vi + li) * ML_RS + (32 * w + 16 * di + 4 * g) * 2) = cw; }
                if (li == 0) { u32x2 nw; nw.x = pk2(nacc[di][0], nacc[di][1]); nw.y = pk2(nacc[di][2], nacc[di][3]); *(LAS u32x2*)(lds + ML_NT + (32 * w + 16 * di + 4 * g) * 2) = nw; } }
            __syncthreads();
            if (c + 1 < nch) ML_LOAD(t0 + 64);
            const float Mprev = (c > 0) ? ML_[t0 - 1] : m0, MT = ML_[t0 + 63];
            bf16x8 qf[8];
            { const int ti = w >> 1, si0 = 2 * (w & 1); const bool need0 = si0 <= ti, need1 = si0 + 1 <= ti, needn = (w & 1) == 0;
              f32x4 a0 = {0.f, 0.f, 0.f, 0.f}, a1 = {0.f, 0.f, 0.f, 0.f}, aN = {0.f, 0.f, 0.f, 0.f};
              bf16x8 kf[8], nf[8];
#pragma unroll
              for (int k = 0; k < 8; ++k) qf[k] = *(const LAS bf16x8*)(lds + ML_Q + (16 * ti + li) * ML_RS + (32 * k + 8 * g) * 2);
              if (need0) {
#pragma unroll
                  for (int k = 0; k < 8; ++k) kf[k] = *(const LAS bf16x8*)(lds + ML_K + (16 * si0 + li) * ML_RS + (32 * k + 8 * g) * 2); }
              if (needn) {
#pragma unroll
                  for (int k = 0; k < 8; ++k) { const u32x4 t = *(const LAS u32x4*)(lds + ML_NT + (32 * k + 8 * g) * 2); nf[k] = __builtin_bit_cast(bf16x8, (li == 0) ? t : (u32x4){0u, 0u, 0u, 0u}); } }
              __builtin_amdgcn_sched_barrier(0);
              if (need0) {
#pragma unroll
                  for (int k = 0; k < 8; ++k) a0 = __builtin_amdgcn_mfma_f32_16x16x32_bf16(kf[k], qf[k], a0, 0, 0, 0); }
              __builtin_amdgcn_sched_barrier(0);
              if (need1) {
#pragma unroll
                  for (int k = 0; k < 8; ++k) kf[k] = *(const LAS bf16x8*)(lds + ML_K + (16 * si0 + 16 + li) * ML_RS + (32 * k + 8 * g) * 2); }
              if (needn) {
#pragma unroll
                  for (int k = 0; k < 8; ++k) aN = __builtin_amdgcn_mfma_f32_16x16x32_bf16(nf[k], qf[k], aN, 0, 0, 0);
                  if (g == 0) qnL[16 * ti + li] = aN[0]; }
              __builtin_amdgcn_sched_barrier(0);
              if (need1) {
#pragma unroll
                  for (int k = 0; k < 8; ++k) a1 = __builtin_amdgcn_mfma_f32_16x16x32_bf16(kf[k], qf[k], a1, 0, 0, 0); }
              const int tau = 16 * ti + li; const float Mt = ML_[t0 + tau]; float dsum = 0.f;
#pragma unroll
              for (int x = 0; x < 2; ++x) { const f32x4 acc = x ? a1 : a0; const int sb = 16 * (si0 + x) + 4 * g; const f32x4 as = *(const LAS f32x4*)(aL + t0 + sb); float v[4];
#pragma unroll
                  for (int r = 0; r < 4; ++r) { const float wgt = (sb + r <= tau) ? __expf(as[r] - Mt) : 0.f; v[r] = acc[r] * wgt; dsum += v[r]; }
                  u32x2 sw; sw.x = pk2(v[0], v[1]); sw.y = pk2(v[2], v[3]);
                  *(LAS u32x2*)(lds + ML_SW + tau * ML_VS + sb * 2) = sw; }
              dsum += __shfl_xor(dsum, 16); dsum += __shfl_xor(dsum, 32);
              if (g == 0) denL[tau * 2 + (w & 1)] = dsum; }
            { const int dv0 = tid >> 4, sp = tid & 15; const f32x4 as = *(const LAS f32x4*)(aL + t0 + 4 * sp);
              const f32x4 wk = {__expf(as.x - MT), __expf(as.y - MT), __expf(as.z - MT), __expf(as.w - MT)};
              if (dv0 == 0) *(LAS f32x4*)(wkL + 4 * sp) = wk;
#pragma unroll
              for (int x = 0; x < 2; ++x) { const int dv = dv0 + 32 * x; const u32x2 vv = *(const LAS u32x2*)(lds + ML_VT + vt_off(dv, sp >> 1) + (sp & 1) * 8);
                  u32x2 o; o.x = pk2(bflo(vv.x) * wk.x, bfhi(vv.x) * wk.y); o.y = pk2(bflo(vv.y) * wk.z, bfhi(vv.y) * wk.w);
                  *(LAS u32x2*)(lds + ML_WV + dv * ML_VS + sp * 8) = o; } }
            __syncthreads();
            { const int ti = w >> 1;
              bf16x8 sf[2];
#pragma unroll
              for (int k = 0; k < 2; ++k) sf[k] = *(const LAS bf16x8*)(lds + ML_SW + (16 * ti + li) * ML_VS + (32 * k + 8 * g) * 2);
#pragma unroll
              for (int x = 0; x < 2; ++x) { const int vi = (w & 1) + 2 * x; f32x4 acc = {0.f, 0.f, 0.f, 0.f}, acc2 = {0.f, 0.f, 0.f, 0.f};
              bf16x8 cf[8], vf[2];
#pragma unroll
              for (int k = 0; k < 8; ++k) cf[k] = *(const LAS bf16x8*)(lds + ML_CT + (16 * vi + li) * ML_RS + (32 * k + 8 * g) * 2);
#pragma unroll
              for (int k = 0; k < 2; ++k) vf[k] = *(const LAS bf16x8*)(lds + ML_VT + vt_off(16 * vi + li, 4 * k + g));
              const int tau = 16 * ti + li; const float Mt = ML_[t0 + tau], Bt = BL[t0 + tau], qn = qnL[tau]; const float d0 = denL[tau * 2], d1 = denL[tau * 2 + 1];
              __builtin_amdgcn_sched_barrier(0);
#pragma unroll
              for (int k = 0; k < 8; ++k) acc = __builtin_amdgcn_mfma_f32_16x16x32_bf16(cf[k], qf[k], acc, 0, 0, 0);
#pragma unroll
              for (int k = 0; k < 2; ++k) acc2 = __builtin_amdgcn_mfma_f32_16x16x32_bf16(vf[k], sf[k], acc2, 0, 0, 0);
              const float ei = __expf(Mprev - Mt);
              acc = acc * ei + acc2;
              const float den = d0 + d1 + ei * qn;
              const float inv = __builtin_amdgcn_rcpf(fmaxf(fabsf(den), __expf(-(Bt + Mt))));
              acc = acc * inv;
              if (t0 + tau < L) { u32x2 hw; hw.x = pk2(acc[0], acc[1]); hw.y = pk2(acc[2], acc[3]); *(u32x2*)(ACAT + (size_t)(row0 + t0 + tau) * 2048 + 1024 + hh * DH + j * 64 + 16 * vi + 4 * g) = hw; } } }
            { const float decay = __expf(Mprev - MT);
#pragma unroll
              for (int di = 0; di < 2; ++di) { nacc[di] = nacc[di] * decay;
#pragma unroll
                  for (int vi = 0; vi < 4; ++vi) cacc[di][vi] = cacc[di][vi] * decay; }
              const int q = li >> 2, pp = li & 3;
              bf16x8 ak[2][2], bw[2][4], bnf[2];
#pragma unroll
              for (int k = 0; k < 2; ++k) {
#pragma unroll
                  for (int di = 0; di < 2; ++di) {
                      const v4s lo = __builtin_amdgcn_ds_read_tr16_b64_v4i16((LAS v4s*)(lds + ML_K + (32 * k + 8 * g + q) * ML_RS + (32 * w + 16 * di + 4 * pp) * 2));
                      const v4s hi = __builtin_amdgcn_ds_read_tr16_b64_v4i16((LAS v4s*)(lds + ML_K + (32 * k + 8 * g + 4 + q) * ML_RS + (32 * w + 16 * di + 4 * pp) * 2));
                      ak[k][di] = (bf16x8){lo.x, lo.y, lo.z, lo.w, hi.x, hi.y, hi.z, hi.w}; }
#pragma unroll
                  for (int vi = 0; vi < 4; ++vi) bw[k][vi] = *(const LAS bf16x8*)(lds + ML_WV + (16 * vi + li) * ML_VS + (32 * k + 8 * g) * 2);
                  { const f32x4 w0 = *(const LAS f32x4*)(wkL + 32 * k + 8 * g), w1 = *(const LAS f32x4*)(wkL + 32 * k + 8 * g + 4);
                    u32x4 bn; bn.x = pk2(w0.x, w0.y); bn.y = pk2(w0.z, w0.w); bn.z = pk2(w1.x, w1.y); bn.w = pk2(w1.z, w1.w);
                    if (li != 0) bn = (u32x4){0u, 0u, 0u, 0u};
                    bnf[k] = __builtin_bit_cast(bf16x8, bn); } }
              __builtin_amdgcn_sched_barrier(0);
#pragma unroll
              for (int k = 0; k < 2; ++k) {
#pragma unroll
                  for (int vi = 0; vi < 4; ++vi)
#pragma unroll
                      for (int di = 0; di < 2; ++di) cacc[di][vi] = __builtin_amdgcn_mfma_f32_16x16x32_bf16(ak[k][di], bw[k][vi], cacc[di][vi], 0, 0, 0);
#pragma unroll
                  for (int di = 0; di < 2; ++di) nacc[di] = __builtin_amdgcn_mfma_f32_16x16x32_bf16(ak[k][di], bnf[k], nacc[di], 0, 0, 0); } }
            __syncthreads();
        }
#undef ML_LOAD
        { const int lane = lane_id_volatile(), g = lane >> 4, li = lane & 15;
          float* oC = p.out + O_PC + ((size_t)s * NH + hh) * DH * DH; float* oN = p.out + O_PN + ((size_t)s * NH + hh) * DH; float* oM = p.out + O_PM + (size_t)s * NH + hh;
#pragma unroll
          for (int di = 0; di < 2; ++di)
#pragma unroll
              for (int vi = 0; vi < 4; ++vi)
#pragma unroll
                  for (int r = 0; r < 4; ++r) oC[(size_t)(32 * w + 16 * di + 4 * g + r) * DH + j * 64 + 16 * vi + li] = cacc[di][vi][r];
          if (j == 0 && li == 0) {
#pragma unroll
              for (int di = 0; di < 2; ++di) *(f32x4*)(oN + 32 * w + 16 * di + 4 * g) = nacc[di]; }
          if (j == 0 && w == 0 && lane == 0) oM[0] = BL[L - 1] + ML_[L - 1]; }
        __syncthreads();
    }
}

constexpr int MS_NP = 0, MS_QF = 0, MS_KF = 8192, MS_QT = 32768, MS_WT = 40960, MS_SS = 49152, MS_HALF = 65536;
__device__ __forceinline__ void mlstm_sample(const P& p, LAS unsigned char* lds, int bid, int nb, int wv) {
    const int tid = opaque_tid(wv), half = tid >> 8, lt = tid & 255, lane = tid & 63, wq = (tid >> 6) & 3;
    const bf16_t* Z = (const bf16_t*)(p.ws + WS_Z); bf16_t* ACAT = (bf16_t*)(p.ws + WS_ACAT); const float* gates = (const float*)(p.ws + WS_SMALL + 65536);
    LAS unsigned char* hb = lds + half * MS_HALF;
    LAS float* NP = (LAS float*)(hb + MS_NP); LAS float* QF = (LAS float*)(hb + MS_QF); LAS float* KF = (LAS float*)(hb + MS_KF); LAS float* QT = (LAS float*)(hb + MS_QT); LAS float* WT = (LAS float*)(hb + MS_WT); LAS float* SS = (LAS float*)(hb + MS_SS);
    for (int pp = bid; pp < DECB * NH / 2; pp += nb) {
        const int pr = pp * 2 + half, b = pr >> 2, hh = pr & 3; const int rowb = MP + b * DECS;
        const float* C0 = p.in[I_SC] + (size_t)pr * DH * DH; float* OC = p.out + O_SC + (size_t)pr * DH * DH;
        float aG[8], MtG[8], BtG[8], wk[8]; const float m0 = p.in[I_SM][pr];
        { float Bc = 0.f, Mc = m0;
#pragma unroll
          for (int t = 0; t < 8; ++t) { const float* gr = gates + (size_t)(rowb + t) * 8 + hh; const float ig = gr[0], lf = logsigmoidf_(gr[4]); Bc += lf; BtG[t] = Bc; aG[t] = ig - Bc; Mc = fmaxf(Mc, aG[t]); MtG[t] = Mc; } }
        const float MT = MtG[7], decay = __expf(m0 - MT);
#pragma unroll
        for (int t = 0; t < 8; ++t) wk[t] = __expf(aG[t] - MT);
        { float kq[8], kk[8]; const bf16_t* zr = Z + (size_t)rowb * NZ + hh * DH + lt;
#pragma unroll
          for (int t = 0; t < 8; ++t) { kq[t] = bf2f(zr[(size_t)t * NZ + ZC_Q]); kk[t] = bf2f(zr[(size_t)t * NZ + ZC_K]); QF[t * 256 + lt] = kq[t]; KF[t * 256 + lt] = kk[t]; }
          const float n0 = p.in[I_SN][(size_t)pr * DH + lt]; KF[8 * 256 + lt] = n0;
          *(LAS f32x4*)(QT + lt * 8) = (f32x4){kq[0], kq[1], kq[2], kq[3]}; *(LAS f32x4*)(QT + lt * 8 + 4) = (f32x4){kq[4], kq[5], kq[6], kq[7]};
          float nn = decay * n0;
#pragma unroll
          for (int t = 0; t < 8; ++t) { kk[t] *= wk[t]; nn += kk[t]; }
          *(LAS f32x4*)(WT + lt * 8) = (f32x4){kk[0], kk[1], kk[2], kk[3]}; *(LAS f32x4*)(WT + lt * 8 + 4) = (f32x4){kk[4], kk[5], kk[6], kk[7]};
          p.out[O_SN + (size_t)pr * DH + lt] = nn;
          if (lt == 0) { p.out[O_SM + pr] = BtG[7] + MT;
#pragma unroll
              for (int t = 0; t < 8; ++t) { SS[80 + t] = aG[t]; SS[88 + t] = MtG[t]; SS[96 + t] = BtG[t]; } } }
        f32x4 vv[8];
#pragma unroll
        for (int t = 0; t < 8; ++t) { const u32x2 w = *(const u32x2*)(Z + (size_t)(rowb + t) * NZ + ZC_V + hh * DH + 4 * lane); vv[t] = (f32x4){bflo(w.x), bfhi(w.x), bflo(w.y), bfhi(w.y)}; }
        const f32x4* cp = (const f32x4*)(C0 + (size_t)(64 * wq) * DH) + lane; f32x4* op = (f32x4*)(OC + (size_t)(64 * wq) * DH) + lane;
        f32x4 cr[4];
#pragma unroll
        for (int i = 0; i < 4; ++i) cr[i] = __builtin_nontemporal_load(cp + i * 64);
        __syncthreads();
        if (lt < 144) { const int pair = lt >> 1, part = lt & 1, t = pair / 9, sp = pair - 9 * t; float acc = 0.f;
#pragma unroll 8
            for (int i = 0; i < 32; ++i) { const f32x4 a = *(const LAS f32x4*)(QF + t * 256 + part * 128 + 4 * i), bq = *(const LAS f32x4*)(KF + sp * 256 + part * 128 + 4 * i); acc += (a.x * bq.x + a.y * bq.y) + (a.z * bq.z + a.w * bq.w); }
            acc += __shfl_xor(acc, 1);
            if (part == 0) SS[pair] = acc; }
        __syncthreads();
        f32x4 num[8];
#pragma unroll
        for (int t = 0; t < 8; ++t) num[t] = (f32x4){0.f, 0.f, 0.f, 0.f};
        const LAS float* qtp = QT + 64 * wq * 8; const LAS float* wtp = WT + 64 * wq * 8;
#pragma unroll 1
        for (int rb = 0; rb < 64; rb += 4) {
            f32x4 cn[4];
            cp += 4 * 64;
            if (rb + 4 < 64) {
#pragma unroll
                for (int i = 0; i < 4; ++i) cn[i] = __builtin_nontemporal_load(cp + i * 64); }
#pragma unroll
            for (int i = 0; i < 4; ++i) {
                const f32x4 q0 = *(const LAS f32x4*)(qtp + i * 8), q1 = *(const LAS f32x4*)(qtp + i * 8 + 4), w0 = *(const LAS f32x4*)(wtp + i * 8), w1 = *(const LAS f32x4*)(wtp + i * 8 + 4);
                const f32x4 c = cr[i];
                num[0] += q0.x * c; num[1] += q0.y * c; num[2] += q0.z * c; num[3] += q0.w * c; num[4] += q1.x * c; num[5] += q1.y * c; num[6] += q1.z * c; num[7] += q1.w * c;
                f32x4 o = decay * c + w0.x * vv[0]; o += w0.y * vv[1]; o += w0.z * vv[2]; o += w0.w * vv[3]; o += w1.x * vv[4]; o += w1.y * vv[5]; o += w1.z * vv[6]; o += w1.w * vv[7];
                __builtin_nontemporal_store(o, op + i * 64); }
            op += 4 * 64; qtp += 32; wtp += 32;
            if (rb + 4 < 64) {
#pragma unroll
                for (int i = 0; i < 4; ++i) cr[i] = cn[i]; }
        }
#pragma unroll
        for (int t = 0; t < 8; ++t) *(LAS f32x4*)(NP + (wq * 8 + t) * 256 + 4 * lane) = num[t];
        __syncthreads();
        { const int t = lt >> 5, d8 = (lt & 31) * 8; float nc[8];
#pragma unroll
          for (int i = 0; i < 8; ++i) nc[i] = 0.f;
#pragma unroll
          for (int x = 0; x < 4; ++x) { const f32x4 a = *(const LAS f32x4*)(NP + (x * 8 + t) * 256 + d8), c2 = *(const LAS f32x4*)(NP + (x * 8 + t) * 256 + d8 + 4);
              nc[0] += a.x; nc[1] += a.y; nc[2] += a.z; nc[3] += a.w; nc[4] += c2.x; nc[5] += c2.y; nc[6] += c2.z; nc[7] += c2.w; }
          const float Mt = SS[88 + t], Bt = SS[96 + t]; const float eint = __expf(m0 - Mt);
          float den = eint * SS[t * 9 + 8];
#pragma unroll
          for (int i = 0; i < 8; ++i) nc[i] *= eint;
#pragma unroll
          for (int sI = 0; sI < 8; ++sI) { const float sw = (sI <= t) ? SS[t * 9 + sI] * __expf(SS[80 + sI] - Mt) : 0.f; den += sw;
              float v8[8]; unpack8(*(const u32x4*)(Z + (size_t)(rowb + sI) * NZ + ZC_V + hh * DH + d8), v8);
#pragma unroll
              for (int i = 0; i < 8; ++i) nc[i] += sw * v8[i]; }
          const float dinv = 1.0f / fmaxf(fabsf(den), __expf(-(Bt + Mt)));
          u32x4 w; w.x = pk2(nc[0] * dinv, nc[1] * dinv); w.y = pk2(nc[2] * dinv, nc[3] * dinv); w.z = pk2(nc[4] * dinv, nc[5] * dinv); w.w = pk2(nc[6] * dinv, nc[7] * dinv);
          *(u32x4*)(ACAT + (size_t)(rowb + t) * 2048 + 1024 + hh * DH + d8) = w; }
        __syncthreads();
    }
}

__device__ __forceinline__ void phase_headnorm(const P& p, int bid, int nb, int wv) {
    const int tid = opaque_tid(wv), lane = tid & 63, wave = tid >> 6;
    const bf16_t* Z = (const bf16_t*)(p.ws + WS_Z); bf16_t* ACAT = (bf16_t*)(p.ws + WS_ACAT); const float* hg = p.in[I_HG];
    const bf16_t* PCUM = (const bf16_t*)(p.ws + WS_PCUM); const float* CARRY = (const float*)(p.ws + WS_CARRY);
    f32x4 gg[4];
#pragma unroll
    for (int j = 0; j < 4; ++j) gg[j] = ((const f32x4*)hg)[lane + 64 * j];
    for (int m = wave * nb + bid; m < MTOK; m += nb * 8) {
        u32x2* ap = (u32x2*)(ACAT + (size_t)m * 2048) + lane; u32x2* hp = ap + 256; const unsigned* op = (const unsigned*)((const unsigned char*)Z + (size_t)m * ZG_PITCH + ZG_OFF) + lane;
        bool fix = false; int sq = 0, seg = 0;
        if (m < MP) { sq = m / LP; seg = (m - sq * LP) >> 6; fix = seg > 0; }
        u32x2 hv[4], av[4]; unsigned ov[4], pv[4]; f32x4 cv[4];
#pragma unroll
        for (int j = 0; j < 4; ++j) { hv[j] = hp[64 * j]; ov[j] = op[64 * j]; }
        if (fix) { const unsigned* pp = (const unsigned*)((const unsigned char*)PCUM + (size_t)m * D) + lane; const f32x4* cp = (const f32x4*)(CARRY + (size_t)(sq * NSEGP + seg) * D) + lane;
#pragma unroll
            for (int j = 0; j < 4; ++j) { av[j] = ap[64 * j]; pv[j] = pp[64 * j]; cv[j] = cp[64 * j]; } }
        if (fix) {
#pragma unroll
            for (int j = 0; j < 4; ++j) { const f32x4 c = cv[j] * (1.0f / 255.0f); u32x2 o; o.x = pk2(bflo(av[j].x) + ub0(pv[j]) * c.x, bfhi(av[j].x) + ub1(pv[j]) * c.y); o.y = pk2(bflo(av[j].y) + ub2(pv[j]) * c.z, bfhi(av[j].y) + ub3(pv[j]) * c.w); ap[64 * j] = o; } }
#pragma unroll
        for (int j = 0; j < 4; ++j) {
            float v0 = bflo(hv[j].x), v1 = bfhi(hv[j].x), v2 = bflo(hv[j].y), v3 = bfhi(hv[j].y);
            const float ssq = wave_sum((v0 * v0 + v1 * v1) + (v2 * v2 + v3 * v3));
            const float rstd = 1.0f / sqrtf(ssq * (1.0f / DH) + EPS);
            const float rq = rstd * (1.0f / 255.0f);
            v0 = v0 * rq * gg[j].x * ub0(ov[j]); v1 = v1 * rq * gg[j].y * ub1(ov[j]); v2 = v2 * rq * gg[j].z * ub2(ov[j]); v3 = v3 * rq * gg[j].w * ub3(ov[j]);
            u32x2 o; o.x = pk2(v0, v1); o.y = pk2(v2, v3); hp[64 * j] = o; }
    }
}

__device__ __forceinline__ void phase_norm2(const P& p, int bid, int nb, int wv) {
    const int tid = opaque_tid(wv), lane = tid & 63, wave = tid >> 6;
    const float* X1 = (const float*)(p.ws + WS_X1); bf16_t* XN = (bf16_t*)(p.ws + WS_XN);
    for (int m = wave * nb + bid; m < MTOK; m += nb * 8) {
        const f32x4* xr = (const f32x4*)(X1 + (size_t)m * D) + lane; f32x4 v[4]; float s = 0.f;
#pragma unroll
        for (int j = 0; j < 4; ++j) { v[j] = xr[64 * j]; s += (v[j].x * v[j].x + v[j].y * v[j].y) + (v[j].z * v[j].z + v[j].w * v[j].w); }
        const float rstd = 1.0f / sqrtf(wave_sum(s) * (1.0f / D) + EPS);
        unsigned long long* o8 = (unsigned long long*)(XN + (size_t)m * D) + lane;
#pragma unroll
        for (int j = 0; j < 4; ++j) { v[j] = v[j] * rstd; o8[64 * j] = (unsigned long long)pk2(v[j].x, v[j].y) | ((unsigned long long)pk2(v[j].z, v[j].w) << 32); }
    }
}

__device__ __forceinline__ float gelu_tanh(float x) { const float u2 = -1.5957691216057308f * (x + 0.044715f * x * x * x); return x * __builtin_amdgcn_rcpf(1.0f + __expf(u2)); }
__device__ __forceinline__ void phase_convffn(const P& p, int bid, int nb, int wv) {
    const int gid = bid * NTHREADS + opaque_tid(wv), nruns = (nb * NTHREADS) / (DFF / 8);
    const int run = gid / (DFF / 8), c0 = (gid - run * (DFF / 8)) * 8;
    if (run >= nruns) return;
    const int rpr = (MTOK + nruns - 1) / nruns, r0 = run * rpr, r1 = (r0 + rpr < MTOK) ? r0 + rpr : MTOK;
    if (r0 >= r1) return;
    const bf16_t* __restrict__ UP = (const bf16_t*)(p.ws + WS_Z); bf16_t* __restrict__ HMID = (bf16_t*)(p.ws + WS_ACAT);
    const float* __restrict__ cw = p.in[I_FCW]; const float* __restrict__ cbv = p.in[I_FCB]; const float* __restrict__ sf = p.in[I_SF]; float* __restrict__ out = p.out;
    float wvt[3][8], wg[3][8], bv[8], bg[8];
#pragma unroll
    for (int q = 0; q < 8; ++q) { bv[q] = cbv[c0 + q]; bg[q] = cbv[DFF + c0 + q];
#pragma unroll
        for (int jx = 0; jx < 3; ++jx) { wvt[jx][q] = cw[(size_t)jx * NUP + c0 + q]; wg[jx][q] = cw[(size_t)jx * NUP + DFF + c0 + q]; } }
    int s, t, L, row0;
    if (r0 < MP) s = r0 / LP; else s = NBP + (r0 - MP) / DECS;
    seq_info(s, row0, L); t = r0 - row0;
    float x0v[8], x1v[8], x0g[8], x1g[8];
#pragma unroll
    for (int q = 0; q < 8; ++q) { x0v[q] = 0.f; x1v[q] = 0.f; x0g[q] = 0.f; x1g[q] = 0.f; }
    if (t >= 1) { unpack8(*(const u32x4*)(UP + (size_t)(r0 - 1) * NUP + c0), x1v); unpack8(*(const u32x4*)(UP + (size_t)(r0 - 1) * NUP + DFF + c0), x1g); }
    if (t >= 2) { unpack8(*(const u32x4*)(UP + (size_t)(r0 - 2) * NUP + c0), x0v); unpack8(*(const u32x4*)(UP + (size_t)(r0 - 2) * NUP + DFF + c0), x0g); }
    else if (t == 1 && s >= NBP) { const float* b1 = sf + ((size_t)(s - NBP) * 2 + 1) * NUP;
#pragma unroll
        for (int q = 0; q < 8; ++q) { x0v[q] = b1[c0 + q]; x0g[q] = b1[DFF + c0 + q]; } }
    u32x4 nv[4], ng[4];
#pragma unroll
    for (int i = 0; i < 4; ++i) { const int rr = (r0 + i < r1) ? r0 + i : r1 - 1; nv[i] = *(const u32x4*)(UP + (size_t)rr * NUP + c0); ng[i] = *(const u32x4*)(UP + (size_t)rr * NUP + DFF + c0); }
    for (int rb = r0; rb < r1; rb += 4) {
        u32x4 lv[4], lg[4];
#pragma unroll
        for (int i = 0; i < 4; ++i) { lv[i] = nv[i]; lg[i] = ng[i]; }
        if (rb + 4 < r1) {
#pragma unroll
            for (int i = 0; i < 4; ++i) { const int rr = (rb + 4 + i < r1) ? rb + 4 + i : r1 - 1; nv[i] = *(const u32x4*)(UP + (size_t)rr * NUP + c0); ng[i] = *(const u32x4*)(UP + (size_t)rr * NUP + DFF + c0); } }
#pragma unroll
        for (int i = 0; i < 4; ++i) { const int r = rb + i;
            if (r < r1) {
                if (t == 0) {
                    if (s >= NBP) { const float* b0 = sf + (size_t)(s - NBP) * 2 * NUP; const float* b1 = b0 + NUP;
#pragma unroll
                        for (int q = 0; q < 8; ++q) { x0v[q] = b0[c0 + q]; x0g[q] = b0[DFF + c0 + q]; x1v[q] = b1[c0 + q]; x1g[q] = b1[DFF + c0 + q]; } }
                    else {
#pragma unroll
                        for (int q = 0; q < 8; ++q) { x0v[q] = 0.f; x0g[q] = 0.f; x1v[q] = 0.f; x1g[q] = 0.f; } } }
                float x2v[8], x2g[8], o[8]; unpack8(lv[i], x2v); unpack8(lg[i], x2g);
#pragma unroll
                for (int q = 0; q < 8; ++q) { const float val = bv[q] + wvt[0][q] * x0v[q] + wvt[1][q] * x1v[q] + wvt[2][q] * x2v[q]; const float gt = bg[q] + wg[0][q] * x0g[q] + wg[1][q] * x1g[q] + wg[2][q] * x2g[q];
                    o[q] = gelu_tanh(gt) * val; }
                u32x4 w; w.x = pk2(o[0], o[1]); w.y = pk2(o[2], o[3]); w.z = pk2(o[4], o[5]); w.w = pk2(o[6], o[7]);
                *(u32x4*)(HMID + (size_t)r * DFF + c0) = w;
                if (t >= L - 2) {
                    float* of = (s < NBP ? out + O_PF + (size_t)s * 2 * NUP : out + O_SF + (size_t)(s - NBP) * 2 * NUP) + (size_t)(t - (L - 2)) * NUP;
                    *(f32x4*)(of + c0) = (f32x4){x2v[0], x2v[1], x2v[2], x2v[3]}; *(f32x4*)(of + c0 + 4) = (f32x4){x2v[4], x2v[5], x2v[6], x2v[7]};
                    *(f32x4*)(of + DFF + c0) = (f32x4){x2g[0], x2g[1], x2g[2], x2g[3]}; *(f32x4*)(of + DFF + c0 + 4) = (f32x4){x2g[4], x2g[5], x2g[6], x2g[7]}; }
#pragma unroll
                for (int q = 0; q < 8; ++q) { x0v[q] = x1v[q]; x1v[q] = x2v[q]; x0g[q] = x1g[q]; x1g[q] = x2g[q]; }
                if (++t == L) { ++s; t = 0; seq_info(s, row0, L); }
            } }
    }
}

__device__ __forceinline__ void phase_final(const P& p, LAS unsigned char* lds, int bid, int nb, int wv) {
    const int tid = opaque_tid(wv), lane = tid & 63, wave = tid >> 6;
    const bf16_t* X2B = (const bf16_t*)(p.ws + WS_X1); const bf16_t* X1B = (const bf16_t*)(p.ws + WS_XN); const float* gf = p.in[I_GF]; const float* PART = (const float*)(p.ws + WS_Z);
    LAS int* tailmap = (LAS int*)lds;
    constexpr int DS = 11;
    for (int i = tid; i < (MPAD / 256) * 4; i += NTHREADS) tailmap[i] = -1;
    __syncthreads();
    { pg8::SplitTailOrder S; S.init(MPAD, D, DFF, nb, 0); const int R = (nb == 256) ? S.nwg - nb : 0;
      if (tid < R) { pg8::Unit u; pg8::StaticOrder t = S; t.c = tid; if (t.next(1, u)) tailmap[u.pm * 4 + u.pn] = tid; } }
    __syncthreads();
    constexpr int FU = 3;
    for (int m0 = wave * nb + bid; m0 < MTOK; m0 += nb * 8 * FU) {
        float* o[FU]; bool ok[FU]; f32x4 v[FU][4]; int tix[FU][4];
#pragma unroll
        for (int u = 0; u < FU; ++u) { const int m = m0 + u * nb * 8; ok[u] = m < MTOK; o[u] = p.out;
            if (ok[u]) { if (m < MP) { const int b = m / LP, t = m - b * LP; if (t < NMETA) ok[u] = false; else o[u] = p.out + O_YP + ((size_t)b * SEQ + (t - NMETA)) * D; }
                         else o[u] = p.out + O_YS + (size_t)(m - MP) * D; }
#pragma unroll
            for (int j = 0; j < 4; ++j) { tix[u][j] = ok[u] ? tailmap[(m >> 8) * 4 + j] : -1;
                u32x2 xw = {0u, 0u}; if (ok[u]) xw = *((const u32x2*)((tix[u][j] >= 0 ? X1B : X2B) + (size_t)m * D) + lane + 64 * j);
                v[u][j] = (f32x4){bflo(xw.x), bfhi(xw.x), bflo(xw.y), bfhi(xw.y)}; } }
#pragma unroll
        for (int u = 0; u < FU; ++u) { const int m = m0 + u * nb * 8; float s = 0.f;
            if (!ok[u]) continue;
#pragma unroll
            for (int j = 0; j < 4; ++j) {
                const int ti = tix[u][j];
                if (ti >= 0) { const u32x2* pp = (const u32x2*)((const bf16_t*)PART + (size_t)(ti * DS) * 65536 + (size_t)(m & 255) * 256) + lane;
#pragma unroll
                    for (int sl = 0; sl < DS; ++sl) { const u32x2 pw = pp[(size_t)sl * 16384]; v[u][j] += (f32x4){bflo(pw.x), bfhi(pw.x), bflo(pw.y), bfhi(pw.y)}; } }
                s += (v[u][j].x * v[u][j].x + v[u][j].y * v[u][j].y) + (v[u][j].z * v[u][j].z + v[u][j].w * v[u][j].w); }
            const float rstd = 1.0f / sqrtf(wave_sum(s) * (1.0f / D) + EPS);
#pragma unroll
            for (int j = 0; j < 4; ++j) __builtin_nontemporal_store(v[u][j] * rstd * ((const f32x4*)gf)[lane + 64 * j], (f32x4*)o[u] + lane + 64 * j); }
    }
}

__device__ __forceinline__ void late_transposes(const P& p, LAS unsigned char* lds, int gw, int NGW, int wv) {
    const int lane = lane_id_volatile(); unsigned char* ws = p.ws;
    LAS float* scr = (LAS float*)(lds + wv * 8448);
    constexpr int I_SQ = 16 * 32, I_UP = 16 * 176, I_DN = 44 * 32, NITEMS = 3 * I_SQ + I_UP + I_DN;
    for (int it = gw; it < NITEMS; it += NGW) {
        int r = it;
        if (r < I_SQ) { tr_item(p.in[I_WA], 1024, (r / 32) * 64, (r % 32) * 32, (bf16_t*)(ws + WS_WCAT), 2048, (r % 32) * 32, 0, nullptr, 1.f, scr, lane); continue; } r -= I_SQ;
        if (r < I_SQ) { tr_item(p.in[I_WB], 1024, (r / 32) * 64, (r % 32) * 32, (bf16_t*)(ws + WS_WCAT), 2048, (r % 32) * 32, 1024, nullptr, 1.f, scr, lane); continue; } r -= I_SQ;
        if (r < I_SQ) { tr_item(p.in[I_WOUT], 1024, (r / 32) * 64, (r % 32) * 32, (bf16_t*)(ws + WS_WOUT), 1024, (r % 32) * 32, 0, nullptr, 1.f, scr, lane); continue; } r -= I_SQ;
        if (r < I_UP) { const int n0 = (r % 176) * 32, ns0 = ((n0 >> 7) & 1) * DFF + (n0 >> 8) * 128 + (n0 & 127);
            tr_item(p.in[I_WUP], NUP, (r / 176) * 64, ns0, (bf16_t*)(ws + WS_WUP), 1024, n0, 0, p.in[I_G2], 1.f, scr, lane); continue; } r -= I_UP;
        tr_item(p.in[I_WDOWN], 1024, (r / 32) * 64, (r % 32) * 32, (bf16_t*)(ws + WS_WDOWN), DFF, (r % 32) * 32, 0, nullptr, 1.f, scr, lane);
    }
}
__device__ __forceinline__ void phase_gemm1(const P& p, LAS unsigned char* lds, int bid, int nb, int wv) {
    pg8::Gemm g{(const bf16_t*)(p.ws + WS_XN), (const bf16_t*)(p.ws + WS_WIN), MPAD, NZ, D, 0}; pg8::StaticOrder S; S.init(MPAD, NZ, D, nb, bid);
    pg8::EpiBf16 E{(bf16_t*)(p.ws + WS_Z), NZ, (const float*)(p.ws + WS_SMALL), nullptr};
    pg8::gemm_phase<pg8::EpiBf16, pg8::StaticOrder, true, true>(lds, g, S, E, wv);
    { const int rem = S.nwg % nb, idle0 = (rem == 0) ? 0 : rem, nidle = nb - idle0;
      if (bid >= idle0) { late_transposes(p, lds, wv * nidle + (bid - idle0), nidle * 8, wv); } }
}
__device__ __forceinline__ void phase_gemm_merge(const P& p, LAS unsigned char* lds, int bid, int nb, int wv) {
    pg8::Gemm g{(const bf16_t*)(p.ws + WS_ACAT), (const bf16_t*)(p.ws + WS_WCAT), MPAD, D, 2048, 0}; pg8::SplitTailOrder S; S.init(MPAD, D, 2048, nb, bid); S.S = (nb == 256) ? 8 : 0;
    pg8::EpiMerge E{(bf16_t*)(p.ws + WS_MERGED), (const bf16_t*)(p.ws + WS_Z), (float*)(p.ws + WS_X1), (unsigned*)(p.ws + WS_CTL) + 1024, 8};
    pg8::gemm_phase<pg8::EpiMerge, pg8::SplitTailOrder, true, true>(lds, g, S, E, wv);
}
__device__ __forceinline__ void phase_gemm_out(const P& p, LAS unsigned char* lds, int bid, int nb, int wv) {
    pg8::Gemm g{(const bf16_t*)(p.ws + WS_MERGED), (const bf16_t*)(p.ws + WS_WOUT), MPAD, D, D, 0}; pg8::SplitTailOrder S; S.init(MPAD, D, D, nb, bid); S.S = (nb == 256) ? 4 : 0;
    pg8::EpiX1 E{p.in[I_META], p.in[I_XP], p.in[I_XS], nullptr, (bf16_t*)(p.ws + WS_XN), (float*)(p.ws + WS_SSQ), (float*)(p.ws + WS_Z), (unsigned*)(p.ws + WS_CTL) + 1088, 4};
    pg8::gemm_phase<pg8::EpiX1, pg8::SplitTailOrder, true, true>(lds, g, S, E, wv);
}
__device__ __forceinline__ void phase_gemm_up(const P& p, LAS unsigned char* lds, int bid, int nb, int wv) {
    pg8::Gemm g{(const bf16_t*)(p.ws + WS_XN), (const bf16_t*)(p.ws + WS_WUP), MPAD, NUP, D, 1}; pg8::StaticOrder S; S.init(MPAD, NUP, D, nb, bid);
    pg8::EpiUp E{(bf16_t*)(p.ws + WS_ACAT), (const float*)(p.ws + WS_SSQ), p.in[I_FCW], p.in[I_FCB], p.in[I_SF], p.out, (LAS float*)(lds + 131072)};
    pg8::gemm_phase<pg8::EpiUp, pg8::StaticOrder, true, true>(lds, g, S, E, wv);
}
__device__ __forceinline__ void phase_gemm_down(const P& p, LAS unsigned char* lds, int bid, int nb, int wv) {
    pg8::Gemm g{(const bf16_t*)(p.ws + WS_ACAT), (const bf16_t*)(p.ws + WS_WDOWN), MPAD, D, DFF, 0}; pg8::SplitTailOrder S; S.init(MPAD, D, DFF, nb, bid); S.S = (nb == 256) ? 11 : 0;
    pg8::EpiAcc E{(const bf16_t*)(p.ws + WS_XN), (bf16_t*)(p.ws + WS_X1), (float*)(p.ws + WS_Z)};
    pg8::gemm_phase<pg8::EpiAcc, pg8::SplitTailOrder, true, true>(lds, g, S, E, wv);
}


#define XB_TMO      128
#define XB_XCNT(j)  (256  + 64 * (j))
#define XB_XSUB(j)  (1280 + 64 * (j))
#define XB_XGEN(j)  (2304 + 64 * (j))
#define XB_TOP      3328
#define XB_TOPGEN   3392
#define XCD_BAR_WORDS 3456
#define XB_SPIN_CAP (1u << 22)
constexpr int CW_BAR = 4096;
__device__ __forceinline__ unsigned xb_ld(unsigned* p)              { return __hip_atomic_load(p, __ATOMIC_RELAXED, __HIP_MEMORY_SCOPE_AGENT); }
__device__ __forceinline__ unsigned xb_add(unsigned* p, unsigned v) { return __hip_atomic_fetch_add(p, v, __ATOMIC_RELAXED, __HIP_MEMORY_SCOPE_AGENT); }
__device__ __forceinline__ unsigned xb_xcc_id() { return (unsigned)__builtin_amdgcn_s_getreg((3 << 11) | 20) & 0xFu; }
#define XB_SPIN(cond, bar) do { unsigned _sp = 0; while (cond) { __builtin_amdgcn_s_sleep(1); \
    if ((++_sp & 255u) == 0u) { if (xb_ld(&(bar)[XB_TMO])) break; if (_sp > XB_SPIN_CAP) { atomicAdd(&(bar)[XB_TMO], 1u); break; } } } } while (0)
struct XcdBarrier { unsigned* bar; unsigned x; volatile LAS unsigned* st; };
__device__ __forceinline__ XcdBarrier xcd_barrier_post(unsigned* bar, volatile LAS unsigned* st) {
    XcdBarrier b; b.bar = bar; b.x = xb_xcc_id(); b.st = st;
    if (threadIdx.x == 0) (void)xb_add(&bar[XB_XCNT(b.x)], 1u);
    return b;
}
__device__ __forceinline__ void xcd_barrier_complete(unsigned* bar, unsigned x, unsigned& nloc, unsigned& nx) {
    const unsigned G = gridDim.x * gridDim.y * gridDim.z;
    unsigned sum, cnt, mine, sp = 0u;
    for (;;) {
        sum = 0u; cnt = 0u; mine = 0u;
#pragma unroll
        for (unsigned j = 0; j < 16; ++j) { const unsigned c = xb_ld(&bar[XB_XCNT(j)]); sum += c; cnt += (c > 0u) ? 1u : 0u; mine = (j == x) ? c : mine; }
        if (sum == G) break;
        __builtin_amdgcn_s_sleep(1);
        if ((++sp & 255u) == 0u) { if (xb_ld(&bar[XB_TMO])) break; if (sp > XB_SPIN_CAP) { atomicAdd(&bar[XB_TMO], 1u); break; } }
    }
    nloc = mine > 0u ? mine : 1u; nx = cnt > 0u ? cnt : 1u;
}
__device__ __forceinline__ void xcd_barrier(const XcdBarrier& b, int wv);
__device__ __forceinline__ void xcd_barrier_at(unsigned* bar, volatile LAS unsigned* st, int wv) { XcdBarrier b; b.bar = bar; b.x = xb_xcc_id(); b.st = st; xcd_barrier(b, wv); }
__device__ __forceinline__ void xcd_barrier(const XcdBarrier& b, int wv) {
    asm volatile("s_waitcnt vmcnt(0)" ::: "memory");
    __syncthreads();
    if (wv == 0 && lane_id_volatile() == 0) {
        unsigned* bar = b.bar;
        __builtin_amdgcn_s_waitcnt(0);
        unsigned nloc = b.st[0], nx = b.st[1];
        if (nloc == 0u) { xcd_barrier_complete(bar, b.x, nloc, nx); b.st[0] = nloc; b.st[1] = nx; }
        const unsigned old = xb_add(&bar[XB_XSUB(b.x)], 1u);
        const unsigned gen = old / nloc;
        if (old + 1u == (gen + 1u) * nloc) {
            __builtin_amdgcn_fence(__ATOMIC_RELEASE, "agent");
            asm volatile("s_waitcnt vmcnt(0)" ::: "memory");
            const unsigned og = xb_add(&bar[XB_TOP], 1u);
            const unsigned tg = og / nx;
            if (og + 1u == (tg + 1u) * nx) xb_add(&bar[XB_TOPGEN], 1u);
            else XB_SPIN(xb_ld(&bar[XB_TOPGEN]) == tg, bar);
            __builtin_amdgcn_fence(__ATOMIC_ACQUIRE, "agent");
            xb_add(&bar[XB_XGEN(b.x)], 1u);
            asm volatile("s_waitcnt vmcnt(0)" ::: "memory");
        } else {
            XB_SPIN(xb_ld(&bar[XB_XGEN(b.x)]) == gen, bar);
            __builtin_amdgcn_fence(__ATOMIC_ACQUIRE, "agent");
            asm volatile("s_waitcnt vmcnt(0)" ::: "memory");
        }
    }
    __syncthreads();
}

constexpr int NPHASES = 12;
template <int PH> __device__ __forceinline__ void run_phase(const P& p, LAS unsigned char* lds, int bid, int nb, int wv) {
    if constexpr (PH == 0) phase_prep(p, lds, bid, nb, wv);
    if constexpr (PH == 1) phase_gemm1(p, lds, bid, nb, wv);
    constexpr int LRU_SPLIT = NBP * NSEGP + DECB / 2;
    if constexpr (PH == 2) { if (bid >= (nb >> 1)) phase_lru(p, lds, bid - (nb >> 1), nb >> 1, wv, 0, LRU_SPLIT); __syncthreads(); }
    if constexpr (PH == 3) {
        if (bid < (nb >> 1)) { phase_mlstm(p, lds, bid, nb >> 1, wv); if (MK_DUP == 30) phase_mlstm(p, lds, bid, nb >> 1, wv); __syncthreads(); phase_lru(p, lds, bid, nb >> 1, wv, LRU_SPLIT, 1 << 30); __syncthreads(); }
        else { mlstm_sample(p, lds, bid - (nb >> 1), nb >> 1, wv); if (MK_DUP == 31) mlstm_sample(p, lds, bid - (nb >> 1), nb >> 1, wv); } }
    if constexpr (PH == 4) phase_headnorm(p, bid, nb, wv);
    if constexpr (PH == 5) phase_gemm_merge(p, lds, bid, nb, wv);
    if constexpr (PH == 6) phase_gemm_out(p, lds, bid, nb, wv);
    if constexpr (PH == 7) phase_norm2(p, bid, nb, wv);
    if constexpr (PH == 8) phase_gemm_up(p, lds, bid, nb, wv);
    if constexpr (PH == 9) phase_convffn(p, bid, nb, wv);
    if constexpr (PH == 10) phase_gemm_down(p, lds, bid, nb, wv);
    if constexpr (PH == 11) phase_final(p, lds, bid, nb, wv);
}
#if MK_ONE_LAUNCH
__global__ void __launch_bounds__(NTHREADS, 2) k_fwd(P p) {
    extern __shared__ __attribute__((aligned(16))) unsigned char lds_raw[];
    LAS unsigned char* lds = (LAS unsigned char*)lds_raw;
    cg::grid_group grid = cg::this_grid();
    const int bid = (int)blockIdx.x, nb = (int)gridDim.x;
    const int wv = __builtin_amdgcn_readfirstlane((int)(threadIdx.x >> 6));
#define RUNP(X) do { run_phase<X>(p, lds, bid, nb, wv); if (MK_DUP == X) { xcd_barrier_at((unsigned*)(p.ws + WS_CTL) + CW_BAR, (volatile LAS unsigned*)(lds + LDS_BYTES - 64), wv); run_phase<X>(p, lds, bid, nb, wv); } } while (0)
    volatile LAS unsigned* bst = (volatile LAS unsigned*)(lds + LDS_BYTES - 64);
    if (threadIdx.x < 16) bst[threadIdx.x] = 0u;
    (void)xcd_barrier_post((unsigned*)(p.ws + WS_CTL) + CW_BAR, bst);
    if (nb == 0x7fffffff) grid.sync();
    run_phase<0>(p, lds, bid, nb, wv); xcd_barrier_at((unsigned*)(p.ws + WS_CTL) + CW_BAR, (volatile LAS unsigned*)(lds + LDS_BYTES - 64), wv);
    RUNP(1); xcd_barrier_at((unsigned*)(p.ws + WS_CTL) + CW_BAR, (volatile LAS unsigned*)(lds + LDS_BYTES - 64), wv);
    RUNP(2);
    RUNP(3); xcd_barrier_at((unsigned*)(p.ws + WS_CTL) + CW_BAR, (volatile LAS unsigned*)(lds + LDS_BYTES - 64), wv);
    run_phase<4>(p, lds, bid, nb, wv); xcd_barrier_at((unsigned*)(p.ws + WS_CTL) + CW_BAR, (volatile LAS unsigned*)(lds + LDS_BYTES - 64), wv);
    RUNP(5); xcd_barrier_at((unsigned*)(p.ws + WS_CTL) + CW_BAR, (volatile LAS unsigned*)(lds + LDS_BYTES - 64), wv);
    RUNP(6); xcd_barrier_at((unsigned*)(p.ws + WS_CTL) + CW_BAR, (volatile LAS unsigned*)(lds + LDS_BYTES - 64), wv);
    RUNP(8); xcd_barrier_at((unsigned*)(p.ws + WS_CTL) + CW_BAR, (volatile LAS unsigned*)(lds + LDS_BYTES - 64), wv);
    run_phase<10>(p, lds, bid, nb, wv); xcd_barrier_at((unsigned*)(p.ws + WS_CTL) + CW_BAR, (volatile LAS unsigned*)(lds + LDS_BYTES - 64), wv);
    RUNP(11);
}
#endif

#if !MK_ONE_LAUNCH
template <int PH> __global__ void __launch_bounds__(NTHREADS, 2) k_phase(P p) {
    extern __shared__ __attribute__((aligned(16))) unsigned char lds_raw[];
    run_phase<PH>(p, (LAS unsigned char*)lds_raw, (int)blockIdx.x, (int)gridDim.x, __builtin_amdgcn_readfirstlane((int)(threadIdx.x >> 6)));
}
template <int PH> static void launch_phase(const P& p, int grid, hipStream_t stream) {
    static bool attr = false;
    if (!attr) { (void)hipFuncSetAttribute((const void*)k_phase<PH>, hipFuncAttributeMaxDynamicSharedMemorySize, LDS_BYTES); attr = true; }
    hipLaunchKernelGGL(k_phase<PH>, dim3(grid), dim3(NTHREADS), LDS_BYTES, stream, p);
}
#endif

extern "C" void kernel_launch(void* const* d_in, const int* in_sizes, int n_in, void* d_out, int out_size, void* d_ws, size_t ws_size, hipStream_t stream) {
    if (n_in != 29 || (size_t)out_size != O_END || ws_size < WS_END) { fprintf(stderr, "kernel_launch: unexpected shapes (n_in %d, out %d, ws %zu)\n", n_in, out_size, ws_size); return; }
    P p{};
    for (int i = 0; i < 29; ++i) p.in[i] = (const float*)d_in[i];
    p.out = (float*)d_out; p.ws = (unsigned char*)d_ws;
#if MK_ONE_LAUNCH
    static int grid = 0;
    if (grid == 0) {
        int dev = 0, cus = 0, per_cu = 0;
        (void)hipGetDevice(&dev); (void)hipDeviceGetAttribute(&cus, hipDeviceAttributeMultiprocessorCount, dev);
        (void)hipFuncSetAttribute((const void*)k_fwd, hipFuncAttributeMaxDynamicSharedMemorySize, LDS_BYTES);
        if (hipOccupancyMaxActiveBlocksPerMultiprocessor(&per_cu, (const void*)k_fwd, NTHREADS, LDS_BYTES) != hipSuccess || per_cu < 1) { fprintf(stderr, "kernel_launch: occupancy query failed (%d)\n", per_cu); per_cu = 1; }
        grid = cus * 1;
        if (grid <= 0) grid = 256;
    }
    if (hipMemsetAsync(d_ws, 0, 32768, stream) != hipSuccess) { fprintf(stderr, "kernel_launch: memset of control words failed\n"); return; }
    void* args[] = {(void*)&p};
    hipError_t e = hipLaunchCooperativeKernel((const void*)k_fwd, dim3(grid), dim3(NTHREADS), args, LDS_BYTES, stream);
    if (e != hipSuccess) fprintf(stderr, "cooperative launch failed: %s (grid %d)\n", hipGetErrorString(e), grid);
#else
    const int grid = 256;
    launch_phase<0>(p, grid, stream); launch_phase<1>(p, grid, stream); launch_phase<2>(p, grid, stream); launch_phase<3>(p, grid, stream);
    launch_phase<4>(p, grid, stream); launch_phase<5>(p, grid, stream); launch_phase<6>(p, grid, stream); launch_phase<7>(p, grid, stream);
    launch_phase<8>(p, grid, stream); launch_phase<9>(p, grid, stream); launch_phase<10>(p, grid, stream); launch_phase<11>(p, grid, stream);
#endif
}
```

```cpp
#include <hip/hip_runtime.h>
#include <hip/hip_cooperative_groups.h>
#include <cstdio>
#include <cstdint>
namespace cg = cooperative_groups;

#ifndef MK_ONE_LAUNCH
#define MK_ONE_LAUNCH 1
#endif

#ifndef MK_KROT
#define MK_KROT 0
#endif
#ifndef MK_DUP
#define MK_DUP -1
#endif
#define LAS __attribute__((address_space(3)))
typedef unsigned short bf16_t;
typedef short bf16x8 __attribute__((ext_vector_type(8)));
typedef float f32x4 __attribute__((ext_vector_type(4)));
typedef float f32x2 __attribute__((ext_vector_type(2)));
typedef unsigned u32x4 __attribute__((ext_vector_type(4)));
typedef unsigned u32x2 __attribute__((ext_vector_type(2)));

constexpr int D = 1024, NBP = 8, SEQ = 2048, NMETA = 16, LP = SEQ + NMETA, DECB = 128, DECS = 8;
constexpr int MP = NBP * LP, MS = DECB * DECS, MTOK = MP + MS, MPAD = 17664;
constexpr int NSEQ = NBP + DECB;
constexpr int NIN = 7176, NZ = 7168;
constexpr int ZC_U = 0, ZC_Q = 1024, ZC_K = 2048, ZC_V = 3072, ZC_O = 4096, ZC_GA = 5120, ZC_GB = 6144;
constexpr int DFF = 2816, NUP = 5632, NH = 4, DH = 256;
constexpr float EPS = 1e-6f;
constexpr size_t O_YP = 0;
constexpr size_t O_YS = O_YP + (size_t)NBP * SEQ * D;
constexpr size_t O_PLC = O_YS + (size_t)DECB * DECS * D;
constexpr size_t O_PLH = O_PLC + (size_t)NBP * 3 * D;
constexpr size_t O_PC = O_PLH + (size_t)NBP * D;
constexpr size_t O_PN = O_PC + (size_t)NBP * NH * DH * DH;
constexpr size_t O_PM = O_PN + (size_t)NBP * NH * DH;
constexpr size_t O_PF = O_PM + (size_t)NBP * NH;
constexpr size_t O_SLC = O_PF + (size_t)NBP * 2 * NUP;
constexpr size_t O_SLH = O_SLC + (size_t)DECB * 3 * D;
constexpr size_t O_SC = O_SLH + (size_t)DECB * D;
constexpr size_t O_SN = O_SC + (size_t)DECB * NH * DH * DH;
constexpr size_t O_SM = O_SN + (size_t)DECB * NH * DH;
constexpr size_t O_SF = O_SM + (size_t)DECB * NH;
constexpr size_t O_END = O_SF + (size_t)DECB * 2 * NUP;
constexpr size_t MiB = 1u << 20;
constexpr size_t WS_CTL = 0, WS_WIN = 1 * MiB, WS_WCAT = 15 * MiB, WS_WOUT = 19 * MiB, WS_WUP = 21 * MiB, WS_WDOWN = 32 * MiB;
constexpr size_t WS_SMALL = 38 * MiB;
constexpr size_t WS_XN = 40 * MiB;
constexpr size_t WS_Z = 75 * MiB;
constexpr size_t WS_ACAT = 317 * MiB;
constexpr size_t WS_MERGED = 386 * MiB;
constexpr size_t WS_X1 = 421 * MiB;
constexpr size_t WS_END = 490 * MiB;
constexpr int LSEG = 64, NSEGP = 33;
constexpr size_t WS_WLRU = 39 * MiB;
constexpr size_t WS_SSQ = 39 * MiB + 512 * 1024;
constexpr size_t WS_PCUM = WS_MERGED;
constexpr size_t WS_AGG = WS_X1;
constexpr size_t WS_CARRY = WS_X1 + 4 * MiB;

struct P {
    const float* in[29];
    float* out;
    unsigned char* ws;
};
enum { I_XP = 0, I_XS, I_SLC, I_SLH, I_SC, I_SN, I_SM, I_SF, I_META, I_G1, I_WIN, I_BIN, I_LCW, I_LCB, I_LWR, I_LBR, I_LWI, I_LBI, I_LAM, I_HG, I_WA, I_WB, I_WOUT, I_G2, I_WUP, I_FCW, I_FCB, I_WDOWN, I_GF };

__device__ __forceinline__ unsigned pk2(float lo, float hi) { unsigned r; asm("v_cvt_pk_bf16_f32 %0, %1, %2" : "=v"(r) : "v"(lo), "v"(hi)); return r; }
__device__ __forceinline__ unsigned f2bf(float f) { return pk2(f, 0.f) & 0xffffu; }
__device__ __forceinline__ float bf2f(unsigned short b) { return __builtin_bit_cast(float, ((unsigned)b) << 16); }
__device__ __forceinline__ float bflo(unsigned w) { return __builtin_bit_cast(float, w << 16); }
__device__ __forceinline__ float bfhi(unsigned w) { return __builtin_bit_cast(float, w & 0xffff0000u); }
__device__ __forceinline__ void unpack8(const u32x4 w, float (&o)[8]) { o[0] = bflo(w.x); o[1] = bfhi(w.x); o[2] = bflo(w.y); o[3] = bfhi(w.y); o[4] = bflo(w.z); o[5] = bfhi(w.z); o[6] = bflo(w.w); o[7] = bfhi(w.w); }
__device__ __forceinline__ float wave_sum(float v) {
#pragma unroll
    for (int o = 1; o < 64; o <<= 1) v += __shfl_xor(v, o);
    return v;
}
__device__ __forceinline__ int lane_id_volatile() { int l; asm volatile("v_mbcnt_lo_u32_b32 %0, -1, 0\n\tv_mbcnt_hi_u32_b32 %0, -1, %0" : "=v"(l)); return l; }
__device__ __forceinline__ int opaque_tid(int wv) { return wv * 64 + lane_id_volatile(); }
__device__ __forceinline__ float sigmoidf_(float x) { return __builtin_amdgcn_rcpf(1.0f + __expf(-x)); }
constexpr int ZG_OFF = 8192, ZG_PITCH = 14336;
__device__ __forceinline__ float ub0(unsigned w) { return (float)(w & 0xffu); }
__device__ __forceinline__ float ub1(unsigned w) { return (float)((w >> 8) & 0xffu); }
__device__ __forceinline__ float ub2(unsigned w) { return (float)((w >> 16) & 0xffu); }
__device__ __forceinline__ float ub3(unsigned w) { return (float)(w >> 24); }
__device__ __forceinline__ unsigned q8(float s, unsigned lo) { const unsigned q = (unsigned)(s * 255.0f + 0.5f); return q < lo ? lo : q; }
__device__ __forceinline__ float logsigmoidf_(float x) { return fminf(x, 0.f) - log1pf(__expf(-fabsf(x))); }
__device__ __forceinline__ void seq_info(int s, int& row0, int& L) { if (s < NBP) { row0 = s * LP; L = LP; } else { row0 = MP + (s - NBP) * DECS; L = DECS; } }
__device__ __forceinline__ const float* xrow3(const float* meta, const float* xp, const float* xs, int r) {
    if (r < MP) { const int b = r / LP, t = r - b * LP; return t < NMETA ? meta + (size_t)t * D : xp + ((size_t)b * SEQ + (t - NMETA)) * D; }
    return xs + (size_t)(r - MP) * D;
}
__device__ __forceinline__ const float* xrow_ptr(const P& p, int r) {
    if (r < MP) { const int b = r / LP, t = r - b * LP; return t < NMETA ? p.in[I_META] + (size_t)t * D : p.in[I_XP] + ((size_t)b * SEQ + (t - NMETA)) * D; }
    return p.in[I_XS] + (size_t)(r - MP) * D;
}

namespace pg8 {
constexpr int BM = 256, BK = 64, HALF = 128, HTB = HALF * BK * 2, STAGE_BYTES = 8 * HTB, NXCD = 8, WGM = 8;
__host__ __device__ __forceinline__ int lds_byte(int r, int c) { const int st = (r >> 4) * 2 + (c >> 5), rr = r & 15, cc = c & 31, ob = rr * 64 + cc * 2; return st * 1024 + (ob ^ (((ob >> 9) & 1) << 5)); }
__host__ __device__ __forceinline__ void stage_rc(int b, int& R, int& C) { const int st = b / 1024, sb = b % 1024, swz = sb ^ (((sb >> 9) & 1) << 5); R = (st >> 1) * 16 + swz / 64; C = (st & 1) * 32 + (swz % 64) / 2; }
__host__ __device__ __forceinline__ int perm32(int rho) { const int n = rho >> 4, i = rho & 15; return 8 * (i >> 2) + 4 * n + (i & 3); }
__host__ __device__ __forceinline__ int up_row0(int pm) { return pm < 65 ? 254 * pm : MP + 256 * (pm - 65); }
struct Unit { int pm, pn, kt0, nt, kind, slot; };
struct Gemm { const bf16_t* A; const bf16_t* Bt; int M, N, K; int a_mode; };
struct StaticOrder {
    int nM, nN, nwg, G, c, ntk;
    __host__ __device__ void init(int M, int N, int K, int G_, int c_) { nM = M / BM; nN = N / BM; nwg = nM * nN; G = G_; c = c_; ntk = K / BK; }
    __host__ __device__ bool next(int i, Unit& u) const {
        const long L = (long)i * G + c; if (L >= nwg) return false;
        int wgid = (int)L; { const int q = nwg / NXCD, r = nwg % NXCD, xcd = wgid % NXCD, off = wgid / NXCD; wgid = (xcd < r ? xcd * (q + 1) : r * (q + 1) + (xcd - r) * q) + off; }
        const int nig = WGM * nN, gid = wgid / nig, fm = gid * WGM, gsz = (nM - fm) < WGM ? (nM - fm) : WGM;
        u.pm = fm + ((wgid % nig) % gsz); u.pn = (wgid % nig) / gsz; u.kt0 = 0; u.nt = ntk; u.kind = 0; u.slot = 0; return true;
    }
    __device__ __forceinline__ void a_ready(const Unit&) const {}
    __device__ __forceinline__ void done(const Unit&) const {}
};
struct SplitTailOrder : StaticOrder {
    int S;
    __host__ __device__ bool next(int i, Unit& u) const {
        if (S <= 0 || i == 0) return StaticOrder::next(i, u);
        if (i > 1) return false;
        const int R = nwg - G; if (R <= 0 || c >= R * S) return false;
        StaticOrder t = *this; t.c = c / S; if (!t.StaticOrder::next(1, u)) return false;
        const int sl = c % S, per = ntk / S; u.kt0 = sl * per; u.nt = per; u.kind = 1; u.slot = c; return true;
    }
};
__device__ __forceinline__ unsigned cvt_pk_bf16(float lo, float hi) { unsigned r; asm volatile("v_cvt_pk_bf16_f32 %0, %1, %2" : "=v"(r) : "v"(lo), "v"(hi)); return r; }

struct EpiBf16 {
    static constexpr bool PERM = true, APERM = false, AFTER_DRAIN = false, HAS_MID = false, TAIL_REDUCE = false;
    bf16_t* O; int ldc; const float* bias; const float* ssq;
    __device__ __forceinline__ void mid(f32x4 (&acc)[2][2][4][2], const Unit& u, int wr, int wc, int fr, int fq) const {}
    __device__ __forceinline__ void operator()(const f32x4 (&acc)[2][2][4][2], const Unit& u, int wr, int wc, int fr, int fq) const {
        const int row0 = u.pm * BM + wr * 64 + fr; const int col0 = u.pn * BM + wc * 32 + 8 * fq;
        f32x4 bv[2][2];
#pragma unroll
        for (int bj = 0; bj < 2; ++bj)
#pragma unroll
            for (int n = 0; n < 2; ++n) bv[bj][n] = bias ? *(const f32x4*)(bias + col0 + bj * HALF + 4 * n) : (f32x4){0.f, 0.f, 0.f, 0.f};
        if (u.pn >= 16) {
            const unsigned lo = (u.pn >= 24) ? 1u : 0u; unsigned char* zb = (unsigned char*)O + ZG_OFF + (col0 - 4096);
            f32x4 bvs[2][2];
#pragma unroll
            for (int bj = 0; bj < 2; ++bj)
#pragma unroll
                for (int n = 0; n < 2; ++n) bvs[bj][n] = bv[bj][n] * (-1.4426950408889634f);
#pragma unroll
            for (int ai = 0; ai < 2; ++ai)
#pragma unroll
                for (int m = 0; m < 4; ++m) { unsigned char* rowp = zb + (size_t)(row0 + ai * HALF + m * 16) * ZG_PITCH;
#pragma unroll
                    for (int bj = 0; bj < 2; ++bj) { u32x2 w;
#pragma unroll
                        for (int n = 0; n < 2; ++n) {
                            const f32x4 t = acc[ai][bj][m][n] * (-1.4426950408889634f) + bvs[bj][n];
                            const f32x4 d = (f32x4){__builtin_amdgcn_exp2f(t[0]), __builtin_amdgcn_exp2f(t[1]), __builtin_amdgcn_exp2f(t[2]), __builtin_amdgcn_exp2f(t[3])} + 1.0f;
                            const f32x4 sq = (f32x4){__builtin_amdgcn_rcpf(d[0]), __builtin_amdgcn_rcpf(d[1]), __builtin_amdgcn_rcpf(d[2]), __builtin_amdgcn_rcpf(d[3])} * 255.0f + 0.5f;
                            unsigned q0 = (unsigned)sq[0], q1 = (unsigned)sq[1], q2 = (unsigned)sq[2], q3 = (unsigned)sq[3];
                            if (lo) { q0 = q0 < 1u ? 1u : q0; q1 = q1 < 1u ? 1u : q1; q2 = q2 < 1u ? 1u : q2; q3 = q3 < 1u ? 1u : q3; }
                            const unsigned pw = q0 | (q1 << 8) | (q2 << 16) | (q3 << 24); if (n == 0) w.x = pw; else w.y = pw; }
                        *(u32x2*)(rowp + bj * HALF) = w; } }
            return; }
#pragma unroll
        for (int ai = 0; ai < 2; ++ai)
#pragma unroll
            for (int m = 0; m < 4; ++m) { bf16_t* rowp = O + (size_t)(row0 + ai * HALF + m * 16) * ldc + col0;
                const float rs = ssq ? 1.0f / sqrtf(ssq[row0 + ai * HALF + m * 16] * (1.0f / D) + EPS) : 1.0f;
#pragma unroll
                for (int bj = 0; bj < 2; ++bj) { const f32x4 v0 = acc[ai][bj][m][0] * rs + bv[bj][0], v1 = acc[ai][bj][m][1] * rs + bv[bj][1];
                    u32x4 w; w.x = cvt_pk_bf16(v0[0], v0[1]); w.y = cvt_pk_bf16(v0[2], v0[3]); w.z = cvt_pk_bf16(v1[0], v1[1]); w.w = cvt_pk_bf16(v1[2], v1[3]);
                    __builtin_nontemporal_store(w, (u32x4*)(rowp + bj * HALF)); } }
    }
};
template <int CTRL> __device__ __forceinline__ float dppmovz(float src) { return __builtin_bit_cast(float, __builtin_amdgcn_update_dpp(0, __builtin_bit_cast(int, src), CTRL, 0xf, 0xf, true)); }
__device__ __forceinline__ float gelu_tanh_e(float x) { const float u2 = -1.5957691216057308f * (x + 0.044715f * x * x * x); return x * __builtin_amdgcn_rcpf(1.0f + __expf(u2)); }
struct EpiUp {
    static constexpr bool PERM = true, APERM = true, AFTER_DRAIN = false, HAS_MID = false, TAIL_REDUCE = false;
    bf16_t* HM; const float* ssq; const float* cw; const float* cb; const float* sf; float* out; LAS float* EX;
    __device__ __forceinline__ void mid(f32x4 (&acc)[2][2][4][2], const Unit& u, int wr, int wc, int fr, int fq) const {}
    __device__ __forceinline__ void operator()(f32x4 (&acc)[2][2][4][2], const Unit& u, int wr, int wc, int fr_, int fq_) const {
        int fr = fr_, fq = fq_; asm volatile("" : "+v"(fr), "+v"(fq));
        const int rbase = up_row0(u.pm) + wr * 64 + 4 * fr;
        const bool sample = u.pm >= 65;
#pragma unroll
        for (int ai = 0; ai < 2; ++ai) { const f32x4 sq = *(const f32x4*)(ssq + rbase + ai * HALF);
#pragma unroll
            for (int m = 0; m < 4; ++m) { const float rs = __builtin_amdgcn_rsqf(sq[m] * (1.0f / D) + EPS);
#pragma unroll
                for (int bj = 0; bj < 2; ++bj)
#pragma unroll
                    for (int n = 0; n < 2; ++n) acc[ai][bj][m][n] = acc[ai][bj][m][n] * rs; } }
        const int cl = wc * 32 + 8 * fq;
        if (fr == 15) {
#pragma unroll
            for (int ai = 0; ai < 2; ++ai)
#pragma unroll
                for (int bj = 0; bj < 2; ++bj)
#pragma unroll
                    for (int n = 0; n < 2; ++n) { *(LAS f32x4*)(EX + ((ai * 2 + wr) * 2 + 0) * 256 + bj * 128 + cl + 4 * n) = acc[ai][bj][2][n]; *(LAS f32x4*)(EX + ((ai * 2 + wr) * 2 + 1) * 256 + bj * 128 + cl + 4 * n) = acc[ai][bj][3][n]; } }
        asm volatile("s_waitcnt lgkmcnt(0)" ::: "memory"); __builtin_amdgcn_s_barrier(); asm volatile("" ::: "memory");
        const float mk0 = (fr == 0) ? 1.f : 0.f;
        const int hal = (u.pm >= 1 && u.pm < 65) ? 2 : 0;
        const int ch0 = u.pn * 128 + cl;
#pragma unroll
        for (int n = 0; n < 2; ++n) {
            const int ch = ch0 + 4 * n;
            const f32x4 wv0 = *(const f32x4*)(cw + ch), wv1 = *(const f32x4*)(cw + NUP + ch), wv2 = *(const f32x4*)(cw + 2 * NUP + ch), bv = *(const f32x4*)(cb + ch);
            const f32x4 wg0 = *(const f32x4*)(cw + DFF + ch), wg1 = *(const f32x4*)(cw + NUP + DFF + ch), wg2 = *(const f32x4*)(cw + 2 * NUP + DFF + ch), bg = *(const f32x4*)(cb + DFF + ch);
#pragma unroll
            for (int ai = 0; ai < 2; ++ai) {
                const int r0 = rbase + ai * HALF;
                const int t0 = sample ? ((r0 - MP) & 7) : (r0 - (r0 / LP) * LP);
                f32x4 p1v, p2v, p1g, p2g;
#pragma unroll
                for (int j = 0; j < 4; ++j) { p1v[j] = dppmovz<0x111>(acc[ai][0][3][n][j]); p2v[j] = dppmovz<0x111>(acc[ai][0][2][n][j]); p1g[j] = dppmovz<0x111>(acc[ai][1][3][n][j]); p2g[j] = dppmovz<0x111>(acc[ai][1][2][n][j]); }
                if (ai + wr > 0) { const int pb = (wr == 1) ? (ai * 2) : 1;
                    p2v += *(const LAS f32x4*)(EX + (pb * 2 + 0) * 256 + cl + 4 * n) * mk0; p1v += *(const LAS f32x4*)(EX + (pb * 2 + 1) * 256 + cl + 4 * n) * mk0;
                    p2g += *(const LAS f32x4*)(EX + (pb * 2 + 0) * 256 + 128 + cl + 4 * n) * mk0; p1g += *(const LAS f32x4*)(EX + (pb * 2 + 1) * 256 + 128 + cl + 4 * n) * mk0; }
                if (sample) {
                    if ((fr & 1) == 0) { const float* b0 = sf + (size_t)((r0 - MP) >> 3) * 2 * NUP; p2v = *(const f32x4*)(b0 + ch); p2g = *(const f32x4*)(b0 + DFF + ch); p1v = *(const f32x4*)(b0 + NUP + ch); p1g = *(const f32x4*)(b0 + NUP + DFF + ch); } }
                if (!sample && __builtin_amdgcn_ballot_w64(t0 == 0) != 0ull) { const float keep = (t0 == 0) ? 0.f : 1.f; p1v = p1v * keep; p2v = p2v * keep; p1g = p1g * keep; p2g = p2g * keep; }
                const bool zmid = !sample && __builtin_amdgcn_ballot_w64(t0 == LP - 2) != 0ull; const float z2 = (!sample && t0 == LP - 2) ? 1.f : 0.f;
#pragma unroll
                for (int m = 0; m < 4; ++m) {
                    const f32x4 xv = acc[ai][0][m][n], xg = acc[ai][1][m][n];
                    const f32x4 av = (m == 0) ? p1v : acc[ai][0][m > 0 ? m - 1 : 0][n], ag = (m == 0) ? p1g : acc[ai][1][m > 0 ? m - 1 : 0][n];
                    const f32x4 bv2 = (m == 0) ? p2v : (m == 1) ? p1v : acc[ai][0][m > 1 ? m - 2 : 0][n], bg2 = (m == 0) ? p2g : (m == 1) ? p1g : acc[ai][1][m > 1 ? m - 2 : 0][n];
                    f32x4 cv = bv + wv2 * xv + wv1 * av + wv0 * bv2, cg = bg + wg2 * xg + wg1 * ag + wg0 * bg2;
                    if (zmid && m == 2) { cv -= z2 * (wv1 * av + wv0 * bv2); cg -= z2 * (wg1 * ag + wg0 * bg2); }
                    if (zmid && m == 3) { cv -= z2 * (wv0 * bv2); cg -= z2 * (wg0 * bg2); }
                    if ((ai == 1 || m >= 2) ? true : (wr * 64 + 4 * fr + m >= hal)) {
                        constexpr float GC = -1.5957691216057308f * 1.4426950408889634f; const f32x4 ug = cg * ((cg * cg) * (0.044715f * GC) + GC);
                        const f32x4 dg = (f32x4){__builtin_amdgcn_exp2f(ug[0]), __builtin_amdgcn_exp2f(ug[1]), __builtin_amdgcn_exp2f(ug[2]), __builtin_amdgcn_exp2f(ug[3])} + 1.0f;
                        const f32x4 og = (cg * cv) * (f32x4){__builtin_amdgcn_rcpf(dg[0]), __builtin_amdgcn_rcpf(dg[1]), __builtin_amdgcn_rcpf(dg[2]), __builtin_amdgcn_rcpf(dg[3])};
                        u32x2 w; w.x = cvt_pk_bf16(og[0], og[1]); w.y = cvt_pk_bf16(og[2], og[3]);
                        *(u32x2*)((char*)HM + (((unsigned)(r0 + m) * (unsigned)DFF + (unsigned)ch) * 2u)) = w; }
                    __builtin_amdgcn_sched_barrier(0); }
            }
        }
#pragma unroll
        for (int ai = 0; ai < 2; ++ai) {
            int r0s = rbase + ai * HALF; asm volatile("" : "+v"(r0s));
            const int t0 = sample ? ((r0s - MP) & 7) : (r0s - (r0s / LP) * LP), Lq = sample ? DECS : LP;
            if (__builtin_amdgcn_ballot_w64(t0 + 3 >= Lq - 2) != 0ull) {
                float* ob = sample ? out + O_SF + (size_t)((r0s - MP) >> 3) * 2 * NUP : out + O_PF + (size_t)(r0s / LP) * 2 * NUP;
#pragma unroll
                for (int m = 0; m < 4; ++m) { const int t = t0 + m, i = ai * HALF + wr * 64 + 4 * fr + m;
                    if (t >= Lq - 2 && t < Lq && i >= hal) { float* of = ob + (size_t)(t - (Lq - 2)) * NUP + ch0;
                        *(f32x4*)(of) = acc[ai][0][m][0]; *(f32x4*)(of + 4) = acc[ai][0][m][1]; *(f32x4*)(of + DFF) = acc[ai][1][m][0]; *(f32x4*)(of + DFF + 4) = acc[ai][1][m][1]; } } }
        }
    }
};
struct EpiMerge {
    static constexpr bool PERM = true, APERM = false, AFTER_DRAIN = false, HAS_MID = true, TAIL_REDUCE = true;
    bf16_t* O; const bf16_t* Z; float* PART; unsigned* tcnt; int S;
    __device__ __forceinline__ void mid(f32x4 (&acc)[2][2][4][2], const Unit& u, int wr, int wc, int fr, int fq) const {
        int row0 = u.pm * BM + wr * 64 + fr; const int col0 = u.pn * BM + wc * 32 + 8 * fq;
        asm volatile("" : "+v"(row0));
#pragma unroll
        for (int ai = 0; ai < 2; ++ai)
#pragma unroll
            for (int m = 0; m < 4; ++m) { const unsigned char* zr = (const unsigned char*)Z + (size_t)(row0 + ai * HALF + m * 16) * ZG_PITCH + ZG_OFF + col0;
#pragma unroll
                for (int bj = 0; bj < 2; ++bj) {
                    const u32x2 qa = *(const u32x2*)(zr + 1024 + bj * HALF), qb = *(const u32x2*)(zr + 2048 + bj * HALF);
                    const unsigned qaw[2] = {qa.x, qa.y}, qbw[2] = {qb.x, qb.y};
#pragma unroll
                    for (int n = 0; n < 2; ++n) { const unsigned wa = qaw[n], wb = qbw[n];
                        const f32x4 fa = {ub0(wa), ub1(wa), ub2(wa), ub3(wa)}, rb = {__builtin_amdgcn_rcpf(ub0(wb)), __builtin_amdgcn_rcpf(ub1(wb)), __builtin_amdgcn_rcpf(ub2(wb)), __builtin_amdgcn_rcpf(ub3(wb))};
                        acc[ai][bj][m][n] = acc[ai][bj][m][n] * (fa * rb); } }
                asm volatile("" ::: "memory"); }
    }
    __device__ __forceinline__ void operator()(const f32x4 (&acc)[2][2][4][2], const Unit& u, int wr, int wc, int fr, int fq) const {
        const int row0 = u.pm * BM + wr * 64 + fr; const int col0 = u.pn * BM + wc * 32 + 8 * fq;
#pragma unroll
        for (int ai = 0; ai < 2; ++ai)
#pragma unroll
            for (int m = 0; m < 4; ++m) { const size_t r = (size_t)(row0 + ai * HALF + m * 16);
#pragma unroll
                for (int bj = 0; bj < 2; ++bj) {
                    const u32x2 qb = *(const u32x2*)((const unsigned char*)Z + r * ZG_PITCH + ZG_OFF + 2048 + col0 + bj * HALF); const unsigned qbw[2] = {qb.x, qb.y};
                    float v[8];
#pragma unroll
                    for (int n = 0; n < 2; ++n) { const unsigned wb = qbw[n]; const f32x4 a = acc[ai][bj][m][n] * (1.0f / 255.0f);
                        v[4 * n + 0] = a[0] * ub0(wb); v[4 * n + 1] = a[1] * ub1(wb); v[4 * n + 2] = a[2] * ub2(wb); v[4 * n + 3] = a[3] * ub3(wb); }
                    u32x4 w; w.x = cvt_pk_bf16(v[0], v[1]); w.y = cvt_pk_bf16(v[2], v[3]); w.z = cvt_pk_bf16(v[4], v[5]); w.w = cvt_pk_bf16(v[6], v[7]);
                    *(u32x4*)(O + r * D + col0 + bj * HALF) = w; }
                asm volatile("" ::: "memory"); }
    }
    __device__ __forceinline__ void strip(const f32x4 (&sA)[4][2], const f32x4 (&sB)[4][2], const Unit& u, int wr, int wc, int fr, int fq, int a, int b, int m0, int nm) const {
        const int row0 = u.pm * BM + a * HALF + wr * 64 + fr, col0 = u.pn * BM + b * HALF + wc * 32 + 8 * fq;
#pragma unroll
        for (int mi = 0; mi < 4; ++mi) if (mi < nm) { const size_t r = (size_t)(row0 + (m0 + mi) * 16);
            const unsigned char* zr = (const unsigned char*)Z + r * ZG_PITCH + ZG_OFF + col0; const u32x2 qa = *(const u32x2*)(zr + 1024), qb = *(const u32x2*)(zr + 2048); const unsigned qaw[2] = {qa.x, qa.y}, qbw[2] = {qb.x, qb.y};
            float v[8];
#pragma unroll
            for (int n = 0; n < 2; ++n) { const unsigned wa = qaw[n], wb = qbw[n]; const f32x4 xa = sA[mi][n] * (1.0f / 255.0f), xb = sB[mi][n] * (1.0f / 255.0f);
                v[4 * n + 0] = ub0(wa) * xa[0] + ub0(wb) * xb[0]; v[4 * n + 1] = ub1(wa) * xa[1] + ub1(wb) * xb[1]; v[4 * n + 2] = ub2(wa) * xa[2] + ub2(wb) * xb[2]; v[4 * n + 3] = ub3(wa) * xa[3] + ub3(wb) * xb[3]; }
            u32x4 w; w.x = cvt_pk_bf16(v[0], v[1]); w.y = cvt_pk_bf16(v[2], v[3]); w.z = cvt_pk_bf16(v[4], v[5]); w.w = cvt_pk_bf16(v[6], v[7]);
            *(u32x4*)(O + r * D + col0) = w; }
    }
};
struct EpiX1 {
    static constexpr bool PERM = true, APERM = false, AFTER_DRAIN = false, HAS_MID = false, TAIL_REDUCE = true;
    const float *meta, *xp, *xs; float* X1; bf16_t* XN; float* ssq; float* PART; unsigned* tcnt; int S;
    __device__ __forceinline__ void mid(f32x4 (&acc)[2][2][4][2], const Unit& u, int wr, int wc, int fr, int fq) const {}
    __device__ __forceinline__ void operator()(const f32x4 (&acc)[2][2][4][2], const Unit& u, int wr, int wc, int fr, int fq) const {
        const int row0 = u.pm * BM + wr * 64 + fr, col0 = u.pn * BM + wc * 32 + 8 * fq;
#pragma unroll
        for (int ai = 0; ai < 2; ++ai)
#pragma unroll
            for (int m = 0; m < 4; ++m) { const int r = row0 + ai * HALF + m * 16; float sq = 0.f;
                if (r < MTOK) { const float* xr = xrow3(meta, xp, xs, r) + col0; bf16_t* ob = XN + (size_t)r * D + col0;
#pragma unroll
                    for (int bj = 0; bj < 2; ++bj) { const f32x4 v0 = *(const f32x4*)(xr + bj * HALF) + acc[ai][bj][m][0], v1 = *(const f32x4*)(xr + bj * HALF + 4) + acc[ai][bj][m][1];
                        u32x4 w; w.x = cvt_pk_bf16(v0[0], v0[1]); w.y = cvt_pk_bf16(v0[2], v0[3]); w.z = cvt_pk_bf16(v1[0], v1[1]); w.w = cvt_pk_bf16(v1[2], v1[3]); *(u32x4*)(ob + bj * HALF) = w;
                        sq += ((v0[0] * v0[0] + v0[1] * v0[1]) + (v0[2] * v0[2] + v0[3] * v0[3])) + ((v1[0] * v1[0] + v1[1] * v1[1]) + (v1[2] * v1[2] + v1[3] * v1[3])); } }
                sq += __shfl_xor(sq, 16); sq += __shfl_xor(sq, 32);
                if (fq == 0 && r < MTOK) atomicAdd(ssq + r, sq); }
    }
    __device__ __forceinline__ void strip(const f32x4 (&sA)[4][2], const f32x4 (&sB)[4][2], const Unit& u, int wr, int wc, int fr, int fq, int a, int b, int m0, int nm) const {
        const int row0 = u.pm * BM + a * HALF + wr * 64 + fr, col0 = u.pn * BM + b * HALF + wc * 32 + 8 * fq;
#pragma unroll
        for (int mi = 0; mi < 4; ++mi) if (mi < nm) { const int r = row0 + (m0 + mi) * 16; float sq = 0.f;
            if (r < MTOK) { const float* xr = xrow3(meta, xp, xs, r) + col0; bf16_t* ob = XN + (size_t)r * D + col0;
                const f32x4 v0 = *(const f32x4*)(xr) + sA[mi][0], v1 = *(const f32x4*)(xr + 4) + sA[mi][1];
                u32x4 w; w.x = cvt_pk_bf16(v0[0], v0[1]); w.y = cvt_pk_bf16(v0[2], v0[3]); w.z = cvt_pk_bf16(v1[0], v1[1]); w.w = cvt_pk_bf16(v1[2], v1[3]); *(u32x4*)ob = w;
                sq += ((v0[0] * v0[0] + v0[1] * v0[1]) + (v0[2] * v0[2] + v0[3] * v0[3])) + ((v1[0] * v1[0] + v1[1] * v1[1]) + (v1[2] * v1[2] + v1[3] * v1[3])); }
            sq += __shfl_xor(sq, 16); sq += __shfl_xor(sq, 32);
            if (fq == 0 && r < MTOK) atomicAdd(ssq + r, sq); }
    }
};
struct EpiAcc {
    static constexpr bool PERM = true, APERM = false, AFTER_DRAIN = false, HAS_MID = false, TAIL_REDUCE = false;
    const bf16_t* X1B; bf16_t* X2B; float* PART;
    __device__ __forceinline__ void mid(f32x4 (&acc)[2][2][4][2], const Unit& u, int wr, int wc, int fr, int fq) const {}
    __device__ __forceinline__ void operator()(const f32x4 (&acc)[2][2][4][2], const Unit& u, int wr, int wc, int fr, int fq) const {
        const int rl0 = wr * 64 + fr, cl0 = wc * 32 + 8 * fq;
        if (u.kind == 0) {
#pragma unroll
            for (int ai = 0; ai < 2; ++ai)
#pragma unroll
                for (int m = 0; m < 4; ++m) { const int r = u.pm * BM + rl0 + ai * HALF + m * 16;
                    if (r < MTOK) { const size_t e = (size_t)r * D + u.pn * BM + cl0;
#pragma unroll
                        for (int bj = 0; bj < 2; ++bj) { const u32x4 xw = *(const u32x4*)(X1B + e + bj * HALF); const f32x4 a0 = acc[ai][bj][m][0], a1 = acc[ai][bj][m][1];
                            u32x4 w; w.x = cvt_pk_bf16(bflo(xw.x) + a0[0], bfhi(xw.x) + a0[1]); w.y = cvt_pk_bf16(bflo(xw.y) + a0[2], bfhi(xw.y) + a0[3]);
                            w.z = cvt_pk_bf16(bflo(xw.z) + a1[0], bfhi(xw.z) + a1[1]); w.w = cvt_pk_bf16(bflo(xw.w) + a1[2], bfhi(xw.w) + a1[3]);
                            *(u32x4*)(X2B + e + bj * HALF) = w; } } }
        } else {
            bf16_t* pt = (bf16_t*)PART + (size_t)u.slot * 65536;
#pragma unroll
            for (int ai = 0; ai < 2; ++ai)
#pragma unroll
                for (int m = 0; m < 4; ++m) { bf16_t* o = pt + (size_t)(rl0 + ai * HALF + m * 16) * 256 + cl0;
#pragma unroll
                    for (int bj = 0; bj < 2; ++bj) { const f32x4 a0 = acc[ai][bj][m][0], a1 = acc[ai][bj][m][1];
                        u32x4 w; w.x = cvt_pk_bf16(a0[0], a0[1]); w.y = cvt_pk_bf16(a0[2], a0[3]); w.z = cvt_pk_bf16(a1[0], a1[1]); w.w = cvt_pk_bf16(a1[2], a1[3]); *(u32x4*)(o + bj * HALF) = w; } }
        }
    }
};

template <class Epi, class Sched, bool ALIGN_EPI = false, bool SP2 = false>
__device__ __forceinline__ void gemm_phase(LAS unsigned char* lds, const Gemm g, const Sched& S, const Epi& E, int wv) {
    int tid_ = opaque_tid(wv);
    const int tid = tid_, wid = __builtin_amdgcn_readfirstlane(tid >> 6), lane = tid & 63, wr = wid >> 2, wc = wid & 3, fr = lane & 15, fq = lane >> 4;
    const int K = g.K;
    unsigned voffA[2], voffB[2];
#pragma unroll
    for (int i = 0; i < 2; ++i) { int R, C; stage_rc(tid * 16 + i * 8192, R, C); const int Rb = Epi::PERM ? ((R & ~31) + perm32(R & 31)) : R;
        const int Ra = Epi::APERM ? ((R & ~63) + 4 * (R & 15) + ((R >> 4) & 3)) : R;
        voffA[i] = (unsigned)(Ra * K + C) * 2u; voffB[i] = (unsigned)(Rb * K + C) * 2u; }
    const size_t kstep = (size_t)(BK * 2);
    const size_t hstep = (size_t)HALF * K * 2;
    const size_t tstep = 2 * hstep;
    const unsigned ldsw = (unsigned)wid * 1024u;
    const int aoff = lds_byte(wr * 64 + fr, fq * 8), boff = lds_byte(wc * 32 + fr, fq * 8);
#define PG8_SA(b, h) (((b) * 2 + (h)) * HTB)
#define PG8_SB(b, h) ((4 + (b) * 2 + (h)) * HTB)
#define PG8_STAGE(bufoff, gbase, voff) do { _Pragma("unroll") for (int _i = 0; _i < 2; ++_i) \
        __builtin_amdgcn_global_load_lds((const unsigned*)((const char*)(gbase) + (voff)[_i]), (LAS unsigned*)(lds + (bufoff) + ldsw + _i * 8192), 16, 0, 0); } while (0)
#define PG8_LDA(dst, b, h) do { _Pragma("unroll") for (int m = 0; m < 4; ++m) _Pragma("unroll") for (int k = 0; k < 2; ++k) dst[m][k] = *(const LAS bf16x8*)(lds + PG8_SA(b, h) + aoff + m * 2048 + k * 1024); } while (0)
#define PG8_LDB(dst, b, h) do { _Pragma("unroll") for (int n = 0; n < 2; ++n) _Pragma("unroll") for (int k = 0; k < 2; ++k) dst[n][k] = *(const LAS bf16x8*)(lds + PG8_SB(b, h) + boff + n * 2048 + k * 1024); } while (0)
#define PG8_MMA(ai, bj, At, Bt) do { __builtin_amdgcn_s_setprio(1); _Pragma("unroll") for (int m = 0; m < 4; ++m) _Pragma("unroll") for (int n = 0; n < 2; ++n) _Pragma("unroll") for (int k = 0; k < 2; ++k) \
        acc[ai][bj][m][n] = __builtin_amdgcn_mfma_f32_16x16x32_bf16(Bt[n][k], At[m][k], acc[ai][bj][m][n], 0, 0, 0); __builtin_amdgcn_s_setprio(0); } while (0)
#define PG8_WAIT_V(n) asm volatile("s_waitcnt vmcnt(" #n ")" ::: "memory")
#define PG8_WAIT_L(n) asm volatile("s_waitcnt lgkmcnt(" #n ")" ::: "memory")
#define PG8_BAR __builtin_amdgcn_s_barrier()
#define PG8_SCHED __builtin_amdgcn_sched_barrier(0)
    Unit cur, nxt; int ui = 0;
    if (!S.next(0, cur)) return;
    f32x4 acc[2][2][4][2];
#pragma unroll
    for (int a = 0; a < 2; ++a)
#pragma unroll
        for (int b = 0; b < 2; ++b)
#pragma unroll
            for (int m = 0; m < 4; ++m)
#pragma unroll
                for (int n = 0; n < 2; ++n) acc[a][b][m][n] = (f32x4){0.f, 0.f, 0.f, 0.f};
    bf16x8 At[4][2], B0[2][2], B1[2][2];
    const char* cA = (const char*)g.A + (size_t)(g.a_mode ? up_row0(cur.pm) : cur.pm * BM) * K * 2 + (size_t)cur.kt0 * kstep; const char* cB = (const char*)g.Bt + (size_t)cur.pn * tstep + (size_t)cur.kt0 * kstep;
    S.a_ready(cur);
    auto krot = [](const Unit& u) -> int { return (MK_KROT && !Epi::HAS_MID && u.kind == 0) ? (((((u.pm + 2 * u.pn) & 7) * u.nt) >> 3) & ~1) : 0; };
    int crot = krot(cur);
    { const char* fA = cA + (size_t)crot * kstep; const char* fB = cB + (size_t)crot * kstep;
    if constexpr (SP2) {
        PG8_STAGE(PG8_SB(0, 0), fB, voffB); PG8_STAGE(PG8_SB(0, 1), fB + hstep, voffB); PG8_STAGE(PG8_SA(0, 0), fA, voffA); PG8_STAGE(PG8_SA(0, 1), fA + hstep, voffA);
        if (wr == 1) PG8_BAR;
        PG8_WAIT_V(2); PG8_BAR;
        PG8_STAGE(PG8_SB(1, 0), fB + kstep, voffB); PG8_STAGE(PG8_SA(1, 0), fA + kstep, voffA); PG8_STAGE(PG8_SB(1, 1), fB + hstep + kstep, voffB);
        PG8_WAIT_V(6); PG8_BAR;
    } else {
        PG8_STAGE(PG8_SB(0, 0), fB, voffB); PG8_STAGE(PG8_SA(0, 0), fA, voffA); PG8_STAGE(PG8_SB(0, 1), fB + hstep, voffB); PG8_STAGE(PG8_SA(0, 1), fA + hstep, voffA);
        if (wr == 1) PG8_BAR;
        PG8_WAIT_V(4); PG8_BAR;
        PG8_STAGE(PG8_SB(1, 0), fB + kstep, voffB); PG8_STAGE(PG8_SA(1, 0), fA + kstep, voffA); PG8_STAGE(PG8_SB(1, 1), fB + hstep + kstep, voffB);
        PG8_WAIT_V(6); PG8_BAR;
    } }
    for (;;) {
        const bool has_next = S.next(ui + 1, nxt);
        const char* nA = has_next ? (const char*)g.A + (size_t)(g.a_mode ? up_row0(nxt.pm) : nxt.pm * BM) * K * 2 + (size_t)nxt.kt0 * kstep : cA; const char* nB = has_next ? (const char*)g.Bt + (size_t)nxt.pn * tstep + (size_t)nxt.kt0 * kstep : cB;
        const int nt = cur.nt; const int nrot = has_next ? krot(nxt) : 0;
        for (int t = 0; t < nt; t += 2) {
            const bool last = (t == nt - 2);
            int k1 = crot + t + 1, k2 = crot + t + 2; if (k1 >= nt) k1 -= nt; if (k2 >= nt) k2 -= nt;
            const char* a1 = cA + (size_t)k1 * kstep;
            const char* a2 = last ? nA + (size_t)nrot * kstep : cA + (size_t)k2 * kstep; const char* b2 = last ? nB + (size_t)nrot * kstep : cB + (size_t)k2 * kstep;
            const char* a3 = a2 + kstep; const char* b3 = b2 + kstep;
            if (last && has_next) S.a_ready(nxt);
            if constexpr (Epi::HAS_MID) { if (cur.kind == 0 && t == (nt >> 1)) E.mid(acc, cur, wr, wc, fr, fq); }
            if constexpr (SP2) {
            PG8_LDB(B0, 0, 0); PG8_LDB(B1, 0, 1); PG8_SCHED; PG8_LDA(At, 0, 0); PG8_STAGE(PG8_SA(1, 1), a1 + hstep, voffA);
            PG8_WAIT_V(8); PG8_WAIT_L(0); PG8_BAR; PG8_MMA(0, 0, At, B0); PG8_MMA(0, 1, At, B1); PG8_BAR; PG8_SCHED;
            PG8_LDA(At, 0, 1); PG8_STAGE(PG8_SB(0, 0), b2, voffB); PG8_STAGE(PG8_SB(0, 1), b2 + hstep, voffB); PG8_STAGE(PG8_SA(0, 0), a2, voffA);
            PG8_WAIT_V(8); PG8_WAIT_L(0); PG8_BAR; PG8_MMA(1, 0, At, B0); PG8_MMA(1, 1, At, B1); PG8_BAR; PG8_SCHED;
            PG8_LDB(B0, 1, 0); PG8_LDB(B1, 1, 1); PG8_SCHED; PG8_LDA(At, 1, 0); PG8_STAGE(PG8_SA(0, 1), a2 + hstep, voffA);
            PG8_WAIT_V(8); PG8_WAIT_L(0); PG8_BAR; PG8_MMA(0, 0, At, B0); PG8_MMA(0, 1, At, B1); PG8_BAR; PG8_SCHED;
            PG8_LDA(At, 1, 1); PG8_STAGE(PG8_SB(1, 0), b3, voffB); PG8_STAGE(PG8_SB(1, 1), b3 + hstep, voffB); PG8_STAGE(PG8_SA(1, 0), a3, voffA);
            PG8_WAIT_V(8); PG8_WAIT_L(0); PG8_BAR; PG8_MMA(1, 0, At, B0); PG8_MMA(1, 1, At, B1); PG8_BAR; PG8_SCHED;
            } else {
            PG8_LDB(B0, 0, 0); PG8_SCHED; PG8_LDA(At, 0, 0); PG8_STAGE(PG8_SA(1, 1), a1 + hstep, voffA);
            PG8_WAIT_L(8); PG8_BAR; PG8_WAIT_L(0); PG8_MMA(0, 0, At, B0); PG8_BAR; PG8_SCHED;
            PG8_LDB(B1, 0, 1); PG8_STAGE(PG8_SB(0, 0), b2, voffB);
            PG8_BAR; PG8_WAIT_L(0); PG8_MMA(0, 1, At, B1); PG8_BAR;
            PG8_LDA(At, 0, 1); PG8_STAGE(PG8_SA(0, 0), a2, voffA);
            PG8_BAR; PG8_WAIT_L(0); PG8_MMA(1, 0, At, B0); PG8_BAR; PG8_SCHED;
            PG8_STAGE(PG8_SB(0, 1), b2 + hstep, voffB);
            PG8_WAIT_V(6); PG8_BAR; PG8_MMA(1, 1, At, B1); PG8_BAR;
            PG8_LDB(B0, 1, 0); PG8_SCHED; PG8_LDA(At, 1, 0); PG8_STAGE(PG8_SA(0, 1), a2 + hstep, voffA);
            PG8_WAIT_L(8); PG8_BAR; PG8_WAIT_L(0); PG8_MMA(0, 0, At, B0); PG8_BAR; PG8_SCHED;
            PG8_LDB(B1, 1, 1); PG8_STAGE(PG8_SB(1, 0), b3, voffB);
            PG8_BAR; PG8_WAIT_L(0); PG8_MMA(0, 1, At, B1); PG8_BAR;
            PG8_LDA(At, 1, 1); PG8_STAGE(PG8_SA(1, 0), a3, voffA);
            PG8_BAR; PG8_WAIT_L(0); PG8_MMA(1, 0, At, B0); PG8_BAR; PG8_SCHED;
            PG8_STAGE(PG8_SB(1, 1), b3 + hstep, voffB);
            PG8_WAIT_V(6); PG8_BAR; PG8_MMA(1, 1, At, B1); PG8_BAR;
            }
        }
        if constexpr (ALIGN_EPI) { if (wr == 0) PG8_BAR; }
        if constexpr (Epi::TAIL_REDUCE) {
            if (cur.kind == 1) {
                const int tix = cur.slot / E.S, sl = cur.slot - tix * E.S; LAS unsigned* bw = (LAS unsigned*)(lds + STAGE_BYTES + 8192);
                { const __amdgpu_buffer_rsrc_t rs = __builtin_amdgcn_make_buffer_rsrc(E.PART, 0, 0x7fffffff, 0x00020000); const unsigned base = ((unsigned)cur.slot * 8192u + (unsigned)tid) * 16u;
#pragma unroll
                  for (int a = 0; a < 2; ++a)
#pragma unroll
                      for (int b = 0; b < 2; ++b)
#pragma unroll
                          for (int m = 0; m < 4; ++m) { const f32x4 a0 = acc[a][b][m][0], a1 = acc[a][b][m][1];
                              u32x4 w; w.x = cvt_pk_bf16(a0[0], a0[1]); w.y = cvt_pk_bf16(a0[2], a0[3]); w.z = cvt_pk_bf16(a1[0], a1[1]); w.w = cvt_pk_bf16(a1[2], a1[3]);
                              __builtin_amdgcn_raw_buffer_store_b128(w, rs, base + (unsigned)(((a * 2 + b) * 4 + m) * 512 * 16), 0, 16); } }
                asm volatile("s_waitcnt vmcnt(0)" ::: "memory"); PG8_BAR; asm volatile("" ::: "memory");
                if (tid == 0) { (void)__hip_atomic_fetch_add(E.tcnt + tix, 1u, __ATOMIC_RELAXED, __HIP_MEMORY_SCOPE_AGENT);
                    unsigned sp = 0; while (__hip_atomic_load(E.tcnt + tix, __ATOMIC_RELAXED, __HIP_MEMORY_SCOPE_AGENT) < (unsigned)E.S) { __builtin_amdgcn_s_sleep(2); if (++sp > (1u << 22)) break; }
                    __builtin_amdgcn_fence(__ATOMIC_ACQUIRE, "agent"); }
                asm volatile("s_waitcnt vmcnt(0) lgkmcnt(0)" ::: "memory"); PG8_BAR; asm volatile("" ::: "memory");
                __builtin_amdgcn_fence(__ATOMIC_ACQUIRE, "agent"); asm volatile("s_waitcnt vmcnt(0)" ::: "memory");
                const int per = 32 / E.S, i0 = sl * per, sa_ = i0 >> 4, sb_ = (i0 >> 3) & 1, m0 = (i0 >> 1) & 3, nm = per >> 1;
                f32x4 sA[4][2], sB[4][2];
#pragma unroll
                for (int mi = 0; mi < 4; ++mi)
#pragma unroll
                    for (int n = 0; n < 2; ++n) { sA[mi][n] = (f32x4){0.f, 0.f, 0.f, 0.f}; sB[mi][n] = (f32x4){0.f, 0.f, 0.f, 0.f}; }
#pragma unroll 1
                for (int s2 = 0; s2 < E.S; ++s2) {
                    const u32x4* pp = (const u32x4*)((const char*)E.PART + (size_t)(tix * E.S + s2) * 131072) + tid + (i0 >> 1) * 512; f32x4 tq[4][2];
#pragma unroll
                    for (int mi = 0; mi < 4; ++mi) { u32x4 pw = {0u, 0u, 0u, 0u}; if (mi < nm) pw = pp[mi * 512];
                        tq[mi][0] = (f32x4){__builtin_bit_cast(float, pw.x << 16), __builtin_bit_cast(float, pw.x & 0xffff0000u), __builtin_bit_cast(float, pw.y << 16), __builtin_bit_cast(float, pw.y & 0xffff0000u)};
                        tq[mi][1] = (f32x4){__builtin_bit_cast(float, pw.z << 16), __builtin_bit_cast(float, pw.z & 0xffff0000u), __builtin_bit_cast(float, pw.w << 16), __builtin_bit_cast(float, pw.w & 0xffff0000u)}; }
                    const bool second = Epi::HAS_MID && (s2 >= (E.S >> 1));
#pragma unroll
                    for (int mi = 0; mi < 4; ++mi)
#pragma unroll
                        for (int n = 0; n < 2; ++n) { if (second) sB[mi][n] += tq[mi][n]; else sA[mi][n] += tq[mi][n]; } }
                E.strip(sA, sB, cur, wr, wc, fr, fq, sa_, sb_, m0, nm);
            } else E(acc, cur, wr, wc, fr, fq);
        } else E(acc, cur, wr, wc, fr, fq);
        S.done(cur);
        if (!has_next) break;
#pragma unroll
        for (int a = 0; a < 2; ++a)
#pragma unroll
            for (int b = 0; b < 2; ++b)
#pragma unroll
                for (int m = 0; m < 4; ++m)
#pragma unroll
                    for (int n = 0; n < 2; ++n) acc[a][b][m][n] = (f32x4){0.f, 0.f, 0.f, 0.f};
        cur = nxt; cA = nA; cB = nB; crot = nrot; ++ui;
        if constexpr (ALIGN_EPI) { if (wr == 1) PG8_BAR; }
    }
    PG8_WAIT_V(0);
    if constexpr (!ALIGN_EPI) { if (wr == 0) PG8_BAR; }
    PG8_BAR;
#undef PG8_SA
#undef PG8_SB
#undef PG8_STAGE
#undef PG8_LDA
#undef PG8_LDB
#undef PG8_MMA
#undef PG8_WAIT_V
#undef PG8_WAIT_L
#undef PG8_BAR
#undef PG8_SCHED
}
}

constexpr int LDS_BYTES = 159744;
constexpr int NTHREADS = 512;

__device__ __forceinline__ void tr_item(const float* W, int ldw, int k0, int ns0, bf16_t* WT, int ldt, int nd0, int kd0, const float* kscale, float cs, LAS float* scr, int lane) {
    float wv_[32];
#pragma unroll
    for (int i = 0; i < 32; ++i) wv_[i] = W[(size_t)(k0 + 2 * i + (lane >> 5)) * ldw + ns0 + (lane & 31)];
#pragma unroll
    for (int i = 0; i < 32; ++i) { const int kk = 2 * i + (lane >> 5); const float s = kscale ? kscale[k0 + kk] * cs : cs; scr[kk * 33 + (lane & 31)] = wv_[i] * s; }
    asm volatile("s_waitcnt lgkmcnt(0)" ::: "memory");
    const int c = lane & 7;
#pragma unroll
    for (int j = 0; j < 4; ++j) { const int n = (lane >> 3) + 8 * j; const LAS float* s = scr + (8 * c) * 33 + n;
        u32x4 o; o.x = pk2(s[0 * 33], s[1 * 33]); o.y = pk2(s[2 * 33], s[3 * 33]); o.z = pk2(s[4 * 33], s[5 * 33]); o.w = pk2(s[6 * 33], s[7 * 33]);
        *(u32x4*)(WT + (size_t)(nd0 + n) * ldt + kd0 + k0 + 8 * c) = o; }
    asm volatile("s_waitcnt lgkmcnt(0)" ::: "memory");
}
__device__ __forceinline__ void phase_prep(const P& p, LAS unsigned char* lds, int bid, int nb, int wv) {
    const int tid = opaque_tid(wv), lane = tid & 63, wave = tid >> 6;
    unsigned char* ws = p.ws;
    LAS float* scr = (LAS float*)(lds + wave * 8448);
    LAS float* wg = (LAS float*)(lds + 8 * 8448);
    const float* w_in = p.in[I_WIN];
    for (int i = tid; i < 8192; i += NTHREADS) { const int k = i >> 3, j = i & 7; wg[j * 1024 + k] = w_in[(size_t)k * NIN + 5120 + j]; }
    __syncthreads();
    const int gw = wave * nb + bid, NGW = nb * 8;
    constexpr int I_IN = 16 * 224;
    for (int it = gw; it < I_IN; it += NGW) { const int kb = it / 224, nbk = it % 224, n0 = nbk * 32; const int ns0 = n0 + (n0 >= 5120 ? 8 : 0); const float cs = (n0 >= ZC_Q && n0 < ZC_K) ? 0.0625f : 1.0f;
        tr_item(w_in, NIN, kb * 64, ns0, (bf16_t*)(ws + WS_WIN), 1024, n0, 0, nullptr, cs, scr, lane); }
    { bf16_t* WL = (bf16_t*)(ws + WS_WLRU);
      for (int e = bid * NTHREADS + tid; e < 2 * 65536; e += nb * NTHREADS) { const int gate = e >> 16, n = (e >> 12) & 15, d = (e >> 6) & 63, c = e & 63;
          WL[e] = (bf16_t)f2bf((gate ? p.in[I_LWI] : p.in[I_LWR])[(size_t)(n * 64 + c) * 64 + d]); }
    }
    { float* ssq = (float*)(ws + WS_SSQ); for (int i = bid * NTHREADS + tid; i < MPAD; i += nb * NTHREADS) ssq[i] = 0.f; }
    { float* bias1 = (float*)(ws + WS_SMALL); const float* b_in = p.in[I_BIN];
      for (int n = bid * NTHREADS + tid; n < NZ; n += nb * NTHREADS) { const float cs = (n >= ZC_Q && n < ZC_K) ? 0.0625f : 1.0f; bias1[n] = b_in[n + (n >= 5120 ? 8 : 0)] * cs; } }
    { bf16_t* XN = (bf16_t*)(ws + WS_XN); float* gates = (float*)(ws + WS_SMALL + 65536); const float* g1 = p.in[I_G1]; const float* b_in = p.in[I_BIN];
      f32x4 vn[4];
      if (gw < MTOK) { const f32x4* xr = (const f32x4*)xrow_ptr(p, gw) + lane;
#pragma unroll
          for (int j = 0; j < 4; ++j) vn[j] = xr[64 * j]; }
      for (int m = gw; m < MTOK; m += NGW) {
          f32x4 v[4]; float s = 0.f;
#pragma unroll
          for (int j = 0; j < 4; ++j) v[j] = vn[j];
          if (m + NGW < MTOK) { const f32x4* xr = (const f32x4*)xrow_ptr(p, m + NGW) + lane;
#pragma unroll
              for (int j = 0; j < 4; ++j) vn[j] = xr[64 * j]; }
#pragma unroll
          for (int j = 0; j < 4; ++j) s += (v[j].x * v[j].x + v[j].y * v[j].y) + (v[j].z * v[j].z + v[j].w * v[j].w);
          const float rstd = 1.0f / sqrtf(wave_sum(s) * (1.0f / D) + EPS);
          unsigned long long* o8 = (unsigned long long*)(XN + (size_t)m * D) + lane;
          float ga[8];
#pragma unroll
          for (int q = 0; q < 8; ++q) ga[q] = 0.f;
#pragma unroll
          for (int j = 0; j < 4; ++j) { const f32x4 gg = ((const f32x4*)g1)[lane + 64 * j]; v[j] = v[j] * rstd * gg;
              o8[64 * j] = (unsigned long long)pk2(v[j].x, v[j].y) | ((unsigned long long)pk2(v[j].z, v[j].w) << 32);
#pragma unroll
              for (int q = 0; q < 8; ++q) { const f32x4 w = *(const LAS f32x4*)(wg + q * 1024 + 4 * (lane + 64 * j)); ga[q] += (v[j].x * w.x + v[j].y * w.y) + (v[j].z * w.z + v[j].w * w.w); } }
#pragma unroll
          for (int q = 0; q < 8; ++q) ga[q] = wave_sum(ga[q]);
          if (lane < 8) { float r = ga[0];
#pragma unroll
              for (int q = 1; q < 8; ++q) r = (lane == q) ? ga[q] : r;
              gates[(size_t)m * 8 + lane] = r + b_in[5120 + lane]; }
      } }
}

__device__ __forceinline__ void lru_load8(const bf16_t* Z, const float* st, int row0, int L, int tok, int ch, float (&o)[8]) {
    if (tok >= 0) { const int tc = tok < L ? tok : L - 1; const u32x4 w = *(const u32x4*)(Z + (size_t)(row0 + tc) * NZ + ZC_U + ch);
        o[0] = bflo(w.x); o[1] = bfhi(w.x); o[2] = bflo(w.y); o[3] = bfhi(w.y); o[4] = bflo(w.z); o[5] = bfhi(w.z); o[6] = bflo(w.w); o[7] = bfhi(w.w); }
    else if (st) { const f32x4 a = *(const f32x4*)(st + (size_t)(3 + tok) * D + ch), b = *(const f32x4*)(st + (size_t)(3 + tok) * D + ch + 4);
        o[0] = a.x; o[1] = a.y; o[2] = a.z; o[3] = a.w; o[4] = b.x; o[5] = b.y; o[6] = b.z; o[7] = b.w; }
    else {
#pragma unroll
        for (int q = 0; q < 8; ++q) o[q] = 0.f; }
}
__device__ __forceinline__ void phase_lru(const P& p, LAS unsigned char* lds, int bid, int nb, int wv, int it_lo, int it_hi) {
    const int tid = opaque_tid(wv), lane = tid & 63, w = __builtin_amdgcn_readfirstlane(tid >> 6), g = lane >> 4, li = lane & 15;
    const bf16_t* Z = (const bf16_t*)(p.ws + WS_Z); bf16_t* ACAT = (bf16_t*)(p.ws + WS_ACAT); bf16_t* PCUM = (bf16_t*)(p.ws + WS_PCUM);
    float* AGG = (float*)(p.ws + WS_AGG); float* CARRY = (float*)(p.ws + WS_CARRY); const bf16_t* WL = (const bf16_t*)(p.ws + WS_WLRU); unsigned* cnt = (unsigned*)(p.ws + WS_CTL);
    LAS float* cwL = (LAS float*)(lds + w * 6400);
    LAS float* ucL = cwL + 320;
    LAS float* gbL = cwL + 1408;
    const int n = bid & 15;
    LAS unsigned char* wls = lds + 8 * 6400;
    for (int i = tid; i < 1024; i += NTHREADS) { const int row = i >> 3, ch8 = i & 7; *(LAS u32x4*)(wls + row * 144 + ch8 * 16) = *(const u32x4*)(WL + (size_t)((row >> 6) * 16 + n) * 4096 + (row & 63) * 64 + ch8 * 8); }
    __syncthreads();
    constexpr int NPI = NBP * NSEGP, NIT = NPI + DECB;
    const int nwv = (nb >> 4) * 8;
    for (int it = it_lo + (bid >> 4) * 8 + w; it < (it_hi < NIT ? it_hi : NIT); it += nwv) {
        int s, seg;
        constexpr int NFULL = NBP * (NSEGP - 1);
        if (it < NFULL) { seg = it % (NSEGP - 1); s = it / (NSEGP - 1); } else if (it < NPI) { s = it - NFULL; seg = NSEGP - 1; } else { s = NBP + (it - NPI); seg = 0; }
        int row0, L; seq_info(s, row0, L);
        const int tb = seg * LSEG, te = (tb + LSEG < L) ? tb + LSEG : L, ntile = (te - tb + 15) >> 4;
        const float* st = (s >= NBP) ? p.in[I_SLC] + (size_t)(s - NBP) * 3 * D : nullptr;
        { const int ch = n * 64 + lane; cwL[lane] = p.in[I_LCW][ch]; cwL[64 + lane] = p.in[I_LCW][D + ch]; cwL[128 + lane] = p.in[I_LCW][2 * D + ch]; cwL[192 + lane] = p.in[I_LCW][3 * D + ch]; cwL[256 + lane] = p.in[I_LCB][ch]; }
        { const int ch = n * 64 + lane; const float lam = p.in[I_LAM][ch]; gbL[lane] = p.in[I_LBR][ch]; gbL[64 + lane] = p.in[I_LBI][ch]; gbL[128 + lane] = 8.0f * (fmaxf(-lam, 0.f) + log1pf(__expf(-fabsf(lam)))); }
        float hc[4], pc[4];
#pragma unroll
        for (int q = 0; q < 4; ++q) { const int ch = n * 64 + 16 * q + li; hc[q] = (s >= NBP) ? p.in[I_SLH][(size_t)(s - NBP) * D + ch] : 0.f; pc[q] = 1.f; }
        const int cA = n * 64 + 8 * g, cB = cA + 32;
        u32x4 rwa[4], rwb[4];
#define LRU_LOADRAW(tt0_) do { _Pragma("unroll") for (int d = 0; d < 4; ++d) { int tok = (tt0_) + li - 3 + d; tok = tok < 0 ? 0 : (tok < L ? tok : L - 1); \
            const bf16_t* zr = Z + (size_t)(row0 + tok) * NZ + ZC_U; rwa[d] = *(const u32x4*)(zr + cA); rwb[d] = *(const u32x4*)(zr + cB); } } while (0)
        LRU_LOADRAW(tb);
        for (int tile = 0; tile < ntile; ++tile) {
            const int tt0 = tb + tile * 16, t = tt0 + li;
            float ucA[8], ucB[8];
            { const f32x4 b0 = *(const LAS f32x4*)(cwL + 256 + 8 * g), b1 = *(const LAS f32x4*)(cwL + 256 + 8 * g + 4), b2 = *(const LAS f32x4*)(cwL + 256 + 32 + 8 * g), b3 = *(const LAS f32x4*)(cwL + 256 + 32 + 8 * g + 4);
              ucA[0] = b0.x; ucA[1] = b0.y; ucA[2] = b0.z; ucA[3] = b0.w; ucA[4] = b1.x; ucA[5] = b1.y; ucA[6] = b1.z; ucA[7] = b1.w;
              ucB[0] = b2.x; ucB[1] = b2.y; ucB[2] = b2.z; ucB[3] = b2.w; ucB[4] = b3.x; ucB[5] = b3.y; ucB[6] = b3.z; ucB[7] = b3.w; }
#pragma unroll
            for (int d = 0; d < 4; ++d) { float ua[8], ub[8]; unpack8(rwa[d], ua); unpack8(rwb[d], ub);
                if (tt0 == 0 && t - 3 + d < 0) { lru_load8(Z, st, row0, L, t - 3 + d, cA, ua); lru_load8(Z, st, row0, L, t - 3 + d, cB, ub); }
                const f32x4 w0 = *(const LAS f32x4*)(cwL + d * 64 + 8 * g), w1 = *(const LAS f32x4*)(cwL + d * 64 + 8 * g + 4), w2 = *(const LAS f32x4*)(cwL + d * 64 + 32 + 8 * g), w3 = *(const LAS f32x4*)(cwL + d * 64 + 32 + 8 * g + 4);
                ucA[0] += w0.x * ua[0]; ucA[1] += w0.y * ua[1]; ucA[2] += w0.z * ua[2]; ucA[3] += w0.w * ua[3]; ucA[4] += w1.x * ua[4]; ucA[5] += w1.y * ua[5]; ucA[6] += w1.z * ua[6]; ucA[7] += w1.w * ua[7];
                ucB[0] += w2.x * ub[0]; ucB[1] += w2.y * ub[1]; ucB[2] += w2.z * ub[2]; ucB[3] += w2.w * ub[3]; ucB[4] += w3.x * ub[4]; ucB[5] += w3.y * ub[5]; ucB[6] += w3.z * ub[6]; ucB[7] += w3.w * ub[7]; }
            if (tile + 1 < ntile) LRU_LOADRAW(tt0 + 16);
            *(LAS f32x4*)(ucL + li * 68 + 8 * g) = (f32x4){ucA[0], ucA[1], ucA[2], ucA[3]}; *(LAS f32x4*)(ucL + li * 68 + 8 * g + 4) = (f32x4){ucA[4], ucA[5], ucA[6], ucA[7]};
            *(LAS f32x4*)(ucL + li * 68 + 32 + 8 * g) = (f32x4){ucB[0], ucB[1], ucB[2], ucB[3]}; *(LAS f32x4*)(ucL + li * 68 + 32 + 8 * g + 4) = (f32x4){ucB[4], ucB[5], ucB[6], ucB[7]};
            bf16x8 af[2];
            { u32x4 a0, a1; a0.x = pk2(ucA[0], ucA[1]); a0.y = pk2(ucA[2], ucA[3]); a0.z = pk2(ucA[4], ucA[5]); a0.w = pk2(ucA[6], ucA[7]);
              a1.x = pk2(ucB[0], ucB[1]); a1.y = pk2(ucB[2], ucB[3]); a1.z = pk2(ucB[4], ucB[5]); a1.w = pk2(ucB[6], ucB[7]);
              af[0] = __builtin_bit_cast(bf16x8, a0); af[1] = __builtin_bit_cast(bf16x8, a1); }
            f32x4 ra[4], ia[4];
#pragma unroll
            for (int q = 0; q < 4; ++q) { ra[q] = (f32x4){0.f, 0.f, 0.f, 0.f}; ia[q] = (f32x4){0.f, 0.f, 0.f, 0.f};
#pragma unroll
                for (int k = 0; k < 2; ++k) { const bf16x8 wr0 = *(const LAS bf16x8*)(wls + (16 * q + li) * 144 + (32 * k + 8 * g) * 2), wi0 = *(const LAS bf16x8*)(wls + (64 + 16 * q + li) * 144 + (32 * k + 8 * g) * 2);
                    ra[q] = __builtin_amdgcn_mfma_f32_16x16x32_bf16(af[k], wr0, ra[q], 0, 0, 0); ia[q] = __builtin_amdgcn_mfma_f32_16x16x32_bf16(af[k], wi0, ia[q], 0, 0, 0); } }
            asm volatile("s_waitcnt lgkmcnt(0)" ::: "memory");
#pragma unroll
            for (int q = 0; q < 4; ++q) {
                const float brq = gbL[16 * q + li], biq = gbL[64 + 16 * q + li], sp8q = gbL[128 + 16 * q + li];
                float av[4], hv[4], pv[4];
                {
                    constexpr float L2E = 1.4426950408889634f;
                    const f32x4 uc4 = {ucL[(4 * g + 0) * 68 + 16 * q + li], ucL[(4 * g + 1) * 68 + 16 * q + li], ucL[(4 * g + 2) * 68 + 16 * q + li], ucL[(4 * g + 3) * 68 + 16 * q + li]};
                    const f32x4 xr = (ra[q] + brq) * (-L2E), xi = (ia[q] + biq) * (-L2E);
                    const f32x4 dr = (f32x4){__builtin_amdgcn_exp2f(xr[0]), __builtin_amdgcn_exp2f(xr[1]), __builtin_amdgcn_exp2f(xr[2]), __builtin_amdgcn_exp2f(xr[3])} + 1.0f;
                    const f32x4 di = (f32x4){__builtin_amdgcn_exp2f(xi[0]), __builtin_amdgcn_exp2f(xi[1]), __builtin_amdgcn_exp2f(xi[2]), __builtin_amdgcn_exp2f(xi[3])} + 1.0f;
                    const f32x4 rg = {__builtin_amdgcn_rcpf(dr[0]), __builtin_amdgcn_rcpf(dr[1]), __builtin_amdgcn_rcpf(dr[2]), __builtin_amdgcn_rcpf(dr[3])};
                    const f32x4 ig = {__builtin_amdgcn_rcpf(di[0]), __builtin_amdgcn_rcpf(di[1]), __builtin_amdgcn_rcpf(di[2]), __builtin_amdgcn_rcpf(di[3])};
                    const f32x4 la = rg * (-sp8q), y = la + la, le = la * L2E;
                    const f32x4 a4 = {__builtin_amdgcn_exp2f(le[0]), __builtin_amdgcn_exp2f(le[1]), __builtin_amdgcn_exp2f(le[2]), __builtin_amdgcn_exp2f(le[3])};
                    const f32x4 ser = (0.0f - y) * (1.0f + y * (0.5f + y * (0.16666667f + y * (0.041666668f + y * 0.0083333338f)))), dir = 1.0f - a4 * a4;
                    const f32x4 iu = ig * uc4;
#pragma unroll
                    for (int r = 0; r < 4; ++r) { const float om = (y[r] > -0.125f) ? ser[r] : dir[r]; float a = a4[r], inp = __builtin_amdgcn_sqrtf(om) * iu[r];
                        if (tt0 + 4 * g + r >= te) { a = 1.f; inp = 0.f; }
                        av[r] = a; hv[r] = inp; } }
                pv[0] = av[0];
#pragma unroll
                for (int r = 1; r < 4; ++r) { hv[r] = av[r] * hv[r - 1] + hv[r]; pv[r] = av[r] * pv[r - 1]; }
                float Pg[4], Hg[4];
#pragma unroll
                for (int x = 0; x < 4; ++x) { Pg[x] = __shfl(pv[3], li + 16 * x); Hg[x] = __shfl(hv[3], li + 16 * x); }
                float cin = hc[q], pin = pc[q], mycin = cin, mypin = pin;
#pragma unroll
                for (int x = 0; x < 4; ++x) { cin = Hg[x] + Pg[x] * cin; pin = Pg[x] * pin; if (g == x + 1) { mycin = cin; mypin = pin; } }
                hc[q] = cin; pc[q] = pin;
                { const unsigned ao = ((unsigned)(row0 + tt0 + 4 * g) * 2048u + (unsigned)(n * 64 + li)) * 2u, po = ((unsigned)(row0 + tt0 + 4 * g) * (unsigned)D + (unsigned)(n * 64 + li)) * 2u;
                  if (tt0 + 16 <= te) {
#pragma unroll
                      for (int r = 0; r < 4; ++r) { *(bf16_t*)((char*)ACAT + (ao + (unsigned)(r * 4096 + q * 32))) = (bf16_t)f2bf(hv[r] + pv[r] * mycin);
                          if (seg > 0) *((unsigned char*)PCUM + ((po >> 1) + (unsigned)(r * D + q * 16))) = (unsigned char)q8(pv[r] * mypin, 0u); }
                  } else {
#pragma unroll
                      for (int r = 0; r < 4; ++r) { if (tt0 + 4 * g + r < te) { *(bf16_t*)((char*)ACAT + (ao + (unsigned)(r * 4096 + q * 32))) = (bf16_t)f2bf(hv[r] + pv[r] * mycin);
                          if (seg > 0) *((unsigned char*)PCUM + ((po >> 1) + (unsigned)(r * D + q * 16))) = (unsigned char)q8(pv[r] * mypin, 0u); } } } }
            }
        }
        const int lane = lane_id_volatile(), g = lane >> 4, li = lane & 15;
        if (te == L) { float* oc = (s < NBP) ? p.out + O_PLC + (size_t)s * 3 * D : p.out + O_SLC + (size_t)(s - NBP) * 3 * D; const int ch = n * 64 + lane;
#pragma unroll
            for (int i = 0; i < 3; ++i) oc[(size_t)i * D + ch] = bf2f(Z[(size_t)(row0 + L - 3 + i) * NZ + ZC_U + ch]); }
        if (s >= NBP) { if (g == 0) {
#pragma unroll
            for (int q = 0; q < 4; ++q) p.out[O_SLH + (size_t)(s - NBP) * D + n * 64 + 16 * q + li] = hc[q]; } }
        else {
            if (g == 0) {
#pragma unroll
                for (int q = 0; q < 4; ++q) { float* ag = AGG + ((size_t)(s * NSEGP + seg) * D + n * 64 + 16 * q + li) * 2;
                    __hip_atomic_store(ag, pc[q], __ATOMIC_RELAXED, __HIP_MEMORY_SCOPE_AGENT); __hip_atomic_store(ag + 1, hc[q], __ATOMIC_RELAXED, __HIP_MEMORY_SCOPE_AGENT); } }
            asm volatile("s_waitcnt vmcnt(0)" ::: "memory");
            unsigned old = 0; if (lane == 0) old = __hip_atomic_fetch_add(cnt + s * 16 + n, 1u, __ATOMIC_RELAXED, __HIP_MEMORY_SCOPE_AGENT);
            old = (unsigned)__builtin_amdgcn_readfirstlane((int)old);
            if (old == NSEGP - 1) {
                __builtin_amdgcn_fence(__ATOMIC_ACQUIRE, "agent");
                const int ch = n * 64 + lane; const float* ag0 = AGG + ((size_t)(s * NSEGP) * D + ch) * 2;
                float Pv[NSEGP], Ev[NSEGP];
#pragma unroll
                for (int sg = 0; sg < NSEGP; ++sg) { Pv[sg] = __hip_atomic_load(ag0 + (size_t)sg * D * 2, __ATOMIC_RELAXED, __HIP_MEMORY_SCOPE_AGENT); Ev[sg] = __hip_atomic_load(ag0 + (size_t)sg * D * 2 + 1, __ATOMIC_RELAXED, __HIP_MEMORY_SCOPE_AGENT); }
                float c = 0.f;
#pragma unroll
                for (int sg = 0; sg < NSEGP; ++sg) { CARRY[(size_t)(s * NSEGP + sg) * D + ch] = c; c = Ev[sg] + Pv[sg] * c; }
                p.out[O_PLH + (size_t)s * D + ch] = c; }
        }
        asm volatile("s_waitcnt lgkmcnt(0)" ::: "memory");
    }
#undef LRU_LOADRAW
}

constexpr int ML_RS = 528, ML_VS = 144;
constexpr int ML_Q = 0, ML_K = 33792, ML_CT = 67584, ML_VT = 101376, ML_WV = 110592, ML_SW = 119808, ML_N = 129024, ML_GA = 130048, ML_QN = 131328, ML_DEN = 131584, ML_SC = 132096;
typedef short v4s __attribute__((ext_vector_type(4)));
__device__ __forceinline__ int vt_off(int R, int gi) { return R * ML_VS + ((gi ^ ((R >> 3) & 7)) << 4); }
__device__ __forceinline__ float scan_sum64(float x, int lane) {
#pragma unroll
    for (int o = 1; o < 64; o <<= 1) { const float t = __shfl_up(x, o); if (lane >= o) x += t; }
    return x;
}
__device__ __forceinline__ float scan_max64(float x, int lane) {
#pragma unroll
    for (int o = 1; o < 64; o <<= 1) { const float t = __shfl_up(x, o); if (lane >= o) x = fmaxf(x, t); }
    return x;
}
constexpr int ML_AL = 132160, ML_BL = ML_AL + 8448, ML_ML = ML_BL + 8448, ML_NT = ML_ML + 8448;
__device__ __forceinline__ void phase_mlstm(const P& p, LAS unsigned char* lds, int bid, int nb, int wv) {
    const int tid = opaque_tid(wv), lane = tid & 63, w = __builtin_amdgcn_readfirstlane(tid >> 6), g = lane >> 4, li = lane & 15;
    const bf16_t* Z = (const bf16_t*)(p.ws + WS_Z); bf16_t* ACAT = (bf16_t*)(p.ws + WS_ACAT); const float* gates = (const float*)(p.ws + WS_SMALL + 65536);
    LAS float* nL = (LAS float*)(lds + ML_N); LAS float* wkL = (LAS float*)(lds + ML_GA); LAS float* totL = wkL + 64; LAS float* cmxL = wkL + 128;
    LAS float* qnL = (LAS float*)(lds + ML_QN); LAS float* denL = (LAS float*)(lds + ML_DEN);
    LAS float* aL = (LAS float*)(lds + ML_AL); LAS float* BL = (LAS float*)(lds + ML_BL); LAS float* ML_ = (LAS float*)(lds + ML_ML);
    for (int it = bid; it < NBP * 16; it += nb) {
        const int lane = lane_id_volatile(), tid = w * 64 + lane, g = lane >> 4, li = lane & 15;
        const int sh = (it & 7) + 8 * (it >> 5), s = sh >> 2, hh = sh & 3, j = (it >> 3) & 3;
        int row0, L; seq_info(s, row0, L);
        const int nch = (L + 63) >> 6;
        const float m0 = 0.f;
        f32x4 cacc[2][4], nacc[2];
#pragma unroll
        for (int di = 0; di < 2; ++di) { nacc[di] = (f32x4){0.f, 0.f, 0.f, 0.f};
#pragma unroll
            for (int vi = 0; vi < 4; ++vi) cacc[di][vi] = (f32x4){0.f, 0.f, 0.f, 0.f}; }
        {
#pragma unroll 1
          for (int c = w; c < nch; c += 8) { const int t = c * 64 + lane; const bool valid = t < L; const float* gr = gates + (size_t)(row0 + t) * 8 + hh;
              const float lf = valid ? logsigmoidf_(gr[4]) : 0.f; const float sl = scan_sum64(lf, lane); aL[t] = valid ? gr[0] : -INFINITY; BL[t] = sl; if (lane == 63) totL[c] = sl; }
          __syncthreads();
          { const float x = (lane < nch) ? totL[lane] : 0.f; const float inc = scan_sum64(x, lane);
#pragma unroll 1
            for (int c = w; c < nch; c += 8) { const int t = c * 64 + lane; const float boff = (c > 0) ? __shfl(inc, c - 1) : 0.f; const float Bt = boff + BL[t]; const float a = aL[t] - Bt;
                const float ml = scan_max64(a, lane); aL[t] = a; BL[t] = Bt; ML_[t] = ml; if (lane == 63) cmxL[c] = ml; } }
          __syncthreads();
          { const float x = (lane < nch) ? cmxL[lane] : -INFINITY; const float pm = scan_max64(x, lane);
#pragma unroll 1
            for (int c = w; c < nch; c += 8) { const int t = c * 64 + lane; const float mp = (c > 0) ? fmaxf(m0, __shfl(pm, c - 1)) : m0; ML_[t] = fmaxf(mp, ML_[t]); } }
        }
        u32x4 pq[4], pk[4], pv;
#define ML_LOAD(t0_) do { const int t0__ = (t0_); \
            _Pragma("unroll") for (int i = 0; i < 4; ++i) { const int id = tid + 512 * i, rr = id >> 5, ch = id & 31; const bf16_t* zr = Z + (size_t)(row0 + t0__ + rr) * NZ + hh * DH + ch * 8; \
                pq[i] = *(const u32x4*)(zr + ZC_Q); pk[i] = *(const u32x4*)(zr + ZC_K); } \
            { const int rr = tid >> 3, ch = tid & 7; pv = *(const u32x4*)(Z + (size_t)(row0 + t0__ + rr) * NZ + ZC_V + hh * DH + j * 64 + ch * 8); } } while (0)
        ML_LOAD(0);
        for (int c = 0; c < nch; ++c) {
            const int t0 = c * 64;
            int tid_c = tid; asm volatile("" : "+v"(tid_c));
            const int tid = tid_c, lane = tid & 63, g = lane >> 4, li = lane & 15;
#pragma unroll
            for (int i = 0; i < 4; ++i) { const int id = tid + 512 * i, rr = id >> 5, ch = id & 31;
                *(LAS u32x4*)(lds + ML_Q + rr * ML_RS + ch * 16) = pq[i]; *(LAS u32x4*)(lds + ML_K + rr * ML_RS + ch * 16) = pk[i]; }
            { const int rr = tid >> 3, ch = tid & 7; const unsigned vw[4] = {pv.x, pv.y, pv.z, pv.w};
#pragma unroll
                for (int q = 0; q < 4; ++q) { *(LAS unsigned short*)(lds + ML_VT + vt_off(ch * 8 + 2 * q, rr >> 3) + (rr & 7) * 2) = (unsigned short)(vw[q] & 0xffffu);
                                              *(LAS unsigned short*)(lds + ML_VT + vt_off(ch * 8 + 2 * q + 1, rr >> 3) + (rr & 7) * 2) = (unsigned short)(vw[q] >> 16); } }
#pragma unroll
            for (int di = 0; di < 2; ++di) {
#pragma unroll
                for (int vi = 0; vi < 4; ++vi) { u32x2 cw; cw.x = pk2(cacc[di][vi][0], cacc[di][vi][1]); cw.y = pk2(cacc[di][vi][2], cacc[di][vi][3]);
                    *(LAS u32x2*)(lds + ML_CT + (16 * vi + li) * ML_RS + (32 * w + 16 * di + 4 * g) * 2) = cw; }
                if (li == 0) { u32x2 nw; nw.x = pk2(nacc[di][0], nacc[di][1]); nw.y = pk2(nacc[di][2], nacc[di][3]); *(LAS u32x2*)(lds + ML_NT + (32 * w + 16 * di + 4 * g) * 2) = nw; } }
            __syncthreads();
            if (c + 1 < nch) ML_LOAD(t0 + 64);
            const float Mprev = (c > 0) ? ML_[t0 - 1] : m0, MT = ML_[t0 + 63];
            bf16x8 qf[8];
            { const int ti = w >> 1, si0 = 2 * (w & 1); const bool need0 = si0 <= ti, need1 = si0 + 1 <= ti, needn = (w & 1) == 0;
              f32x4 a0 = {0.f, 0.f, 0.f, 0.f}, a1 = {0.f, 0.f, 0.f, 0.f}, aN = {0.f, 0.f, 0.f, 0.f};
              bf16x8 kf[8], nf[8];
#pragma unroll
              for (int k = 0; k < 8; ++k) qf[k] = *(const LAS bf16x8*)(lds + ML_Q + (16 * ti + li) * ML_RS + (32 * k + 8 * g) * 2);
              if (need0) {
#pragma unroll
                  for (int k = 0; k < 8; ++k) kf[k] = *(const LAS bf16x8*)(lds + ML_K + (16 * si0 + li) * ML_RS + (32 * k + 8 * g) * 2); }
              if (needn) {
#pragma unroll
                  for (int k = 0; k < 8; ++k) { const u32x4 t = *(const LAS u32x4*)(lds + ML_NT + (32 * k + 8 * g) * 2); nf[k] = __builtin_bit_cast(bf16x8, (li == 0) ? t : (u32x4){0u, 0u, 0u, 0u}); } }
              __builtin_amdgcn_sched_barrier(0);
              if (need0) {
#pragma unroll
                  for (int k = 0; k < 8; ++k) a0 = __builtin_amdgcn_mfma_f32_16x16x32_bf16(kf[k], qf[k], a0, 0, 0, 0); }
              __builtin_amdgcn_sched_barrier(0);
              if (need1) {
#pragma unroll
                  for (int k = 0; k < 8; ++k) kf[k] = *(const LAS bf16x8*)(lds + ML_K + (16 * si0 + 16 + li) * ML_RS + (32 * k + 8 * g) * 2); }
              if (needn) {
#pragma unroll
                  for (int k = 0; k < 8; ++k) aN = __builtin_amdgcn_mfma_f32_16x16x32_bf16(nf[k], qf[k], aN, 0, 0, 0);
                  if (g == 0) qnL[16 * ti + li] = aN[0]; }
              __builtin_amdgcn_sched_barrier(0);
              if (need1) {
#pragma unroll
                  for (int k = 0; k < 8; ++k) a1 = __builtin_amdgcn_mfma_f32_16x16x32_bf16(kf[k], qf[k], a1, 0, 0, 0); }
              const int tau = 16 * ti + li; const float Mt = ML_[t0 + tau]; float dsum = 0.f;
#pragma unroll
              for (int x = 0; x < 2; ++x) { const f32x4 acc = x ? a1 : a0; const int sb = 16 * (si0 + x) + 4 * g; const f32x4 as = *(const LAS f32x4*)(aL + t0 + sb); float v[4];
#pragma unroll
                  for (int r = 0; r < 4; ++r) { const float wgt = (sb + r <= tau) ? __expf(as[r] - Mt) : 0.f; v[r] = acc[r] * wgt; dsum += v[r]; }
                  u32x2 sw; sw.x = pk2(v[0], v[1]); sw.y = pk2(v[2], v[3]);
                  *(LAS u32x2*)(lds + ML_SW + tau * ML_VS + sb * 2) = sw; }
              dsum += __shfl_xor(dsum, 16); dsum += __shfl_xor(dsum, 32);
              if (g == 0) denL[tau * 2 + (w & 1)] = dsum; }
            { const int dv0 = tid >> 4, sp = tid & 15; const f32x4 as = *(const LAS f32x4*)(aL + t0 + 4 * sp);
              const f32x4 wk = {__expf(as.x - MT), __expf(as.y - MT), __expf(as.z - MT), __expf(as.w - MT)};
              if (dv0 == 0) *(LAS f32x4*)(wkL + 4 * sp) = wk;
#pragma unroll
              for (int x = 0; x < 2; ++x) { const int dv = dv0 + 32 * x; const u32x2 vv = *(const LAS u32x2*)(lds + ML_VT + vt_off(dv, sp >> 1) + (sp & 1) * 8);
                  u32x2 o; o.x = pk2(bflo(vv.x) * wk.x, bfhi(vv.x) * wk.y); o.y = pk2(bflo(vv.y) * wk.z, bfhi(vv.y) * wk.w);
                  *(LAS u32x2*)(lds + ML_WV + dv * ML_VS + sp * 8) = o; } }
            __syncthreads();
            { const int ti = w >> 1;
              bf16x8 sf[2];
#pragma unroll
              for (int k = 0; k < 2; ++k) sf[k] = *(const LAS bf16x8*)(lds + ML_SW + (16 * ti + li) * ML_VS + (32 * k + 8 * g) * 2);
#pragma unroll
              for (int x = 0; x < 2; ++x) { const int vi = (w & 1) + 2 * x; f32x4 acc = {0.f, 0.f, 0.f, 0.f}, acc2 = {0.f, 0.f, 0.f, 0.f};
              bf16x8 cf[8], vf[2];
#pragma unroll
              for (int k = 0; k < 8; ++k) cf[k] = *(const LAS bf16x8*)(lds + ML_CT + (16 * vi + li) * ML_RS + (32 * k + 8 * g) * 2);
#pragma unroll
              for (int k = 0; k < 2; ++k) vf[k] = *(const LAS bf16x8*)(lds + ML_VT + vt_off(16 * vi + li, 4 * k + g));
              const int tau = 16 * ti + li; const float Mt = ML_[t0 + tau], Bt = BL[t0 + tau], qn = qnL[tau]; const float d0 = denL[tau * 2], d1 = denL[tau * 2 + 1];
              __builtin_amdgcn_sched_barrier(0);
#pragma unroll
              for (int k = 0; k < 8; ++k) acc = __builtin_amdgcn_mfma_f32_16x16x32_bf16(cf[k], qf[k], acc, 0, 0, 0);
#pragma unroll
              for (int k = 0; k < 2; ++k) acc2 = __builtin_amdgcn_mfma_f32_16x16x32_bf16(vf[k], sf[k], acc2, 0, 0, 0);
              const float ei = __expf(Mprev - Mt);
              acc = acc * ei + acc2;
              const float den = d0 + d1 + ei * qn;
              const float inv = __builtin_amdgcn_rcpf(fmaxf(fabsf(den), __expf(-(Bt + Mt))));
              acc = acc * inv;
              if (t0 + tau < L) { u32x2 hw; hw.x = pk2(acc[0], acc[1]); hw.y = pk2(acc[2], acc[3]); *(u32x2*)(ACAT + (size_t)(row0 + t0 + tau) * 2048 + 1024 + hh * DH + j * 64 + 16 * vi + 4 * g) = hw; } } }
            { const float decay = __expf(Mprev - MT);
#pragma unroll
              for (int di = 0; di < 2; ++di) { nacc[di] = nacc[di] * decay;
#pragma unroll
                  for (int vi = 0; vi < 4; ++vi) cacc[di][vi] = cacc[di][vi] * decay; }
              const int q = li >> 2, pp = li & 3;
              bf16x8 ak[2][2], bw[2][4], bnf[2];
#pragma unroll
              for (int k = 0; k < 2; ++k) {
#pragma unroll
                  for (int di = 0; di < 2; ++di) {
                      const v4s lo = __builtin_amdgcn_ds_read_tr16_b64_v4i16((LAS v4s*)(lds + ML_K + (32 * k + 8 * g + q) * ML_RS + (32 * w + 16 * di + 4 * pp) * 2));
                      const v4s hi = __builtin_amdgcn_ds_read_tr16_b64_v4i16((LAS v4s*)(lds + ML_K + (32 * k + 8 * g + 4 + q) * ML_RS + (32 * w + 16 * di + 4 * pp) * 2));
                      ak[k][di] = (bf16x8){lo.x, lo.y, lo.z, lo.w, hi.x, hi.y, hi.z, hi.w}; }
#pragma unroll
                  for (int vi = 0; vi < 4; ++vi) bw[k][vi] = *(const LAS bf16x8*)(lds + ML_WV + (16 * vi + li) * ML_VS + (32 * k + 8 * g) * 2);
                  { const f32x4 w0 = *(const LAS f32x4*)(wkL + 32 * k + 8 * g), w1 = *(const LAS f32x4*)(wkL + 32 * k + 8 * g + 4);
                    u32x4 bn; bn.x = pk2(w0.x, w0.y); bn.y = pk2(w0.z, w0.w); bn.z = pk2(w1.x, w1.y); bn.w = pk2(w1.z, w1.w);
                    if (li != 0) bn = (u32x4){0u, 0u, 0u, 0u};
                    bnf[k] = __builtin_bit_cast(bf16x8, bn); } }
              __builtin_amdgcn_sched_barrier(0);
#pragma unroll
              for (int k = 0; k < 2; ++k) {
#pragma unroll
                  for (int vi = 0; vi < 4; ++vi)
#pragma unroll
                      for (int di = 0; di < 2; ++di) cacc[di][vi] = __builtin_amdgcn_mfma_f32_16x16x32_bf16(ak[k][di], bw[k][vi], cacc[di][vi], 0, 0, 0);
#pragma unroll
                  for (int di = 0; di < 2; ++di) nacc[di] = __builtin_amdgcn_mfma_f32_16x16x32_bf16(ak[k][di], bnf[k], nacc[di], 0, 0, 0); } }
            __syncthreads();
        }
#undef ML_LOAD
        { const int lane = lane_id_volatile(), g = lane >> 4, li = lane & 15;
          float* oC = p.out + O_PC + ((size_t)s * NH + hh) * DH * DH; float* oN = p.out + O_PN + ((size_t)s * NH + hh) * DH; float* oM = p.out + O_PM + (size_t)s * NH + hh;
#pragma unroll
          for (int di = 0; di < 2; ++di)
#pragma unroll
              for (int vi = 0; vi < 4; ++vi)
#pragma unroll
                  for (int r = 0; r < 4; ++r) oC[(size_t)(32 * w + 16 * di + 4 * g + r) * DH + j * 64 + 16 * vi + li] = cacc[di][vi][r];
          if (j == 0 && li == 0) {
#pragma unroll
              for (int di = 0; di < 2; ++di) *(f32x4*)(oN + 32 * w + 16 * di + 4 * g) = nacc[di]; }
          if (j == 0 && w == 0 && lane == 0) oM[0] = BL[L - 1] + ML_[L - 1]; }
        __syncthreads();
    }
}

constexpr int MS_NP = 0, MS_QF = 0, MS_KF = 8192, MS_QT = 32768, MS_WT = 40960, MS_SS = 49152, MS_HALF = 65536;
__device__ __forceinline__ void mlstm_sample(const P& p, LAS unsigned char* lds, int bid, int nb, int wv) {
    const int tid = opaque_tid(wv), half = tid >> 8, lt = tid & 255, lane = tid & 63, wq = (tid >> 6) & 3;
    const bf16_t* Z = (const bf16_t*)(p.ws + WS_Z); bf16_t* ACAT = (bf16_t*)(p.ws + WS_ACAT); const float* gates = (const float*)(p.ws + WS_SMALL + 65536);
    LAS unsigned char* hb = lds + half * MS_HALF;
    LAS float* NP = (LAS float*)(hb + MS_NP); LAS float* QF = (LAS float*)(hb + MS_QF); LAS float* KF = (LAS float*)(hb + MS_KF); LAS float* QT = (LAS float*)(hb + MS_QT); LAS float* WT = (LAS float*)(hb + MS_WT); LAS float* SS = (LAS float*)(hb + MS_SS);
    for (int pp = bid; pp < DECB * NH / 2; pp += nb) {
        const int pr = pp * 2 + half, b = pr >> 2, hh = pr & 3; const int rowb = MP + b * DECS;
        const float* C0 = p.in[I_SC] + (size_t)pr * DH * DH; float* OC = p.out + O_SC + (size_t)pr * DH * DH;
        float aG[8], MtG[8], BtG[8], wk[8]; const float m0 = p.in[I_SM][pr];
        { float Bc = 0.f, Mc = m0;
#pragma unroll
          for (int t = 0; t < 8; ++t) { const float* gr = gates + (size_t)(rowb + t) * 8 + hh; const float ig = gr[0], lf = logsigmoidf_(gr[4]); Bc += lf; BtG[t] = Bc; aG[t] = ig - Bc; Mc = fmaxf(Mc, aG[t]); MtG[t] = Mc; } }
        const float MT = MtG[7], decay = __expf(m0 - MT);
#pragma unroll
        for (int t = 0; t < 8; ++t) wk[t] = __expf(aG[t] - MT);
        { float kq[8], kk[8]; const bf16_t* zr = Z + (size_t)rowb * NZ + hh * DH + lt;
#pragma unroll
          for (int t = 0; t < 8; ++t) { kq[t] = bf2f(zr[(size_t)t * NZ + ZC_Q]); kk[t] = bf2f(zr[(size_t)t * NZ + ZC_K]); QF[t * 256 + lt] = kq[t]; KF[t * 256 + lt] = kk[t]; }
          const float n0 = p.in[I_SN][(size_t)pr * DH + lt]; KF[8 * 256 + lt] = n0;
          *(LAS f32x4*)(QT + lt * 8) = (f32x4){kq[0], kq[1], kq[2], kq[3]}; *(LAS f32x4*)(QT + lt * 8 + 4) = (f32x4){kq[4], kq[5], kq[6], kq[7]};
          float nn = decay * n0;
#pragma unroll
          for (int t = 0; t < 8; ++t) { kk[t] *= wk[t]; nn += kk[t]; }
          *(LAS f32x4*)(WT + lt * 8) = (f32x4){kk[0], kk[1], kk[2], kk[3]}; *(LAS f32x4*)(WT + lt * 8 + 4) = (f32x4){kk[4], kk[5], kk[6], kk[7]};
          p.out[O_SN + (size_t)pr * DH + lt] = nn;
          if (lt == 0) { p.out[O_SM + pr] = BtG[7] + MT;
#pragma unroll
              for (int t = 0; t < 8; ++t) { SS[80 + t] = aG[t]; SS[88 + t] = MtG[t]; SS[96 + t] = BtG[t]; } } }
        f32x4 vv[8];
#pragma unroll
        for (int t = 0; t < 8; ++t) { const u32x2 w = *(const u32x2*)(Z + (size_t)(rowb + t) * NZ + ZC_V + hh * DH + 4 * lane); vv[t] = (f32x4){bflo(w.x), bfhi(w.x), bflo(w.y), bfhi(w.y)}; }
        const f32x4* cp = (const f32x4*)(C0 + (size_t)(64 * wq) * DH) + lane; f32x4* op = (f32x4*)(OC + (size_t)(64 * wq) * DH) + lane;
        f32x4 cr[4];
#pragma unroll
        for (int i = 0; i < 4; ++i) cr[i] = __builtin_nontemporal_load(cp + i * 64);
        __syncthreads();
        if (lt < 144) { const int pair = lt >> 1, part = lt & 1, t = pair / 9, sp = pair - 9 * t; float acc = 0.f;
#pragma unroll 8
            for (int i = 0; i < 32; ++i) { const f32x4 a = *(const LAS f32x4*)(QF + t * 256 + part * 128 + 4 * i), bq = *(const LAS f32x4*)(KF + sp * 256 + part * 128 + 4 * i); acc += (a.x * bq.x + a.y * bq.y) + (a.z * bq.z + a.w * bq.w); }
            acc += __shfl_xor(acc, 1);
            if (part == 0) SS[pair] = acc; }
        __syncthreads();
        f32x4 num[8];
#pragma unroll
        for (int t = 0; t < 8; ++t) num[t] = (f32x4){0.f, 0.f, 0.f, 0.f};
        const LAS float* qtp = QT + 64 * wq * 8; const LAS float* wtp = WT + 64 * wq * 8;
#pragma unroll 1
        for (int rb = 0; rb < 64; rb += 4) {
            f32x4 cn[4];
            cp += 4 * 64;
            if (rb + 4 < 64) {
#pragma unroll
                for (int i = 0; i < 4; ++i) cn[i] = __builtin_nontemporal_load(cp + i * 64); }
#pragma unroll
            for (int i = 0; i < 4; ++i) {
                const f32x4 q0 = *(const LAS f32x4*)(qtp + i * 8), q1 = *(const LAS f32x4*)(qtp + i * 8 + 4), w0 = *(const LAS f32x4*)(wtp + i * 8), w1 = *(const LAS f32x4*)(wtp + i * 8 + 4);
                const f32x4 c = cr[i];
                num[0] += q0.x * c; num[1] += q0.y * c; num[2] += q0.z * c; num[3] += q0.w * c; num[4] += q1.x * c; num[5] += q1.y * c; num[6] += q1.z * c; num[7] += q1.w * c;
                f32x4 o = decay * c + w0.x * vv[0]; o += w0.y * vv[1]; o += w0.z * vv[2]; o += w0.w * vv[3]; o += w1.x * vv[4]; o += w1.y * vv[5]; o += w1.z * vv[6]; o += w1.w * vv[7];
                __builtin_nontemporal_store(o, op + i * 64); }
            op += 4 * 64; qtp += 32; wtp += 32;
            if (rb + 4 < 64) {
#pragma unroll
                for (int i = 0; i < 4; ++i) cr[i] = cn[i]; }
        }
#pragma unroll
        for (int t = 0; t < 8; ++t) *(LAS f32x4*)(NP + (wq * 8 + t) * 256 + 4 * lane) = num[t];
        __syncthreads();
        { const int t = lt >> 5, d8 = (lt & 31) * 8; float nc[8];
#pragma unroll
          for (int i = 0; i < 8; ++i) nc[i] = 0.f;
#pragma unroll
          for (int x = 0; x < 4; ++x) { const f32x4 a = *(const LAS f32x4*)(NP + (x * 8 + t) * 256 + d8), c2 = *(const LAS f32x4*)(NP + (x * 8 + t) * 256 + d8 + 4);
              nc[0] += a.x; nc[1] += a.y; nc[2] += a.z; nc[3] += a.w; nc[4] += c2.x; nc[5] += c2.y; nc[6] += c2.z; nc[7] += c2.w; }
          const float Mt = SS[88 + t], Bt = SS[96 + t]; const float eint = __expf(m0 - Mt);
          float den = eint * SS[t * 9 + 8];
#pragma unroll
          for (int i = 0; i < 8; ++i) nc[i] *= eint;
#pragma unroll
          for (int sI = 0; sI < 8; ++sI) { const float sw = (sI <= t) ? SS[t * 9 + sI] * __expf(SS[80 + sI] - Mt) : 0.f; den += sw;
              float v8[8]; unpack8(*(const u32x4*)(Z + (size_t)(rowb + sI) * NZ + ZC_V + hh * DH + d8), v8);
#pragma unroll
              for (int i = 0; i < 8; ++i) nc[i] += sw * v8[i]; }
          const float dinv = 1.0f / fmaxf(fabsf(den), __expf(-(Bt + Mt)));
          u32x4 w; w.x = pk2(nc[0] * dinv, nc[1] * dinv); w.y = pk2(nc[2] * dinv, nc[3] * dinv); w.z = pk2(nc[4] * dinv, nc[5] * dinv); w.w = pk2(nc[6] * dinv, nc[7] * dinv);
          *(u32x4*)(ACAT + (size_t)(rowb + t) * 2048 + 1024 + hh * DH + d8) = w; }
        __syncthreads();
    }
}

__device__ __forceinline__ void phase_headnorm(const P& p, int bid, int nb, int wv) {
    const int tid = opaque_tid(wv), lane = tid & 63, wave = tid >> 6;
    const bf16_t* Z = (const bf16_t*)(p.ws + WS_Z); bf16_t* ACAT = (bf16_t*)(p.ws + WS_ACAT); const float* hg = p.in[I_HG];
    const bf16_t* PCUM = (const bf16_t*)(p.ws + WS_PCUM); const float* CARRY = (const float*)(p.ws + WS_CARRY);
    f32x4 gg[4];
#pragma unroll
    for (int j = 0; j < 4; ++j) gg[j] = ((const f32x4*)hg)[lane + 64 * j];
    for (int m = wave * nb + bid; m < MTOK; m += nb * 8) {
        u32x2* ap = (u32x2*)(ACAT + (size_t)m * 2048) + lane; u32x2* hp = ap + 256; const unsigned* op = (const unsigned*)((const unsigned char*)Z + (size_t)m * ZG_PITCH + ZG_OFF) + lane;
        bool fix = false; int sq = 0, seg = 0;
        if (m < MP) { sq = m / LP; seg = (m - sq * LP) >> 6; fix = seg > 0; }
        u32x2 hv[4], av[4]; unsigned ov[4], pv[4]; f32x4 cv[4];
#pragma unroll
        for (int j = 0; j < 4; ++j) { hv[j] = hp[64 * j]; ov[j] = op[64 * j]; }
        if (fix) { const unsigned* pp = (const unsigned*)((const unsigned char*)PCUM + (size_t)m * D) + lane; const f32x4* cp = (const f32x4*)(CARRY + (size_t)(sq * NSEGP + seg) * D) + lane;
#pragma unroll
            for (int j = 0; j < 4; ++j) { av[j] = ap[64 * j]; pv[j] = pp[64 * j]; cv[j] = cp[64 * j]; } }
        if (fix) {
#pragma unroll
            for (int j = 0; j < 4; ++j) { const f32x4 c = cv[j] * (1.0f / 255.0f); u32x2 o; o.x = pk2(bflo(av[j].x) + ub0(pv[j]) * c.x, bfhi(av[j].x) + ub1(pv[j]) * c.y); o.y = pk2(bflo(av[j].y) + ub2(pv[j]) * c.z, bfhi(av[j].y) + ub3(pv[j]) * c.w); ap[64 * j] = o; } }
#pragma unroll
        for (int j = 0; j < 4; ++j) {
            float v0 = bflo(hv[j].x), v1 = bfhi(hv[j].x), v2 = bflo(hv[j].y), v3 = bfhi(hv[j].y);
            const float ssq = wave_sum((v0 * v0 + v1 * v1) + (v2 * v2 + v3 * v3));
            const float rstd = 1.0f / sqrtf(ssq * (1.0f / DH) + EPS);
            const float rq = rstd * (1.0f / 255.0f);
            v0 = v0 * rq * gg[j].x * ub0(ov[j]); v1 = v1 * rq * gg[j].y * ub1(ov[j]); v2 = v2 * rq * gg[j].z * ub2(ov[j]); v3 = v3 * rq * gg[j].w * ub3(ov[j]);
            u32x2 o; o.x = pk2(v0, v1); o.y = pk2(v2, v3); hp[64 * j] = o; }
    }
}

__device__ __forceinline__ void phase_norm2(const P& p, int bid, int nb, int wv) {
    const int tid = opaque_tid(wv), lane = tid & 63, wave = tid >> 6;
    const float* X1 = (const float*)(p.ws + WS_X1); bf16_t* XN = (bf16_t*)(p.ws + WS_XN);
    for (int m = wave * nb + bid; m < MTOK; m += nb * 8) {
        const f32x4* xr = (const f32x4*)(X1 + (size_t)m * D) + lane; f32x4 v[4]; float s = 0.f;
#pragma unroll
        for (int j = 0; j < 4; ++j) { v[j] = xr[64 * j]; s += (v[j].x * v[j].x + v[j].y * v[j].y) + (v[j].z * v[j].z + v[j].w * v[j].w); }
        const float rstd = 1.0f / sqrtf(wave_sum(s) * (1.0f / D) + EPS);
        unsigned long long* o8 = (unsigned long long*)(XN + (size_t)m * D) + lane;
#pragma unroll
        for (int j = 0; j < 4; ++j) { v[j] = v[j] * rstd; o8[64 * j] = (unsigned long long)pk2(v[j].x, v[j].y) | ((unsigned long long)pk2(v[j].z, v[j].w) << 32); }
    }
}

__device__ __forceinline__ float gelu_tanh(float x) { const float u2 = -1.5957691216057308f * (x + 0.044715f * x * x * x); return x * __builtin_amdgcn_rcpf(1.0f + __expf(u2)); }
__device__ __forceinline__ void phase_convffn(const P& p, int bid, int nb, int wv) {
    const int gid = bid * NTHREADS + opaque_tid(wv), nruns = (nb * NTHREADS) / (DFF / 8);
    const int run = gid / (DFF / 8), c0 = (gid - run * (DFF / 8)) * 8;
    if (run >= nruns) return;
    const int rpr = (MTOK + nruns - 1) / nruns, r0 = run * rpr, r1 = (r0 + rpr < MTOK) ? r0 + rpr : MTOK;
    if (r0 >= r1) return;
    const bf16_t* __restrict__ UP = (const bf16_t*)(p.ws + WS_Z); bf16_t* __restrict__ HMID = (bf16_t*)(p.ws + WS_ACAT);
    const float* __restrict__ cw = p.in[I_FCW]; const float* __restrict__ cbv = p.in[I_FCB]; const float* __restrict__ sf = p.in[I_SF]; float* __restrict__ out = p.out;
    float wvt[3][8], wg[3][8], bv[8], bg[8];
#pragma unroll
    for (int q = 0; q < 8; ++q) { bv[q] = cbv[c0 + q]; bg[q] = cbv[DFF + c0 + q];
#pragma unroll
        for (int jx = 0; jx < 3; ++jx) { wvt[jx][q] = cw[(size_t)jx * NUP + c0 + q]; wg[jx][q] = cw[(size_t)jx * NUP + DFF + c0 + q]; } }
    int s, t, L, row0;
    if (r0 < MP) s = r0 / LP; else s = NBP + (r0 - MP) / DECS;
    seq_info(s, row0, L); t = r0 - row0;
    float x0v[8], x1v[8], x0g[8], x1g[8];
#pragma unroll
    for (int q = 0; q < 8; ++q) { x0v[q] = 0.f; x1v[q] = 0.f; x0g[q] = 0.f; x1g[q] = 0.f; }
    if (t >= 1) { unpack8(*(const u32x4*)(UP + (size_t)(r0 - 1) * NUP + c0), x1v); unpack8(*(const u32x4*)(UP + (size_t)(r0 - 1) * NUP + DFF + c0), x1g); }
    if (t >= 2) { unpack8(*(const u32x4*)(UP + (size_t)(r0 - 2) * NUP + c0), x0v); unpack8(*(const u32x4*)(UP + (size_t)(r0 - 2) * NUP + DFF + c0), x0g); }
    else if (t == 1 && s >= NBP) { const float* b1 = sf + ((size_t)(s - NBP) * 2 + 1) * NUP;
#pragma unroll
        for (int q = 0; q < 8; ++q) { x0v[q] = b1[c0 + q]; x0g[q] = b1[DFF + c0 + q]; } }
    u32x4 nv[4], ng[4];
#pragma unroll
    for (int i = 0; i < 4; ++i) { const int rr = (r0 + i < r1) ? r0 + i : r1 - 1; nv[i] = *(const u32x4*)(UP + (size_t)rr * NUP + c0); ng[i] = *(const u32x4*)(UP + (size_t)rr * NUP + DFF + c0); }
    for (int rb = r0; rb < r1; rb += 4) {
        u32x4 lv[4], lg[4];
#pragma unroll
        for (int i = 0; i < 4; ++i) { lv[i] = nv[i]; lg[i] = ng[i]; }
        if (rb + 4 < r1) {
#pragma unroll
            for (int i = 0; i < 4; ++i) { const int rr = (rb + 4 + i < r1) ? rb + 4 + i : r1 - 1; nv[i] = *(const u32x4*)(UP + (size_t)rr * NUP + c0); ng[i] = *(const u32x4*)(UP + (size_t)rr * NUP + DFF + c0); } }
#pragma unroll
        for (int i = 0; i < 4; ++i) { const int r = rb + i;
            if (r < r1) {
                if (t == 0) {
                    if (s >= NBP) { const float* b0 = sf + (size_t)(s - NBP) * 2 * NUP; const float* b1 = b0 + NUP;
#pragma unroll
                        for (int q = 0; q < 8; ++q) { x0v[q] = b0[c0 + q]; x0g[q] = b0[DFF + c0 + q]; x1v[q] = b1[c0 + q]; x1g[q] = b1[DFF + c0 + q]; } }
                    else {
#pragma unroll
                        for (int q = 0; q < 8; ++q) { x0v[q] = 0.f; x0g[q] = 0.f; x1v[q] = 0.f; x1g[q] = 0.f; } } }
                float x2v[8], x2g[8], o[8]; unpack8(lv[i], x2v); unpack8(lg[i], x2g);
#pragma unroll
                for (int q = 0; q < 8; ++q) { const float val = bv[q] + wvt[0][q] * x0v[q] + wvt[1][q] * x1v[q] + wvt[2][q] * x2v[q]; const float gt = bg[q] + wg[0][q] * x0g[q] + wg[1][q] * x1g[q] + wg[2][q] * x2g[q];
                    o[q] = gelu_tanh(gt) * val; }
                u32x4 w; w.x = pk2(o[0], o[1]); w.y = pk2(o[2], o[3]); w.z = pk2(o[4], o[5]); w.w = pk2(o[6], o[7]);
                *(u32x4*)(HMID + (size_t)r * DFF + c0) = w;
                if (t >= L - 2) {
                    float* of = (s < NBP ? out + O_PF + (size_t)s * 2 * NUP : out + O_SF + (size_t)(s - NBP) * 2 * NUP) + (size_t)(t - (L - 2)) * NUP;
                    *(f32x4*)(of + c0) = (f32x4){x2v[0], x2v[1], x2v[2], x2v[3]}; *(f32x4*)(of + c0 + 4) = (f32x4){x2v[4], x2v[5], x2v[6], x2v[7]};
                    *(f32x4*)(of + DFF + c0) = (f32x4){x2g[0], x2g[1], x2g[2], x2g[3]}; *(f32x4*)(of + DFF + c0 + 4) = (f32x4){x2g[4], x2g[5], x2g[6], x2g[7]}; }
#pragma unroll
                for (int q = 0; q < 8; ++q) { x0v[q] = x1v[q]; x1v[q] = x2v[q]; x0g[q] = x1g[q]; x1g[q] = x2g[q]; }
                if (++t == L) { ++s; t = 0; seq_info(s, row0, L); }
            } }
    }
}

__device__ __forceinline__ void phase_final(const P& p, LAS unsigned char* lds, int bid, int nb, int wv) {
    const int tid = opaque_tid(wv), lane = tid & 63, wave = tid >> 6;
    const bf16_t* X2B = (const bf16_t*)(p.ws + WS_X1); const bf16_t* X1B = (const bf16_t*)(p.ws + WS_XN); const float* gf = p.in[I_GF]; const float* PART = (const float*)(p.ws + WS_Z);
    LAS int* tailmap = (LAS int*)lds;
    constexpr int DS = 11;
    for (int i = tid; i < (MPAD / 256) * 4; i += NTHREADS) tailmap[i] = -1;
    __syncthreads();
    { pg8::SplitTailOrder S; S.init(MPAD, D, DFF, nb, 0); const int R = (nb == 256) ? S.nwg - nb : 0;
      if (tid < R) { pg8::Unit u; pg8::StaticOrder t = S; t.c = tid; if (t.next(1, u)) tailmap[u.pm * 4 + u.pn] = tid; } }
    __syncthreads();
    constexpr int FU = 3;
    for (int m0 = wave * nb + bid; m0 < MTOK; m0 += nb * 8 * FU) {
        float* o[FU]; bool ok[FU]; f32x4 v[FU][4]; int tix[FU][4];
#pragma unroll
        for (int u = 0; u < FU; ++u) { const int m = m0 + u * nb * 8; ok[u] = m < MTOK; o[u] = p.out;
            if (ok[u]) { if (m < MP) { const int b = m / LP, t = m - b * LP; if (t < NMETA) ok[u] = false; else o[u] = p.out + O_YP + ((size_t)b * SEQ + (t - NMETA)) * D; }
                         else o[u] = p.out + O_YS + (size_t)(m - MP) * D; }
#pragma unroll
            for (int j = 0; j < 4; ++j) { tix[u][j] = ok[u] ? tailmap[(m >> 8) * 4 + j] : -1;
                u32x2 xw = {0u, 0u}; if (ok[u]) xw = *((const u32x2*)((tix[u][j] >= 0 ? X1B : X2B) + (size_t)m * D) + lane + 64 * j);
                v[u][j] = (f32x4){bflo(xw.x), bfhi(xw.x), bflo(xw.y), bfhi(xw.y)}; } }
#pragma unroll
        for (int u = 0; u < FU; ++u) { const int m = m0 + u * nb * 8; float s = 0.f;
            if (!ok[u]) continue;
#pragma unroll
            for (int j = 0; j < 4; ++j) {
                const int ti = tix[u][j];
                if (ti >= 0) { const u32x2* pp = (const u32x2*)((const bf16_t*)PART + (size_t)(ti * DS) * 65536 + (size_t)(m & 255) * 256) + lane;
#pragma unroll
                    for (int sl = 0; sl < DS; ++sl) { const u32x2 pw = pp[(size_t)sl * 16384]; v[u][j] += (f32x4){bflo(pw.x), bfhi(pw.x), bflo(pw.y), bfhi(pw.y)}; } }
                s += (v[u][j].x * v[u][j].x + v[u][j].y * v[u][j].y) + (v[u][j].z * v[u][j].z + v[u][j].w * v[u][j].w); }
            const float rstd = 1.0f / sqrtf(wave_sum(s) * (1.0f / D) + EPS);
#pragma unroll
            for (int j = 0; j < 4; ++j) __builtin_nontemporal_store(v[u][j] * rstd * ((const f32x4*)gf)[lane + 64 * j], (f32x4*)o[u] + lane + 64 * j); }
    }
}

__device__ __forceinline__ void late_transposes(const P& p, LAS unsigned char* lds, int gw, int NGW, int wv) {
    const int lane = lane_id_volatile(); unsigned char* ws = p.ws;
    LAS float* scr = (LAS float*)(lds + wv * 8448);
    constexpr int I_SQ = 16 * 32, I_UP = 16 * 176, I_DN = 44 * 32, NITEMS = 3 * I_SQ + I_UP + I_DN;
    for (int it = gw; it < NITEMS; it += NGW) {
        int r = it;
        if (r < I_SQ) { tr_item(p.in[I_WA], 1024, (r / 32) * 64, (r % 32) * 32, (bf16_t*)(ws + WS_WCAT), 2048, (r % 32) * 32, 0, nullptr, 1.f, scr, lane); continue; } r -= I_SQ;
        if (r < I_SQ) { tr_item(p.in[I_WB], 1024, (r / 32) * 64, (r % 32) * 32, (bf16_t*)(ws + WS_WCAT), 2048, (r % 32) * 32, 1024, nullptr, 1.f, scr, lane); continue; } r -= I_SQ;
        if (r < I_SQ) { tr_item(p.in[I_WOUT], 1024, (r / 32) * 64, (r % 32) * 32, (bf16_t*)(ws + WS_WOUT), 1024, (r % 32) * 32, 0, nullptr, 1.f, scr, lane); continue; } r -= I_SQ;
        if (r < I_UP) { const int n0 = (r % 176) * 32, ns0 = ((n0 >> 7) & 1) * DFF + (n0 >> 8) * 128 + (n0 & 127);
            tr_item(p.in[I_WUP], NUP, (r / 176) * 64, ns0, (bf16_t*)(ws + WS_WUP), 1024, n0, 0, p.in[I_G2], 1.f, scr, lane); continue; } r -= I_UP;
        tr_item(p.in[I_WDOWN], 1024, (r / 32) * 64, (r % 32) * 32, (bf16_t*)(ws + WS_WDOWN), DFF, (r % 32) * 32, 0, nullptr, 1.f, scr, lane);
    }
}
__device__ __forceinline__ void phase_gemm1(const P& p, LAS unsigned char* lds, int bid, int nb, int wv) {
    pg8::Gemm g{(const bf16_t*)(p.ws + WS_XN), (const bf16_t*)(p.ws + WS_WIN), MPAD, NZ, D, 0}; pg8::StaticOrder S; S.init(MPAD, NZ, D, nb, bid);
    pg8::EpiBf16 E{(bf16_t*)(p.ws + WS_Z), NZ, (const float*)(p.ws + WS_SMALL), nullptr};
    pg8::gemm_phase<pg8::EpiBf16, pg8::StaticOrder, true, true>(lds, g, S, E, wv);
    { const int rem = S.nwg % nb, idle0 = (rem == 0) ? 0 : rem, nidle = nb - idle0;
      if (bid >= idle0) { late_transposes(p, lds, wv * nidle + (bid - idle0), nidle * 8, wv); } }
}
__device__ __forceinline__ void phase_gemm_merge(const P& p, LAS unsigned char* lds, int bid, int nb, int wv) {
    pg8::Gemm g{(const bf16_t*)(p.ws + WS_ACAT), (const bf16_t*)(p.ws + WS_WCAT), MPAD, D, 2048, 0}; pg8::SplitTailOrder S; S.init(MPAD, D, 2048, nb, bid); S.S = (nb == 256) ? 8 : 0;
    pg8::EpiMerge E{(bf16_t*)(p.ws + WS_MERGED), (const bf16_t*)(p.ws + WS_Z), (float*)(p.ws + WS_X1), (unsigned*)(p.ws + WS_CTL) + 1024, 8};
    pg8::gemm_phase<pg8::EpiMerge, pg8::SplitTailOrder, true, true>(lds, g, S, E, wv);
}
__device__ __forceinline__ void phase_gemm_out(const P& p, LAS unsigned char* lds, int bid, int nb, int wv) {
    pg8::Gemm g{(const bf16_t*)(p.ws + WS_MERGED), (const bf16_t*)(p.ws + WS_WOUT), MPAD, D, D, 0}; pg8::SplitTailOrder S; S.init(MPAD, D, D, nb, bid); S.S = (nb == 256) ? 4 : 0;
    pg8::EpiX1 E{p.in[I_META], p.in[I_XP], p.in[I_XS], nullptr, (bf16_t*)(p.ws + WS_XN), (float*)(p.ws + WS_SSQ), (float*)(p.ws + WS_Z), (unsigned*)(p.ws + WS_CTL) + 1088, 4};
    pg8::gemm_phase<pg8::EpiX1, pg8::SplitTailOrder, true, true>(lds, g, S, E, wv);
}
__device__ __forceinline__ void phase_gemm_up(const P& p, LAS unsigned char* lds, int bid, int nb, int wv) {
    pg8::Gemm g{(const bf16_t*)(p.ws + WS_XN), (const bf16_t*)(p.ws + WS_WUP), MPAD, NUP, D, 1}; pg8::StaticOrder S; S.init(MPAD, NUP, D, nb, bid);
    pg8::EpiUp E{(bf16_t*)(p.ws + WS_ACAT), (const float*)(p.ws + WS_SSQ), p.in[I_FCW], p.in[I_FCB], p.in[I_SF], p.out, (LAS float*)(lds + 131072)};
    pg8::gemm_phase<pg8::EpiUp, pg8::StaticOrder, true, true>(lds, g, S, E, wv);
}
__device__ __forceinline__ void phase_gemm_down(const P& p, LAS unsigned char* lds, int bid, int nb, int wv) {
    pg8::Gemm g{(const bf16_t*)(p.ws + WS_ACAT), (const bf16_t*)(p.ws + WS_WDOWN), MPAD, D, DFF, 0}; pg8::SplitTailOrder S; S.init(MPAD, D, DFF, nb, bid); S.S = (nb == 256) ? 11 : 0;
    pg8::EpiAcc E{(const bf16_t*)(p.ws + WS_XN), (bf16_t*)(p.ws + WS_X1), (float*)(p.ws + WS_Z)};
    pg8::gemm_phase<pg8::EpiAcc, pg8::SplitTailOrder, true, true>(lds, g, S, E, wv);
}


#define XB_TMO      128
#define XB_XCNT(j)  (256  + 64 * (j))
#define XB_XSUB(j)  (1280 + 64 * (j))
#define XB_XGEN(j)  (2304 + 64 * (j))
#define XB_TOP      3328
#define XB_TOPGEN   3392
#define XCD_BAR_WORDS 3456
#define XB_SPIN_CAP (1u << 22)
constexpr int CW_BAR = 4096;
__device__ __forceinline__ unsigned xb_ld(unsigned* p)              { return __hip_atomic_load(p, __ATOMIC_RELAXED, __HIP_MEMORY_SCOPE_AGENT); }
__device__ __forceinline__ unsigned xb_add(unsigned* p, unsigned v) { return __hip_atomic_fetch_add(p, v, __ATOMIC_RELAXED, __HIP_MEMORY_SCOPE_AGENT); }
__device__ __forceinline__ unsigned xb_xcc_id() { return (unsigned)__builtin_amdgcn_s_getreg((3 << 11) | 20) & 0xFu; }
#define XB_SPIN(cond, bar) do { unsigned _sp = 0; while (cond) { __builtin_amdgcn_s_sleep(1); \
    if ((++_sp & 255u) == 0u) { if (xb_ld(&(bar)[XB_TMO])) break; if (_sp > XB_SPIN_CAP) { atomicAdd(&(bar)[XB_TMO], 1u); break; } } } } while (0)
struct XcdBarrier { unsigned* bar; unsigned x; volatile LAS unsigned* st; };
__device__ __forceinline__ XcdBarrier xcd_barrier_post(unsigned* bar, volatile LAS unsigned* st) {
    XcdBarrier b; b.bar = bar; b.x = xb_xcc_id(); b.st = st;
    if (threadIdx.x == 0) (void)xb_add(&bar[XB_XCNT(b.x)], 1u);
    return b;
}
__device__ __forceinline__ void xcd_barrier_complete(unsigned* bar, unsigned x, unsigned& nloc, unsigned& nx) {
    const unsigned G = gridDim.x * gridDim.y * gridDim.z;
    unsigned sum, cnt, mine, sp = 0u;
    for (;;) {
        sum = 0u; cnt = 0u; mine = 0u;
#pragma unroll
        for (unsigned j = 0; j < 16; ++j) { const unsigned c = xb_ld(&bar[XB_XCNT(j)]); sum += c; cnt += (c > 0u) ? 1u : 0u; mine = (j == x) ? c : mine; }
        if (sum == G) break;
        __builtin_amdgcn_s_sleep(1);
        if ((++sp & 255u) == 0u) { if (xb_ld(&bar[XB_TMO])) break; if (sp > XB_SPIN_CAP) { atomicAdd(&bar[XB_TMO], 1u); break; } }
    }
    nloc = mine > 0u ? mine : 1u; nx = cnt > 0u ? cnt : 1u;
}
__device__ __forceinline__ void xcd_barrier(const XcdBarrier& b, int wv);
__device__ __forceinline__ void xcd_barrier_at(unsigned* bar, volatile LAS unsigned* st, int wv) { XcdBarrier b; b.bar = bar; b.x = xb_xcc_id(); b.st = st; xcd_barrier(b, wv); }
__device__ __forceinline__ void xcd_barrier(const XcdBarrier& b, int wv) {
    asm volatile("s_waitcnt vmcnt(0)" ::: "memory");
    __syncthreads();
    if (wv == 0 && lane_id_volatile() == 0) {
        unsigned* bar = b.bar;
        __builtin_amdgcn_s_waitcnt(0);
        unsigned nloc = b.st[0], nx = b.st[1];
        if (nloc == 0u) { xcd_barrier_complete(bar, b.x, nloc, nx); b.st[0] = nloc; b.st[1] = nx; }
        const unsigned old = xb_add(&bar[XB_XSUB(b.x)], 1u);
        const unsigned gen = old / nloc;
        if (old + 1u == (gen + 1u) * nloc) {
            __builtin_amdgcn_fence(__ATOMIC_RELEASE, "agent");
            asm volatile("s_waitcnt vmcnt(0)" ::: "memory");
            const unsigned og = xb_add(&bar[XB_TOP], 1u);
            const unsigned tg = og / nx;
            if (og + 1u == (tg + 1u) * nx) xb_add(&bar[XB_TOPGEN], 1u);
            else XB_SPIN(xb_ld(&bar[XB_TOPGEN]) == tg, bar);
            __builtin_amdgcn_fence(__ATOMIC_ACQUIRE, "agent");
            xb_add(&bar[XB_XGEN(b.x)], 1u);
            asm volatile("s_waitcnt vmcnt(0)" ::: "memory");
        } else {
            XB_SPIN(xb_ld(&bar[XB_XGEN(b.x)]) == gen, bar);
            __builtin_amdgcn_fence(__ATOMIC_ACQUIRE, "agent");
            asm volatile("s_waitcnt vmcnt(0)" ::: "memory");
        }
    }
    __syncthreads();
}

constexpr int NPHASES = 12;
template <int PH> __device__ __forceinline__ void run_phase(const P& p, LAS unsigned char* lds, int bid, int nb, int wv) {
    if constexpr (PH == 0) phase_prep(p, lds, bid, nb, wv);
    if constexpr (PH == 1) phase_gemm1(p, lds, bid, nb, wv);
    constexpr int LRU_SPLIT = NBP * NSEGP + DECB / 2;
    if constexpr (PH == 2) { if (bid >= (nb >> 1)) phase_lru(p, lds, bid - (nb >> 1), nb >> 1, wv, 0, LRU_SPLIT); __syncthreads(); }
    if constexpr (PH == 3) {
        if (bid < (nb >> 1)) { phase_mlstm(p, lds, bid, nb >> 1, wv); if (MK_DUP == 30) phase_mlstm(p, lds, bid, nb >> 1, wv); __syncthreads(); phase_lru(p, lds, bid, nb >> 1, wv, LRU_SPLIT, 1 << 30); __syncthreads(); }
        else { mlstm_sample(p, lds, bid - (nb >> 1), nb >> 1, wv); if (MK_DUP == 31) mlstm_sample(p, lds, bid - (nb >> 1), nb >> 1, wv); } }
    if constexpr (PH == 4) phase_headnorm(p, bid, nb, wv);
    if constexpr (PH == 5) phase_gemm_merge(p, lds, bid, nb, wv);
    if constexpr (PH == 6) phase_gemm_out(p, lds, bid, nb, wv);
    if constexpr (PH == 7) phase_norm2(p, bid, nb, wv);
    if constexpr (PH == 8) phase_gemm_up(p, lds, bid, nb, wv);
    if constexpr (PH == 9) phase_convffn(p, bid, nb, wv);
    if constexpr (PH == 10) phase_gemm_down(p, lds, bid, nb, wv);
    if constexpr (PH == 11) phase_final(p, lds, bid, nb, wv);
}
#if MK_ONE_LAUNCH
__global__ void __launch_bounds__(NTHREADS, 2) k_fwd(P p) {
    extern __shared__ __attribute__((aligned(16))) unsigned char lds_raw[];
    LAS unsigned char* lds = (LAS unsigned char*)lds_raw;
    cg::grid_group grid = cg::this_grid();
    const int bid = (int)blockIdx.x, nb = (int)gridDim.x;
    const int wv = __builtin_amdgcn_readfirstlane((int)(threadIdx.x >> 6));
#define RUNP(X) do { run_phase<X>(p, lds, bid, nb, wv); if (MK_DUP == X) { xcd_barrier_at((unsigned*)(p.ws + WS_CTL) + CW_BAR, (volatile LAS unsigned*)(lds + LDS_BYTES - 64), wv); run_phase<X>(p, lds, bid, nb, wv); } } while (0)
    volatile LAS unsigned* bst = (volatile LAS unsigned*)(lds + LDS_BYTES - 64);
    if (threadIdx.x < 16) bst[threadIdx.x] = 0u;
    (void)xcd_barrier_post((unsigned*)(p.ws + WS_CTL) + CW_BAR, bst);
    if (nb == 0x7fffffff) grid.sync();
    run_phase<0>(p, lds, bid, nb, wv); xcd_barrier_at((unsigned*)(p.ws + WS_CTL) + CW_BAR, (volatile LAS unsigned*)(lds + LDS_BYTES - 64), wv);
    RUNP(1); xcd_barrier_at((unsigned*)(p.ws + WS_CTL) + CW_BAR, (volatile LAS unsigned*)(lds + LDS_BYTES - 64), wv);
    RUNP(2);
    RUNP(3); xcd_barrier_at((unsigned*)(p.ws + WS_CTL) + CW_BAR, (volatile LAS unsigned*)(lds + LDS_BYTES - 64), wv);
    run_phase<4>(p, lds, bid, nb, wv); xcd_barrier_at((unsigned*)(p.ws + WS_CTL) + CW_BAR, (volatile LAS unsigned*)(lds + LDS_BYTES - 64), wv);
    RUNP(5); xcd_barrier_at((unsigned*)(p.ws + WS_CTL) + CW_BAR, (volatile LAS unsigned*)(lds + LDS_BYTES - 64), wv);
    RUNP(6); xcd_barrier_at((unsigned*)(p.ws + WS_CTL) + CW_BAR, (volatile LAS unsigned*)(lds + LDS_BYTES - 64), wv);
    RUNP(8); xcd_barrier_at((unsigned*)(p.ws + WS_CTL) + CW_BAR, (volatile LAS unsigned*)(lds + LDS_BYTES - 64), wv);
    run_phase<10>(p, lds, bid, nb, wv); xcd_barrier_at((unsigned*)(p.ws + WS_CTL) + CW_BAR, (volatile LAS unsigned*)(lds + LDS_BYTES - 64), wv);
    RUNP(11);
}
#endif

#if !MK_ONE_LAUNCH
template <int PH> __global__ void __launch_bounds__(NTHREADS, 2) k_phase(P p) {
    extern __shared__ __attribute__((aligned(16))) unsigned char lds_raw[];
    run_phase<PH>(p, (LAS unsigned char*)lds_raw, (int)blockIdx.x, (int)gridDim.x, __builtin_amdgcn_readfirstlane((int)(threadIdx.x >> 6)));
}
template <int PH> static void launch_phase(const P& p, int grid, hipStream_t stream) {
    static bool attr = false;
    if (!attr) { (void)hipFuncSetAttribute((const void*)k_phase<PH>, hipFuncAttributeMaxDynamicSharedMemorySize, LDS_BYTES); attr = true; }
    hipLaunchKernelGGL(k_phase<PH>, dim3(grid), dim3(NTHREADS), LDS_BYTES, stream, p);
}
#endif

extern "C" void kernel_launch(void* const* d_in, const int* in_sizes, int n_in, void* d_out, int out_size, void* d_ws, size_t ws_size, hipStream_t stream) {
    if (n_in != 29 || (size_t)out_size != O_END || ws_size < WS_END) { fprintf(stderr, "kernel_launch: unexpected shapes (n_in %d, out %d, ws %zu)\n", n_in, out_size, ws_size); return; }
    P p{};
    for (int i = 0; i < 29; ++i) p.in[i] = (const float*)d_in[i];
    p.out = (float*)d_out; p.ws = (unsigned char*)d_ws;
#if MK_ONE_LAUNCH
    static int grid = 0;
    if (grid == 0) {
        int dev = 0, cus = 0, per_cu = 0;
        (void)hipGetDevice(&dev); (void)hipDeviceGetAttribute(&cus, hipDeviceAttributeMultiprocessorCount, dev);
        (void)hipFuncSetAttribute((const void*)k_fwd, hipFuncAttributeMaxDynamicSharedMemorySize, LDS_BYTES);
        if (hipOccupancyMaxActiveBlocksPerMultiprocessor(&per_cu, (const void*)k_fwd, NTHREADS, LDS_BYTES) != hipSuccess || per_cu < 1) { fprintf(stderr, "kernel_launch: occupancy query failed (%d)\n", per_cu); per_cu = 1; }
        grid = cus * 1;
        if (grid <= 0) grid = 256;
    }
    if (hipMemsetAsync(d_ws, 0, 32768, stream) != hipSuccess) { fprintf(stderr, "kernel_launch: memset of control words failed\n"); return; }
    void* args[] = {(void*)&p};
    hipError_t e = hipLaunchCooperativeKernel((const void*)k_fwd, dim3(grid), dim3(NTHREADS), args, LDS_BYTES, stream);
    if (e != hipSuccess) fprintf(stderr, "cooperative launch failed: %s (grid %d)\n", hipGetErrorString(e), grid);
#else
    const int grid = 256;
    launch_phase<0>(p, grid, stream); launch_phase<1>(p, grid, stream); launch_phase<2>(p, grid, stream); launch_phase<3>(p, grid, stream);
    launch_phase<4>(p, grid, stream); launch_phase<5>(p, grid, stream); launch_phase<6>(p, grid, stream); launch_phase<7>(p, grid, stream);
    launch_phase<8>(p, grid, stream); launch_phase<9>(p, grid, stream); launch_phase<10>(p, grid, stream); launch_phase<11>(p, grid, stream);
#endif
}
```
